# Optimizing an MI355X kernel written in HIP

```python
import math
import jax, jax.numpy as jnp
from jax import lax
import numpy as np

D_MODEL = 1024
BATCH = 4
SEQ = 8192
DEPTH = 1

GRID_W = 64
HEAD_DIM = 64
A_HEADS = D_MODEL // (2 * HEAD_DIM)
A_KV_HEADS = A_HEADS // 4
B_HEADS = D_MODEL // (2 * HEAD_DIM)
A_WIDTH = A_HEADS * HEAD_DIM
A_KV_WIDTH = A_KV_HEADS * HEAD_DIM
B_WIDTH = B_HEADS * HEAD_DIM
MIX_WIDTH = A_WIDTH + B_WIDTH
IN_WIDTH = A_WIDTH + 2 * A_KV_WIDTH + 3 * B_WIDTH
Q_BLOCK = 128
ROPE_THETA = 10000.0
NA_KH = 8
NA_KW = 16
PEER_HEADS = 8
PEER_N_KEYS = 128
PEER_N_EXPERTS = PEER_N_KEYS * PEER_N_KEYS
PEER_QUERY_DIM = 256
PEER_SUB_DIM = PEER_QUERY_DIM // 2
PEER_TOPK = 16
PEER_BLOCK = 128
EPS = 1e-6

kernel_name = "hymba_gqa_natten_peer_block"


def rmsnorm(x, g):
    xf = x.astype(jnp.float32)
    y = xf * lax.rsqrt(jnp.mean(xf * xf, axis=-1, keepdims=True) + EPS)
    return (y * g.astype(jnp.float32)).astype(x.dtype)


def rope_axis(x, pos):
    half = x.shape[-1] // 2
    freqs = ROPE_THETA ** (-jnp.arange(half, dtype=jnp.float32) / half)
    ang = pos.astype(jnp.float32)[:, None] * freqs[None, :]
    cos = jnp.cos(ang)[None, :, None, :]
    sin = jnp.sin(ang)[None, :, None, :]
    xf = x.astype(jnp.float32)
    x1, x2 = xf[..., :half], xf[..., half:]
    out = jnp.concatenate([x1 * cos - x2 * sin, x1 * sin + x2 * cos], axis=-1)
    return out.astype(x.dtype)


def axial_rope(x, row, col):
    d = x.shape[-1] // 2
    return jnp.concatenate([rope_axis(x[..., :d], row), rope_axis(x[..., d:], col)], axis=-1)


def gqa_axial_attention(q, k, v, row, col, q_norm_g, k_norm_g):
    bsz, seq, nh, dh = q.shape
    grp = nh // A_KV_HEADS
    q = axial_rope(rmsnorm(q, q_norm_g), row, col)
    k = axial_rope(rmsnorm(k, k_norm_g), row, col)
    nblk = seq // Q_BLOCK
    qb = q.reshape(bsz, nblk, Q_BLOCK, A_KV_HEADS, grp, dh).transpose(1, 0, 2, 3, 4, 5)
    scale = dh ** -0.5

    def block(qblk):
        s = jnp.einsum('bqkgd,bskd->bkgqs', qblk, k).astype(jnp.float32) * scale
        p = jax.nn.softmax(s, axis=-1).astype(v.dtype)
        return jnp.einsum('bkgqs,bskd->bqkgd', p, v)

    o = lax.map(block, qb)
    return o.transpose(1, 0, 2, 3, 4, 5).reshape(bsz, seq, nh * dh)


def natten_tables(seq):
    rows = seq // GRID_W
    kh = min(NA_KH, rows)
    t = jnp.arange(seq, dtype=jnp.int32)
    r = t // GRID_W
    cc = t % GRID_W
    rs = jnp.clip(r - kh // 2, 0, rows - kh)
    cs = jnp.clip(cc - NA_KW // 2, 0, GRID_W - NA_KW)
    key_r = rs[:, None, None] + jnp.arange(kh, dtype=jnp.int32)[None, :, None]
    key_c = cs[:, None, None] + jnp.arange(NA_KW, dtype=jnp.int32)[None, None, :]
    shape = (seq, kh, NA_KW)
    idx = jnp.broadcast_to(key_r * GRID_W + key_c, shape).reshape(seq, kh * NA_KW)
    dri = jnp.broadcast_to(key_r - r[:, None, None] + (NA_KH - 1), shape).reshape(seq, kh * NA_KW)
    dci = jnp.broadcast_to(key_c - cc[:, None, None] + (NA_KW - 1), shape).reshape(seq, kh * NA_KW)
    return idx, dri, dci


def neighbourhood_attention(q, k, v, rpb):
    bsz, seq, nh, dh = q.shape
    idx, dri, dci = natten_tables(seq)
    nkeys = idx.shape[-1]
    nblk = seq // Q_BLOCK
    qb = q.reshape(bsz, nblk, Q_BLOCK, nh, dh).swapaxes(0, 1)
    idxb = idx.reshape(nblk, Q_BLOCK, nkeys)
    drb = dri.reshape(nblk, Q_BLOCK, nkeys)
    dcb = dci.reshape(nblk, Q_BLOCK, nkeys)
    scale = dh ** -0.5

    def block(args):
        qblk, ib, rb, cb = args
        kn = k[:, ib]
        vn = v[:, ib]
        bias = rpb[:, rb, cb].astype(jnp.float32)
        s = jnp.einsum('bqhd,bqlhd->bhql', qblk, kn).astype(jnp.float32) * scale + bias[None]
        p = jax.nn.softmax(s, axis=-1).astype(v.dtype)
        return jnp.einsum('bhql,bqlhd->bqhd', p, vn)

    o = lax.map(block, (qb, idxb, drb, dcb))
    return o.swapaxes(0, 1).reshape(bsz, seq, nh * dh)


def peer_ffn(h, w_query, sub_keys_1, sub_keys_2, peer_u, peer_v):
    bsz, seq, d = h.shape
    nblk = seq // PEER_BLOCK
    hb = h.reshape(bsz, nblk, PEER_BLOCK, d).swapaxes(0, 1)

    def block(hblk):
        q = (hblk @ w_query).reshape(bsz, PEER_BLOCK, PEER_HEADS, 2, PEER_SUB_DIM)
        s1 = jnp.einsum('bthd,nd->bthn', q[..., 0, :], sub_keys_1).astype(jnp.float32)
        s2 = jnp.einsum('bthd,nd->bthn', q[..., 1, :], sub_keys_2).astype(jnp.float32)
        v1, i1 = lax.top_k(s1, PEER_TOPK)
        v2, i2 = lax.top_k(s2, PEER_TOPK)
        cand = (v1[..., :, None] + v2[..., None, :]).reshape(bsz, PEER_BLOCK, PEER_HEADS, PEER_TOPK * PEER_TOPK)
        cidx = (i1[..., :, None] * PEER_N_KEYS + i2[..., None, :]).reshape(bsz, PEER_BLOCK, PEER_HEADS, PEER_TOPK * PEER_TOPK)
        top, pos = lax.top_k(cand, PEER_TOPK)
        eidx = jnp.take_along_axis(cidx, pos, axis=-1)
        g = jax.nn.softmax(top, axis=-1).astype(h.dtype)
        u = peer_u[eidx]
        a = jax.nn.gelu(jnp.einsum('bthkd,btd->bthk', u, hblk), approximate=False)
        vv = peer_v[eidx]
        return jnp.einsum('bthk,bthkd->btd', g * a, vv)

    o = lax.map(block, hb)
    return o.swapaxes(0, 1).reshape(bsz, seq, d)


def setup_inputs(seed: int = 0) -> dict:
    key = jax.random.key(seed)
    ks = jax.random.split(key, 20)
    f32 = jnp.float32
    nrm = lambda k, shape, s: jax.random.normal(k, shape, f32) * s
    gain = lambda k, shape: jnp.ones(shape, f32) + 0.01 * jax.random.normal(k, shape, f32)
    return {
        "x": nrm(ks[0], (BATCH, SEQ, D_MODEL), 1.0),
        "c": nrm(ks[1], (BATCH, D_MODEL), 1.0),
        "w_ada": nrm(ks[2], (DEPTH, D_MODEL, 6 * D_MODEL), D_MODEL ** -0.5),
        "b_ada": nrm(ks[3], (DEPTH, 6 * D_MODEL), 0.01),
        "norm1_g": gain(ks[4], (DEPTH, D_MODEL)),
        "w_in": nrm(ks[5], (DEPTH, D_MODEL, IN_WIDTH), D_MODEL ** -0.5),
        "q_norm_g": gain(ks[6], (DEPTH, HEAD_DIM)),
        "k_norm_g": gain(ks[7], (DEPTH, HEAD_DIM)),
        "natten_rpb": nrm(ks[8], (DEPTH, B_HEADS, 2 * NA_KH - 1, 2 * NA_KW - 1), 0.1),
        "group_norm_a_g": gain(ks[9], (DEPTH, A_WIDTH)),
        "group_norm_b_g": gain(ks[10], (DEPTH, B_WIDTH)),
        "w_out": nrm(ks[11], (DEPTH, MIX_WIDTH, D_MODEL), MIX_WIDTH ** -0.5),
        "norm2_g": gain(ks[12], (DEPTH, D_MODEL)),
        "peer_w_query": nrm(ks[13], (DEPTH, D_MODEL, PEER_HEADS * PEER_QUERY_DIM), D_MODEL ** -0.5),
        "peer_sub_keys_1": nrm(ks[14], (DEPTH, PEER_N_KEYS, PEER_SUB_DIM), PEER_SUB_DIM ** -0.5),
        "peer_sub_keys_2": nrm(ks[15], (DEPTH, PEER_N_KEYS, PEER_SUB_DIM), PEER_SUB_DIM ** -0.5),
        "peer_u": nrm(ks[16], (DEPTH, PEER_N_EXPERTS, D_MODEL), D_MODEL ** -0.5),
        "peer_v": nrm(ks[17], (DEPTH, PEER_N_EXPERTS, D_MODEL), PEER_HEADS ** -0.5),
        "final_norm_g": gain(ks[18], (D_MODEL,)),
    }


def reference(x, c, w_ada, b_ada, norm1_g, w_in, q_norm_g, k_norm_g, natten_rpb,
              group_norm_a_g, group_norm_b_g, w_out, norm2_g, peer_w_query,
              peer_sub_keys_1, peer_sub_keys_2, peer_u, peer_v, final_norm_g):
    bsz, seq, d = x.shape
    t = jnp.arange(seq, dtype=jnp.int32)
    row = t // GRID_W
    col = t % GRID_W
    o1 = A_WIDTH
    o2 = o1 + A_KV_WIDTH
    o3 = o2 + A_KV_WIDTH
    o4 = o3 + B_WIDTH
    o5 = o4 + B_WIDTH
    for l in range(DEPTH):
        mod = jax.nn.silu(c) @ w_ada[l] + b_ada[l]
        shift1, scale1, gate1, shift2, scale2, gate2 = jnp.split(mod, 6, axis=-1)
        h = rmsnorm(x, norm1_g[l]) * (1.0 + scale1[:, None, :]) + shift1[:, None, :]
        p = h @ w_in[l]
        qa = p[..., :o1].reshape(bsz, seq, A_HEADS, HEAD_DIM)
        ka = p[..., o1:o2].reshape(bsz, seq, A_KV_HEADS, HEAD_DIM)
        va = p[..., o2:o3].reshape(bsz, seq, A_KV_HEADS, HEAD_DIM)
        qb = p[..., o3:o4].reshape(bsz, seq, B_HEADS, HEAD_DIM)
        kb = p[..., o4:o5].reshape(bsz, seq, B_HEADS, HEAD_DIM)
        vb = p[..., o5:].reshape(bsz, seq, B_HEADS, HEAD_DIM)
        out_a = gqa_axial_attention(qa, ka, va, row, col, q_norm_g[l], k_norm_g[l])
        out_b = neighbourhood_attention(qb, kb, vb, natten_rpb[l])
        mix = jnp.concatenate([rmsnorm(out_a, group_norm_a_g[l]),
                               rmsnorm(out_b, group_norm_b_g[l])], axis=-1) @ w_out[l]
        x = x + gate1[:, None, :] * mix
        h2 = rmsnorm(x, norm2_g[l]) * (1.0 + scale2[:, None, :]) + shift2[:, None, :]
        ffn = peer_ffn(h2, peer_w_query[l], peer_sub_keys_1[l], peer_sub_keys_2[l], peer_u[l], peer_v[l])
        x = x + gate2[:, None, :] * ffn
    return rmsnorm(x, final_norm_g)
```

```cpp
#include <hip/hip_runtime.h>
#include <hip/hip_bf16.h>
#include <cstdio>
#include <cstdint>
#include <cmath>
namespace pg8 {
#define PG8_LAS __attribute__((address_space(3)))
typedef unsigned short bf16_t;
typedef short bf16x8 __attribute__((ext_vector_type(8)));
typedef float f32x4 __attribute__((ext_vector_type(4)));
typedef unsigned u32x4 __attribute__((ext_vector_type(4)));
typedef unsigned u32x2 __attribute__((ext_vector_type(2)));
constexpr int BM = 256, BK = 64, HALF = 128, HTB = HALF * BK * 2  , STAGE_BYTES = 8 * HTB, NXCD = 8, WGM = 8;

__host__ __device__ __forceinline__ int lds_byte(int r, int c) { const int st = (r >> 4) * 2 + (c >> 5), rr = r & 15, cc = c & 31, ob = rr * 64 + cc * 2; return st * 1024 + (ob ^ (((ob >> 9) & 1) << 5)); }
__host__ __device__ __forceinline__ void stage_rc(int b, int& R, int& C) { const int st = b / 1024, sb = b % 1024, swz = sb ^ (((sb >> 9) & 1) << 5); R = (st >> 1) * 16 + swz / 64; C = (st & 1) * 32 + (swz % 64) / 2; }
__host__ __device__ __forceinline__ int perm32(int rho) { const int n = rho >> 4, i = rho & 15; return 8 * (i >> 2) + 4 * n + (i & 3); }

struct Unit { int pm, pn; };
struct Gemm { const bf16_t* A; const bf16_t* Bt; int M, N, K; };

struct StaticOrder {
    int nM, nN, nwg, G, c;
    __host__ __device__ void init(int M, int N, int G_, int c_) { nM = M / BM; nN = N / BM; nwg = nM * nN; G = G_; c = c_; }
    __host__ __device__ bool next(int i, Unit& u) const {
        const long L = (long)i * G + c; if (L >= nwg) return false;
        int wgid = (int)L; { const int q = nwg / NXCD, r = nwg % NXCD, xcd = wgid % NXCD, off = wgid / NXCD; wgid = (xcd < r ? xcd * (q + 1) : r * (q + 1) + (xcd - r) * q) + off; }
        const int nig = WGM * nN, gid = wgid / nig, fm = gid * WGM, gsz = (nM - fm) < WGM ? (nM - fm) : WGM;
        u.pm = fm + ((wgid % nig) % gsz); u.pn = (wgid % nig) / gsz; return true;
    }
    __device__ __forceinline__ void a_ready(const Unit&) const {}
    __device__ __forceinline__ void done(const Unit&) const {}
};

__device__ __forceinline__ unsigned cvt_pk_bf16(float lo, float hi) { unsigned r; asm volatile("v_cvt_pk_bf16_f32 %0, %1, %2" : "=v"(r) : "v"(lo), "v"(hi)); return r; }

struct EpiBf16 {
    static constexpr bool PERM = true, AFTER_DRAIN = false, MIDSCALE = false, EXCH = false;
    bf16_t* O; int ldc;
    __device__ __forceinline__ void operator()(const f32x4 (&acc)[2][2][4][2], const Unit& u, int wr, int wc, int fr, int fq) const {
        const int row0 = u.pm * BM + wr * 64 + fr; const int col0 = u.pn * BM + wc * 32 + 8 * fq;
#pragma unroll
        for (int ai = 0; ai < 2; ++ai)
#pragma unroll
            for (int m = 0; m < 4; ++m) { bf16_t* rowp = O + (size_t)(row0 + ai * HALF + m * 16) * ldc + col0;
#pragma unroll
                for (int bj = 0; bj < 2; ++bj) { const f32x4 v0 = acc[ai][bj][m][0], v1 = acc[ai][bj][m][1];
                    u32x4 w; w.x = cvt_pk_bf16(v0[0], v0[1]); w.y = cvt_pk_bf16(v0[2], v0[3]); w.z = cvt_pk_bf16(v1[0], v1[1]); w.w = cvt_pk_bf16(v1[2], v1[3]);
                    *(u32x4*)(rowp + bj * HALF) = w; } }
    }
};

typedef unsigned u32x2v __attribute__((__vector_size__(2 * sizeof(unsigned))));
struct EpiInProj {
    static constexpr bool PERM = false, AFTER_DRAIN = false, MIDSCALE = false, EXCH = false;
    bf16_t* P; unsigned char* Q8; unsigned char* K8; unsigned char* V8T;
    const float* qg; const float* kg; const PG8_LAS float* rc; const PG8_LAS float* rs; float c2;
    __device__ __forceinline__ void operator()(const f32x4 (&acc)[2][2][4][2], const Unit& u, int wr, int wc, int fr, int fq) const {
        const int pn = u.pn;
        const bool nq = pn < 2, nk = (pn == 2 && wc < 2), normed = nq || nk;
        const float sc = (nq || pn == 3 || pn == 4) ? c2 : 1.0f;
        const float* g = nq ? qg : kg;
        f32x4 gv[2][2];
#pragma unroll
        for (int bj = 0; bj < 2; ++bj)
#pragma unroll
            for (int n = 0; n < 2; ++n) gv[bj][n] = normed ? *(const f32x4*)(g + 32 * bj + 16 * n + 4 * fq) : (f32x4){1.f, 1.f, 1.f, 1.f};
        const int colb = pn * BM + 64 * wc + 4 * fq;
#pragma unroll
        for (int ai = 0; ai < 2; ++ai)
#pragma unroll
            for (int m = 0; m < 4; ++m) {
                const int row = u.pm * BM + ai * HALF + wr * 64 + m * 16 + fr;
                f32x4 v[2][2];
#pragma unroll
                for (int bj = 0; bj < 2; ++bj)
#pragma unroll
                    for (int n = 0; n < 2; ++n) v[bj][n] = acc[ai][bj][m][n];
                if (normed) {
                    float ss = 0.f;
#pragma unroll
                    for (int bj = 0; bj < 2; ++bj)
#pragma unroll
                        for (int n = 0; n < 2; ++n) { const f32x4 x = v[bj][n]; ss += (x[0] * x[0] + x[1] * x[1]) + (x[2] * x[2] + x[3] * x[3]); }
                    ss += __shfl_xor(ss, 16); ss += __shfl_xor(ss, 32);
                    const float rinv = 1.0f / sqrtf(ss * (1.0f / 64.0f) + 1e-6f);
                    const int t = row & 8191, prow = t >> 6, pcol = t & 63;
#pragma unroll
                    for (int bj = 0; bj < 2; ++bj) {
                        const int pos = bj ? pcol : prow;
                        const f32x4 c4 = *(const PG8_LAS f32x4*)(rc + pos * 16 + 4 * fq), s4 = *(const PG8_LAS f32x4*)(rs + pos * 16 + 4 * fq);
                        const f32x4 x1 = v[bj][0] * rinv * gv[bj][0], x2 = v[bj][1] * rinv * gv[bj][1];
                        v[bj][0] = x1 * c4 - x2 * s4; v[bj][1] = x1 * s4 + x2 * c4;
                    }
                }
                const int coff = (fq & 1) ? 12 + 4 * fq : 4 * fq;
                if (pn > 2) {
                    bf16_t* rowp = P + (size_t)row * 2304 + pn * BM + 64 * wc + coff;
#pragma unroll
                    for (int bj = 0; bj < 2; ++bj) { const f32x4 x = v[bj][0] * sc, y = v[bj][1] * sc;
                        const u32x2v s0 = __builtin_amdgcn_permlane16_swap(cvt_pk_bf16(x[0], x[1]), cvt_pk_bf16(y[0], y[1]), false, false), s1 = __builtin_amdgcn_permlane16_swap(cvt_pk_bf16(x[2], x[3]), cvt_pk_bf16(y[2], y[3]), false, false);
                        u32x4 w; w.x = s0[0]; w.y = s1[0]; w.z = s0[1]; w.w = s1[1]; *(u32x4*)(rowp + 32 * bj) = w; }
                } else {
                    const float fs = nq ? sc * 4.0f : (nk ? 0.25f : 8.0f);
                    if (nq || nk) {
#pragma unroll
                        for (int bj = 0; bj < 2; ++bj) { const f32x4 x = v[bj][0] * fs, y = v[bj][1] * fs;
                            unsigned w0 = (unsigned)__builtin_amdgcn_cvt_pk_fp8_f32(x[0], x[1], 0, false); w0 = (unsigned)__builtin_amdgcn_cvt_pk_fp8_f32(x[2], x[3], (int)w0, true);
                            unsigned w1 = (unsigned)__builtin_amdgcn_cvt_pk_fp8_f32(y[0], y[1], 0, false); w1 = (unsigned)__builtin_amdgcn_cvt_pk_fp8_f32(y[2], y[3], (int)w1, true);
                            const u32x2v s0 = __builtin_amdgcn_permlane16_swap(w0, w1, false, false); u32x2 w; w.x = s0[0]; w.y = s0[1];
                            if (nq) *(u32x2*)(Q8 + (size_t)row * 512 + pn * 256 + 64 * wc + 32 * bj + coff) = w;
                            else    *(u32x2*)(K8 + (size_t)row * 128 + 64 * wc + 32 * bj + coff) = w; }
                    } else
#pragma unroll
                    for (int bj = 0; bj < 2; ++bj)
#pragma unroll
                        for (int n = 0; n < 2; ++n) { const f32x4 x = v[bj][n] * fs;
                            unsigned w = (unsigned)__builtin_amdgcn_cvt_pk_fp8_f32(x[0], x[1], 0, false); w = (unsigned)__builtin_amdgcn_cvt_pk_fp8_f32(x[2], x[3], (int)w, true);
                            const int d = 32 * bj + 16 * n + 4 * fq;
                            { const int t = row & 8191, kap = t & 63; const int kp = 32 * ((kap >> 2) & 1) + 16 * (kap >> 5) + (kap & 3) + 4 * ((kap & 31) >> 3);
                                unsigned char* vp = V8T + ((size_t)(((row >> 13) * 2 + (wc - 2)) * 64 + d)) * 8192 + (t & ~63) + kp;
                                vp[0] = (unsigned char)(w & 0xffu); vp[8192] = (unsigned char)((w >> 8) & 0xffu); vp[2 * 8192] = (unsigned char)((w >> 16) & 0xffu); vp[3 * 8192] = (unsigned char)(w >> 24); } }
                }
            }
    }
};

struct EpiX1 {
    static constexpr bool PERM = true, AFTER_DRAIN = false, MIDSCALE = true, EXCH = false;
    const float* x; bf16_t* out; const float* mod;
    const float* ssa; const float* ssb;
    PG8_LAS float* rsl;
    template <class Sched> __device__ __forceinline__ void prep(const Sched& S) const {
        Unit u;
        for (int i = 0; S.next(i, u); ++i) {
            if (threadIdx.x < 256) { const size_t r = (size_t)(u.pm * BM + threadIdx.x) * 8;
                const f32x4 a0 = *(const f32x4*)(ssa + r), a1 = *(const f32x4*)(ssa + r + 4), b0 = *(const f32x4*)(ssb + r), b1 = *(const f32x4*)(ssb + r + 4);
                const float sa = ((a0[0] + a0[1]) + (a0[2] + a0[3])) + ((a1[0] + a1[1]) + (a1[2] + a1[3])), sb = ((b0[0] + b0[1]) + (b0[2] + b0[3])) + ((b1[0] + b1[1]) + (b1[2] + b1[3]));
                const float ra = 1.0f / sqrtf(sa * (1.0f / 512.0f) + 1e-6f), rb = 1.0f / sqrtf(sb * (1.0f / 512.0f) + 1e-6f);
                rsl[(i * 256 + threadIdx.x) * 2] = ra / rb; rsl[(i * 256 + threadIdx.x) * 2 + 1] = rb; }
        }
        __syncthreads();
    }
    __device__ __forceinline__ void mid_scale(f32x4 (&acc)[2][2][4][2], int ui, int wr, int fr) const {
#pragma unroll
        for (int ai = 0; ai < 2; ++ai)
#pragma unroll
            for (int m = 0; m < 4; ++m) { const float sc = rsl[(ui * 256 + ai * HALF + wr * 64 + m * 16 + fr) * 2];
#pragma unroll
                for (int bj = 0; bj < 2; ++bj)
#pragma unroll
                    for (int n = 0; n < 2; ++n) acc[ai][bj][m][n] = acc[ai][bj][m][n] * sc; }
    }
    __device__ __forceinline__ void operator()(const f32x4 (&acc)[2][2][4][2], const Unit& u, int wr, int wc, int fr, int fq, int ui) const {
        const int col0 = u.pn * BM + wc * 32 + 8 * fq;
        const int b = (u.pm * BM) >> 13;
        f32x4 gt[2][2];
#pragma unroll
        for (int bj = 0; bj < 2; ++bj)
#pragma unroll
            for (int n = 0; n < 2; ++n) gt[bj][n] = *(const f32x4*)(mod + b * 6144 + 2048 + col0 + bj * HALF + 4 * n);
#pragma unroll
        for (int ai = 0; ai < 2; ++ai) {
            f32x4 xv[4][2][2];
#pragma unroll
            for (int m = 0; m < 4; ++m) { const size_t off = (size_t)(u.pm * BM + ai * HALF + wr * 64 + m * 16 + fr) * 1024 + col0;
#pragma unroll
                for (int bj = 0; bj < 2; ++bj)
#pragma unroll
                    for (int n = 0; n < 2; ++n) xv[m][bj][n] = *(const f32x4*)(x + off + bj * HALF + 4 * n); }
#pragma unroll
            for (int m = 0; m < 4; ++m) { const size_t off = (size_t)(u.pm * BM + ai * HALF + wr * 64 + m * 16 + fr) * 1024 + col0;
                const float fin = rsl[(ui * 256 + ai * HALF + wr * 64 + m * 16 + fr) * 2 + 1];
#pragma unroll
                for (int bj = 0; bj < 2; ++bj) { const f32x4 y0 = xv[m][bj][0] + gt[bj][0] * (acc[ai][bj][m][0] * fin), y1 = xv[m][bj][1] + gt[bj][1] * (acc[ai][bj][m][1] * fin);
                    u32x4 w; w.x = cvt_pk_bf16(y0[0], y0[1]); w.y = cvt_pk_bf16(y0[2], y0[3]); w.z = cvt_pk_bf16(y1[0], y1[1]); w.w = cvt_pk_bf16(y1[2], y1[3]);
                    *(u32x4*)(out + off + bj * HALF) = w; } }
        }
    }
};

struct EpiX1N {
    static constexpr bool PERM = true, AFTER_DRAIN = false, MIDSCALE = true, EXCH = true;
    const float* x; bf16_t* out; bf16_t* h2; const float* mod; const float* n2g;
    const float* ssa; const float* ssb;
    PG8_LAS float* rsl;
    unsigned* xs; unsigned* cnt;
    template <class Sched> __device__ __forceinline__ void prep(const Sched& S) const {
        Unit u;
        for (int i = 0; S.next(i, u); ++i) {
            if (threadIdx.x < 256) { const size_t r = (size_t)(u.pm * BM + threadIdx.x) * 8;
                const f32x4 a0 = *(const f32x4*)(ssa + r), a1 = *(const f32x4*)(ssa + r + 4), b0 = *(const f32x4*)(ssb + r), b1 = *(const f32x4*)(ssb + r + 4);
                const float sa = ((a0[0] + a0[1]) + (a0[2] + a0[3])) + ((a1[0] + a1[1]) + (a1[2] + a1[3])), sb = ((b0[0] + b0[1]) + (b0[2] + b0[3])) + ((b1[0] + b1[1]) + (b1[2] + b1[3]));
                const float ra = 1.0f / sqrtf(sa * (1.0f / 512.0f) + 1e-6f), rb = 1.0f / sqrtf(sb * (1.0f / 512.0f) + 1e-6f);
                rsl[(i * 256 + threadIdx.x) * 2] = ra / rb; rsl[(i * 256 + threadIdx.x) * 2 + 1] = rb; }
        }
        __syncthreads();
    }
    __device__ __forceinline__ void mid_scale(f32x4 (&acc)[2][2][4][2], int ui, int wr, int fr) const {
#pragma unroll
        for (int ai = 0; ai < 2; ++ai)
#pragma unroll
            for (int m = 0; m < 4; ++m) { const float sc = rsl[(ui * 256 + ai * HALF + wr * 64 + m * 16 + fr) * 2];
#pragma unroll
                for (int bj = 0; bj < 2; ++bj)
#pragma unroll
                    for (int n = 0; n < 2; ++n) acc[ai][bj][m][n] = acc[ai][bj][m][n] * sc; }
    }
    __device__ __forceinline__ void operator()(f32x4 (&acc)[2][2][4][2], const Unit& u, int wr, int wc, int fr, int fq, int ui, int wid, int lane) const {
        unsigned lb = (unsigned)(size_t)rsl; asm volatile("" : "+s"(lb));
        PG8_LAS float* R = (PG8_LAS float*)lb; PG8_LAS float* P = R + 1024; PG8_LAS float* S = R + 2048;
        int r0 = wr * 64 + fr; asm volatile("" : "+v"(r0));
        const int col0 = u.pn * BM + wc * 32 + 8 * fq;
        const int b = (u.pm * BM) >> 13;
        {
            f32x4 gt[2][2];
#pragma unroll
            for (int bj = 0; bj < 2; ++bj)
#pragma unroll
                for (int n = 0; n < 2; ++n) gt[bj][n] = *(const f32x4*)(mod + b * 6144 + 2048 + col0 + bj * HALF + 4 * n);
#pragma unroll
            for (int ai = 0; ai < 2; ++ai) {
                f32x4 xv[4][2][2];
#pragma unroll
                for (int m = 0; m < 4; ++m) { const size_t off = (size_t)(u.pm * BM + ai * HALF + m * 16 + r0) * 1024 + col0;
#pragma unroll
                    for (int bj = 0; bj < 2; ++bj)
#pragma unroll
                        for (int n = 0; n < 2; ++n) xv[m][bj][n] = *(const f32x4*)(x + off + bj * HALF + 4 * n); }
#pragma unroll
                for (int m = 0; m < 4; ++m) { const int r = ai * HALF + m * 16 + r0;
                    const float fin = R[(ui * 256 + r) * 2 + 1]; float s = 0.f;
#pragma unroll
                    for (int bj = 0; bj < 2; ++bj)
#pragma unroll
                        for (int n = 0; n < 2; ++n) { const f32x4 y = xv[m][bj][n] + gt[bj][n] * (acc[ai][bj][m][n] * fin); acc[ai][bj][m][n] = y; s += (y[0] * y[0] + y[1] * y[1]) + (y[2] * y[2] + y[3] * y[3]); }
                    s += __shfl_xor(s, 16); s += __shfl_xor(s, 32);
                    if (fq == 0) P[r * 4 + wc] = s; }
            }
        }
        asm volatile("s_waitcnt lgkmcnt(0)" ::: "memory"); __builtin_amdgcn_s_barrier(); asm volatile("" ::: "memory");
        int row = wid * 32 + (lane & 31); asm volatile("" : "+v"(row));
        if (lane < 32) { const f32x4 p = *(const PG8_LAS f32x4*)(P + row * 4);
            __hip_atomic_store(xs + (size_t)(u.pm * BM + row) * 4 + u.pn, __builtin_bit_cast(unsigned, (p[0] + p[1]) + (p[2] + p[3])), __ATOMIC_RELAXED, __HIP_MEMORY_SCOPE_AGENT); }
        asm volatile("s_waitcnt vmcnt(0)" ::: "memory");
        if (lane == 0) __hip_atomic_fetch_add(cnt + 64 * u.pm, 1u, __ATOMIC_RELAXED, __HIP_MEMORY_SCOPE_AGENT);
        if (wid == 0) {
            unsigned sp = 0u;
            while ((unsigned)__builtin_amdgcn_readfirstlane(__hip_atomic_load(cnt + 64 * u.pm, __ATOMIC_RELAXED, __HIP_MEMORY_SCOPE_AGENT)) < 32u) { __builtin_amdgcn_s_sleep(1); if (++sp > (1u << 22)) break; }
            __builtin_amdgcn_fence(__ATOMIC_ACQUIRE, "agent");
        }
        asm volatile("s_waitcnt vmcnt(0) lgkmcnt(0)" ::: "memory"); __builtin_amdgcn_s_barrier(); asm volatile("" ::: "memory");
        if (lane < 32) { const unsigned* sl = xs + (size_t)(u.pm * BM + row) * 4; float t = 0.f;
#pragma unroll
            for (int k = 0; k < 4; ++k) t += __builtin_bit_cast(float, __hip_atomic_load(sl + k, __ATOMIC_RELAXED, __HIP_MEMORY_SCOPE_AGENT));
            S[row] = 1.0f / sqrtf(t * (1.0f / 1024.0f) + 1e-6f); }
        asm volatile("s_waitcnt lgkmcnt(0)" ::: "memory"); __builtin_amdgcn_s_barrier(); asm volatile("" ::: "memory");
        f32x4 wv[2][2], sv[2][2];
#pragma unroll
        for (int bj = 0; bj < 2; ++bj)
#pragma unroll
            for (int n = 0; n < 2; ++n) { const int c = col0 + bj * HALF + 4 * n;
                wv[bj][n] = *(const f32x4*)(n2g + c) * (*(const f32x4*)(mod + b * 6144 + 4096 + c) + 1.0f); sv[bj][n] = *(const f32x4*)(mod + b * 6144 + 3072 + c); }
#pragma unroll
        for (int ai = 0; ai < 2; ++ai)
#pragma unroll
            for (int m = 0; m < 4; ++m) { const int r = ai * HALF + m * 16 + r0; const size_t off = (size_t)(u.pm * BM + r) * 1024 + col0; const float ri = S[r];
#pragma unroll
                for (int bj = 0; bj < 2; ++bj) { const f32x4 y0 = acc[ai][bj][m][0], y1 = acc[ai][bj][m][1];
                    u32x4 w; w.x = cvt_pk_bf16(y0[0], y0[1]); w.y = cvt_pk_bf16(y0[2], y0[3]); w.z = cvt_pk_bf16(y1[0], y1[1]); w.w = cvt_pk_bf16(y1[2], y1[3]);
                    *(u32x4*)(out + off + bj * HALF) = w;
                    const f32x4 h0 = (y0 * ri) * wv[bj][0] + sv[bj][0], h1 = (y1 * ri) * wv[bj][1] + sv[bj][1];
                    u32x4 g; g.x = cvt_pk_bf16(h0[0], h0[1]); g.y = cvt_pk_bf16(h0[2], h0[3]); g.z = cvt_pk_bf16(h1[0], h1[1]); g.w = cvt_pk_bf16(h1[2], h1[3]);
                    *(u32x4*)(h2 + off + bj * HALF) = g; } }
    }
};


template <class Epi, class Sched, bool ALIGN_EPI = false, bool SP2 = false>
__device__ __forceinline__ void gemm_phase(PG8_LAS unsigned char* lds, const Gemm g, const Sched& S, const Epi& E) {
    const int tid = threadIdx.x, wid = __builtin_amdgcn_readfirstlane(tid >> 6), lane = tid & 63, wr = wid >> 2, wc = wid & 3, fr = lane & 15, fq = lane >> 4;
    const int K = g.K, nt = K / BK;
    unsigned voffA[2], voffB[2];
#pragma unroll
    for (int i = 0; i < 2; ++i) { int R, C; stage_rc(tid * 16 + i * 8192, R, C); const int Rb = Epi::PERM ? ((R & ~31) + perm32(R & 31)) : R;
        voffA[i] = (unsigned)(R * K + C) * 2u; voffB[i] = (unsigned)(Rb * K + C) * 2u; }
    const size_t kstep = (size_t)(BK * 2);
    const size_t hstep = (size_t)HALF * K * 2;
    const size_t tstep = 2 * hstep;
    const unsigned ldsw = (unsigned)wid * 1024u;
    const int aoff = lds_byte(wr * 64 + fr, fq * 8), boff = lds_byte(wc * 32 + fr, fq * 8);
#define PG8_SA(b, h) (((b) * 2 + (h)) * HTB)
#define PG8_SB(b, h) ((4 + (b) * 2 + (h)) * HTB)
#define PG8_STAGE(bufoff, gbase, voff) do { _Pragma("unroll") for (int _i = 0; _i < 2; ++_i) \
        __builtin_amdgcn_global_load_lds((const unsigned*)((const char*)(gbase) + (voff)[_i]), (PG8_LAS unsigned*)(lds + (bufoff) + ldsw + _i * 8192), 16, 0, 0); } while (0)
#define PG8_LDA(dst, b, h) do { _Pragma("unroll") for (int m = 0; m < 4; ++m) _Pragma("unroll") for (int k = 0; k < 2; ++k) dst[m][k] = *(const PG8_LAS bf16x8*)(lds + PG8_SA(b, h) + aoff + m * 2048 + k * 1024); } while (0)
#define PG8_LDB(dst, b, h) do { _Pragma("unroll") for (int n = 0; n < 2; ++n) _Pragma("unroll") for (int k = 0; k < 2; ++k) dst[n][k] = *(const PG8_LAS bf16x8*)(lds + PG8_SB(b, h) + boff + n * 2048 + k * 1024); } while (0)
#define PG8_MMA(ai, bj, At, Bt) do { __builtin_amdgcn_s_setprio(1); _Pragma("unroll") for (int m = 0; m < 4; ++m) _Pragma("unroll") for (int n = 0; n < 2; ++n) _Pragma("unroll") for (int k = 0; k < 2; ++k) \
        acc[ai][bj][m][n] = __builtin_amdgcn_mfma_f32_16x16x32_bf16(Bt[n][k], At[m][k], acc[ai][bj][m][n], 0, 0, 0); __builtin_amdgcn_s_setprio(0); } while (0)
#define PG8_WAIT_V(n) asm volatile("s_waitcnt vmcnt(" #n ")" ::: "memory")
#define PG8_WAIT_L(n) asm volatile("s_waitcnt lgkmcnt(" #n ")" ::: "memory")
#define PG8_BAR __builtin_amdgcn_s_barrier()
#define PG8_SCHED __builtin_amdgcn_sched_barrier(0)
    Unit cur, nxt; int ui = 0;
    if (!S.next(0, cur)) return;
    f32x4 acc[2][2][4][2];
#pragma unroll
    for (int a = 0; a < 2; ++a)
#pragma unroll
        for (int b = 0; b < 2; ++b)
#pragma unroll
            for (int m = 0; m < 4; ++m)
#pragma unroll
                for (int n = 0; n < 2; ++n) acc[a][b][m][n] = (f32x4){0.f, 0.f, 0.f, 0.f};
    bf16x8 At[4][2], B0[2][2], B1[2][2];
    const char* cA = (const char*)g.A + (size_t)cur.pm * tstep; const char* cB = (const char*)g.Bt + (size_t)cur.pn * tstep;
    S.a_ready(cur);
    if constexpr (SP2) {
        PG8_STAGE(PG8_SB(0, 0), cB, voffB); PG8_STAGE(PG8_SB(0, 1), cB + hstep, voffB); PG8_STAGE(PG8_SA(0, 0), cA, voffA); PG8_STAGE(PG8_SA(0, 1), cA + hstep, voffA);
        if (wr == 1) PG8_BAR;
        PG8_WAIT_V(2); PG8_BAR;
        PG8_STAGE(PG8_SB(1, 0), cB + kstep, voffB); PG8_STAGE(PG8_SA(1, 0), cA + kstep, voffA); PG8_STAGE(PG8_SB(1, 1), cB + hstep + kstep, voffB);
        PG8_WAIT_V(6); PG8_BAR;
    } else {
        PG8_STAGE(PG8_SB(0, 0), cB, voffB); PG8_STAGE(PG8_SA(0, 0), cA, voffA); PG8_STAGE(PG8_SB(0, 1), cB + hstep, voffB); PG8_STAGE(PG8_SA(0, 1), cA + hstep, voffA);
        if (wr == 1) PG8_BAR;
        PG8_WAIT_V(4); PG8_BAR;
        PG8_STAGE(PG8_SB(1, 0), cB + kstep, voffB); PG8_STAGE(PG8_SA(1, 0), cA + kstep, voffA); PG8_STAGE(PG8_SB(1, 1), cB + hstep + kstep, voffB);
        PG8_WAIT_V(6); PG8_BAR;
    }
    for (;;) {
        const bool has_next = S.next(ui + 1, nxt);
        const char* nA = has_next ? (const char*)g.A + (size_t)nxt.pm * tstep : cA; const char* nB = has_next ? (const char*)g.Bt + (size_t)nxt.pn * tstep : cB;
        for (int t = 0; t < nt; t += 2) {
            if constexpr (Epi::MIDSCALE) { if (t == nt / 2) E.mid_scale(acc, ui, wr, fr); }
            const bool last = (t == nt - 2);
            const char* a1 = cA + (size_t)(t + 1) * kstep;
            const char* a2 = last ? nA : cA + (size_t)(t + 2) * kstep; const char* b2 = last ? nB : cB + (size_t)(t + 2) * kstep;
            const char* a3 = a2 + kstep; const char* b3 = b2 + kstep;
            if (last && has_next) S.a_ready(nxt);
            if constexpr (SP2) {
            PG8_LDB(B0, 0, 0); PG8_LDB(B1, 0, 1); PG8_SCHED; PG8_LDA(At, 0, 0); PG8_STAGE(PG8_SA(1, 1), a1 + hstep, voffA);
            PG8_WAIT_V(8); PG8_WAIT_L(0); PG8_BAR; PG8_MMA(0, 0, At, B0); PG8_MMA(0, 1, At, B1); PG8_BAR; PG8_SCHED;
            PG8_LDA(At, 0, 1); PG8_STAGE(PG8_SB(0, 0), b2, voffB); PG8_STAGE(PG8_SB(0, 1), b2 + hstep, voffB); PG8_STAGE(PG8_SA(0, 0), a2, voffA);
            PG8_WAIT_V(8); PG8_WAIT_L(0); PG8_BAR; PG8_MMA(1, 0, At, B0); PG8_MMA(1, 1, At, B1); PG8_BAR; PG8_SCHED;
            PG8_LDB(B0, 1, 0); PG8_LDB(B1, 1, 1); PG8_SCHED; PG8_LDA(At, 1, 0); PG8_STAGE(PG8_SA(0, 1), a2 + hstep, voffA);
            PG8_WAIT_V(8); PG8_WAIT_L(0); PG8_BAR; PG8_MMA(0, 0, At, B0); PG8_MMA(0, 1, At, B1); PG8_BAR; PG8_SCHED;
            PG8_LDA(At, 1, 1); PG8_STAGE(PG8_SB(1, 0), b3, voffB); PG8_STAGE(PG8_SB(1, 1), b3 + hstep, voffB); PG8_STAGE(PG8_SA(1, 0), a3, voffA);
            PG8_WAIT_V(8); PG8_WAIT_L(0); PG8_BAR; PG8_MMA(1, 0, At, B0); PG8_MMA(1, 1, At, B1); PG8_BAR; PG8_SCHED;
            } else {
            PG8_LDB(B0, 0, 0); PG8_SCHED; PG8_LDA(At, 0, 0); PG8_STAGE(PG8_SA(1, 1), a1 + hstep, voffA);
            PG8_WAIT_L(8); PG8_BAR; PG8_WAIT_L(0); PG8_MMA(0, 0, At, B0); PG8_BAR; PG8_SCHED;
            PG8_LDB(B1, 0, 1); PG8_STAGE(PG8_SB(0, 0), b2, voffB);
            PG8_BAR; PG8_WAIT_L(0); PG8_MMA(0, 1, At, B1); PG8_BAR;
            PG8_LDA(At, 0, 1); PG8_STAGE(PG8_SA(0, 0), a2, voffA);
            PG8_BAR; PG8_WAIT_L(0); PG8_MMA(1, 0, At, B0); PG8_BAR; PG8_SCHED;
            PG8_STAGE(PG8_SB(0, 1), b2 + hstep, voffB);
            PG8_WAIT_V(6); PG8_BAR; PG8_MMA(1, 1, At, B1); PG8_BAR;
            PG8_LDB(B0, 1, 0); PG8_SCHED; PG8_LDA(At, 1, 0); PG8_STAGE(PG8_SA(0, 1), a2 + hstep, voffA);
            PG8_WAIT_L(8); PG8_BAR; PG8_WAIT_L(0); PG8_MMA(0, 0, At, B0); PG8_BAR; PG8_SCHED;
            PG8_LDB(B1, 1, 1); PG8_STAGE(PG8_SB(1, 0), b3, voffB);
            PG8_BAR; PG8_WAIT_L(0); PG8_MMA(0, 1, At, B1); PG8_BAR;
            PG8_LDA(At, 1, 1); PG8_STAGE(PG8_SA(1, 0), a3, voffA);
            PG8_BAR; PG8_WAIT_L(0); PG8_MMA(1, 0, At, B0); PG8_BAR; PG8_SCHED;
            PG8_STAGE(PG8_SB(1, 1), b3 + hstep, voffB);
            PG8_WAIT_V(6); PG8_BAR; PG8_MMA(1, 1, At, B1); PG8_BAR;
            }
        }
        if constexpr (ALIGN_EPI) { if (wr == 0) PG8_BAR; }
        if constexpr (!Epi::AFTER_DRAIN) { if constexpr (Epi::EXCH) E(acc, cur, wr, wc, fr, fq, ui, wid, lane); else if constexpr (Epi::MIDSCALE) E(acc, cur, wr, wc, fr, fq, ui); else E(acc, cur, wr, wc, fr, fq); S.done(cur); }
        if (!has_next) break;
#pragma unroll
        for (int a = 0; a < 2; ++a)
#pragma unroll
            for (int b = 0; b < 2; ++b)
#pragma unroll
                for (int m = 0; m < 4; ++m)
#pragma unroll
                    for (int n = 0; n < 2; ++n) acc[a][b][m][n] = (f32x4){0.f, 0.f, 0.f, 0.f};
        cur = nxt; cA = nA; cB = nB; ++ui;
        if constexpr (ALIGN_EPI) { if (wr == 1) PG8_BAR; }
    }
    PG8_WAIT_V(0);
    if constexpr (!ALIGN_EPI) { if (wr == 0) PG8_BAR; }
    PG8_BAR;
    if constexpr (Epi::AFTER_DRAIN) { E.fused(acc, cur, wr, wc, fr, fq, lds, wid, lane); S.done(cur); }
#undef PG8_SA
#undef PG8_SB
#undef PG8_STAGE
#undef PG8_LDA
#undef PG8_LDB
#undef PG8_MMA
#undef PG8_WAIT_V
#undef PG8_WAIT_L
#undef PG8_BAR
#undef PG8_SCHED
}
}

namespace attn_body {
using bf16=__hip_bfloat16;
using bf16x8=__attribute__((ext_vector_type(8)))short;
using s16x4=__attribute__((ext_vector_type(4)))short;
using f32x16=__attribute__((ext_vector_type(16)))float;
using u32x4=__attribute__((ext_vector_type(4)))unsigned;
constexpr int BATCH=4,NHEAD=8,NKV=2,SEQ=8192,D=64,PP=2304,OP=1024;
constexpr int NW=8,QBLK=32,QB=QBLK*NW,KVBLK=64,NQB=SEQ/QB;
constexpr int ATTN_UNIT_ROWS=QB;
__device__ __forceinline__ int crow(int r,int hi){return (r&3)+8*(r>>2)+4*hi;}
#define SBAR() __builtin_amdgcn_sched_barrier(0)
__device__ __forceinline__ void cmask(f32x16&p0,f32x16&p1,int jb,int qrel,int hi){
  const float NEG=-INFINITY; int kb=64*jb+4*hi;
  #pragma unroll
  for(int r=0;r<16;++r){int kv=kb+(r&3)+8*(r>>2); if(kv>qrel)p0[r]=NEG; if(kv+32>qrel)p1[r]=NEG;}
}

constexpr int NSLOT=3, SLOTB=8192;
constexpr int LDS_K=0, LDS_V=NSLOT*SLOTB, LDS_WS=2*NSLOT*SLOTB, LDS_OST=LDS_WS+NW*64*4, LDS_BYTES=LDS_OST+NW*4096;
constexpr float C2=0.125f*1.4426950408889634f;
__device__ __forceinline__ void glds16(const void*gsrc,unsigned lds_dst){unsigned keep;
  asm volatile("s_mov_b32 %0, m0\n\ts_mov_b32 m0, %2\n\ts_nop 0\n\tglobal_load_lds_dwordx4 %1, off\n\ts_mov_b32 m0, %0":"=&s"(keep):"v"(gsrc),"s"(lds_dst):"memory");}
__device__ __forceinline__ float max3f(float a,float b,float c){float r;asm("v_max3_f32 %0, %1, %2, %3":"=v"(r):"v"(a),"v"(b),"v"(c));return r;}
__device__ __forceinline__ float max2f(float a,float b){float r;asm("v_max_f32_e32 %0, %1, %2":"=v"(r):"v"(a),"v"(b));return r;}
__device__ __forceinline__ float fadd_s(float a,float b){float r;asm("v_add_f32_e32 %0, %1, %2":"=v"(r):"v"(a),"v"(b));return r;}
__device__ __forceinline__ float fsub_s(float a,float b){float r;asm("v_sub_f32_e32 %0, %1, %2":"=v"(r):"v"(a),"v"(b));return r;}
typedef float f32x2_t __attribute__((ext_vector_type(2))); typedef __bf16 bf16x2_t __attribute__((ext_vector_type(2)));
__device__ __forceinline__ unsigned cvtpk_s(float lo,float hi){f32x2_t v={lo,hi};bf16x2_t b=__builtin_convertvector(v,bf16x2_t);return __builtin_bit_cast(unsigned,b);}
#define WAIT_BAR(N) asm volatile("s_waitcnt vmcnt(" #N ") lgkmcnt(0)\n\ts_barrier":::"memory")

__device__ __forceinline__ void qkt(f32x16&p0,f32x16&p1,const char*Kslot,const bf16x8*qr,const f32x16&negm,int r32,int hi){
  const char*kb=Kslot+hi*1024+r32*16;
  #pragma unroll
  for(int d0=0;d0<4;++d0){
    const bf16x8 b0=*reinterpret_cast<const bf16x8*>(kb+d0*2048);
    const bf16x8 b1=*reinterpret_cast<const bf16x8*>(kb+d0*2048+512);
    if(d0==0){p0=__builtin_amdgcn_mfma_f32_32x32x16_bf16(b0,qr[0],negm,0,0,0);p1=__builtin_amdgcn_mfma_f32_32x32x16_bf16(b1,qr[0],negm,0,0,0);}
    else{p0=__builtin_amdgcn_mfma_f32_32x32x16_bf16(b0,qr[d0],p0,0,0,0);p1=__builtin_amdgcn_mfma_f32_32x32x16_bf16(b1,qr[d0],p1,0,0,0);}}
}
typedef __attribute__((address_space(3))) const char* lds_cptr;
typedef short v4i16_t __attribute__((ext_vector_type(4)));
__device__ __forceinline__ void kload8(bf16x8*kf,lds_cptr kp){
  kf[0]=*(const __attribute__((address_space(3))) bf16x8*)(kp);      kf[1]=*(const __attribute__((address_space(3))) bf16x8*)(kp+512);
  kf[2]=*(const __attribute__((address_space(3))) bf16x8*)(kp+2048); kf[3]=*(const __attribute__((address_space(3))) bf16x8*)(kp+2560);
  kf[4]=*(const __attribute__((address_space(3))) bf16x8*)(kp+4096); kf[5]=*(const __attribute__((address_space(3))) bf16x8*)(kp+4608);
  kf[6]=*(const __attribute__((address_space(3))) bf16x8*)(kp+6144); kf[7]=*(const __attribute__((address_space(3))) bf16x8*)(kp+6656);
}
__device__ __forceinline__ void kload2(bf16x8*kf,lds_cptr kp,int j){ kf[2*j]=*(const __attribute__((address_space(3))) bf16x8*)(kp+j*2048); kf[2*j+1]=*(const __attribute__((address_space(3))) bf16x8*)(kp+j*2048+512); }
__device__ __forceinline__ s16x4 vtr(lds_cptr p){ return __builtin_bit_cast(s16x4,__builtin_amdgcn_ds_read_tr16_b64_v4i16((__attribute__((address_space(3))) v4i16_t*)p)); }
__device__ __forceinline__ float rowmax(const f32x16&p0,const f32x16&p1){
  float a=max3f(p0[0],p0[1],p1[0]),b=max3f(p0[2],p0[3],p1[1]);a=max3f(a,p1[2],p1[3]);
  #pragma unroll
  for(int r=4;r<16;r+=4){a=max3f(a,p0[r],p0[r+1]);b=max3f(b,p0[r+2],p0[r+3]);a=max3f(a,p1[r],p1[r+1]);b=max3f(b,p1[r+2],p1[r+3]);}
  const float m=max2f(a,b);
  auto rr=__builtin_amdgcn_permlane32_swap(__float_as_uint(m),__float_as_uint(m),false,false);
  return max2f(__uint_as_float(rr[0]),__uint_as_float(rr[1]));
}
__device__ __forceinline__ void pv(f32x16*o,int vb,bf16x8 pa0,bf16x8 pa1,bf16x8 pa2,bf16x8 pa3){
  #pragma unroll
  for(int d0=0;d0<2;++d0){s16x4 lo[4],hi[4];
    #pragma unroll
    for(int ks=0;ks<4;++ks){
      asm volatile("ds_read_b64_tr_b16 %0,%1 offset:%c2":"=&v"(lo[ks]):"v"(vb),"i"(d0*4096+ks*1024):"memory");
      asm volatile("ds_read_b64_tr_b16 %0,%1 offset:%c2":"=&v"(hi[ks]):"v"(vb),"i"(d0*4096+ks*1024+512):"memory");}
    asm volatile("s_waitcnt lgkmcnt(0)":::"memory");SBAR();
    #define PK(k) (bf16x8){lo[k][0],lo[k][1],lo[k][2],lo[k][3],hi[k][0],hi[k][1],hi[k][2],hi[k][3]}
    o[d0]=__builtin_amdgcn_mfma_f32_32x32x16_bf16(pa0,PK(0),o[d0],0,0,0);
    o[d0]=__builtin_amdgcn_mfma_f32_32x32x16_bf16(pa1,PK(1),o[d0],0,0,0);
    o[d0]=__builtin_amdgcn_mfma_f32_32x32x16_bf16(pa2,PK(2),o[d0],0,0,0);
    o[d0]=__builtin_amdgcn_mfma_f32_32x32x16_bf16(pa3,PK(3),o[d0],0,0,0);
    #undef PK
  }
}

#ifndef ATTN_STORE16
#define ATTN_STORE16(p,v) (*(u32x4*)(p)=(v))
#endif
template<int THRL> __device__ __forceinline__ void attn_unit(float cb,int b,int h,int kvh,int qb,const bf16*Q,const bf16*__restrict__ K,const bf16*__restrict__ V,bf16*O,float*SS,char*shm){
  const int tid=threadIdx.x,lane=tid&63,r32=lane&31,hi=lane>>5; const int wid=__builtin_amdgcn_readfirstlane(tid>>6);
  const long rowbase=(long)b*SEQ; const int q0=qb*QB;
  const bf16*Qw=Q+(rowbase+q0+wid*QBLK)*PP+h*D;
  const bf16*Kh=K+rowbase*PP+kvh*D,*Vh=V+rowbase*PP+kvh*D;
  const unsigned lds0=(unsigned)(uintptr_t)shm;
  float*wsf=(float*)(shm+LDS_WS)+wid*64;
  const bf16*ksrc=Kh+(long)lane*PP+wid*8;
  const bf16*vsrc=Vh+(long)(16*(wid&3)+(lane>>2))*PP+(wid>>2)*32+(lane&3)*8;
  const unsigned kdst=lds0+LDS_K+wid*1024, vdst=lds0+LDS_V+wid*1024;
  #define DMA_K(t,slot) glds16(ksrc+(long)(t)*KVBLK*PP,(unsigned)__builtin_amdgcn_readfirstlane(kdst+(slot)))
  #define DMA_V(t,slot) glds16(vsrc+(long)(t)*KVBLK*PP,(unsigned)__builtin_amdgcn_readfirstlane(vdst+(slot)))
  const int vb0=(int)(lds0+LDS_V)+((lane>>4)&1)*32+(lane&3)*8+(4*hi+((lane&15)>>2))*64;
  const char*Kbase=shm+LDS_K; bf16x8 kf[8];
  const lds_cptr shm3=(lds_cptr)shm; const lds_cptr kp0=shm3+LDS_K+hi*1024+r32*16; const lds_cptr vp0=shm3+LDS_V+((lane>>4)&1)*32+(lane&3)*8+(4*hi+((lane&15)>>2))*64;
  const int NT=SEQ/KVBLK;
  DMA_K(0,0);DMA_V(0,0);DMA_K(1,SLOTB);
  bf16x8 qr[4];
  #pragma unroll
  for(int d0=0;d0<4;++d0)qr[d0]=*reinterpret_cast<const bf16x8*>(&Qw[(long)r32*PP+d0*16+hi*8]);
  float l_reg=0.f;f32x16 o[2];o[0]=f32x16{};o[1]=f32x16{};f32x16 negm;
  #pragma unroll
  for(int r=0;r<16;++r)negm[r]=-cb;
  asm volatile("":"+v"(negm));
  const int qrel=wid*QBLK+r32;
  #define CMASK(P0,P1,t) do{}while(0)
  #define START(P0,P1) do{ _Pragma("unroll") for(int r=0;r<16;++r)P0[r]=__builtin_amdgcn_exp2f(P0[r]); }while(0)
  #define RESC() do{}while(0)
  f32x16 pA0,pA1,pB0,pB1;
  int sl_prev=0,sl_cur=0,sl_next=SLOTB;
  #define ROT() do{sl_prev=sl_cur;sl_cur=sl_next;sl_next=(sl_next==(NSLOT-1)*SLOTB)?0:sl_next+SLOTB;}while(0)
  DMA_K(2,2*SLOTB);
  WAIT_BAR(3);
  qkt(pA0,pA1,Kbase,qr,negm,r32,hi);asm volatile("s_nop 15\n\ts_nop 7":"+v"(pA0),"+v"(pA1));CMASK(pA0,pA1,0);
  START(pA0,pA1);
  _Pragma("unroll") for(int r=0;r<16;++r)pA1[r]=__builtin_amdgcn_exp2f(pA1[r]);
  WAIT_BAR(0);
  DMA_K(3,0);DMA_V(1,SLOTB);
  ROT();
  kload8(kf,kp0+sl_cur);
  WAIT_BAR(2);
  s16x4 vlo[8],vhi[8]; u32x4 pw0,pw1,pw2,pw3;
  #define PKW(P,B) cvtpk_s(P[B],P[B+1])
  #define PAF(k) __builtin_bit_cast(bf16x8,pw##k)
  #define VFR(i) (bf16x8){vlo[i][0],vlo[i][1],vlo[i][2],vlo[i][3],vhi[i][0],vhi[i][1],vhi[i][2],vhi[i][3]}
  #define PIN(x) asm volatile("":"+v"(x))
  #define MX3(a,b,c) __builtin_fmaxf(__builtin_fmaxf((a),(b)),(c))
  #define GAPA(MF,A0,A1,A2,A3,W0,W1,PW) do{ MF; sacc+=A0; sacc+=A1; sacc+=A2; sacc+=A3; PIN(sacc); W0; W1; PIN(PW); SBAR(); }while(0)
  #define EX(v) __builtin_amdgcn_exp2f(v)
  #define GAPB(MF,X,B) do{ MF; X[B]=EX(X[B]); X[B+1]=EX(X[B+1]); X[B+2]=EX(X[B+2]); X[B+3]=EX(X[B+3]); PIN(X); SBAR(); }while(0)
  #define VRD(i) do{ vlo[i]=vtr(vp_+(((i)>>2)*4096+((i)&3)*1024)); vhi[i]=vtr(vp_+(((i)>>2)*4096+((i)&3)*1024+512)); }while(0)
  #define KRD(G,j) do{ if(G){ kload2(kf,kp0+sl_next,j); SBAR(); } }while(0)
  #define STEP(C0,C1,P0,P1,t,GK,GV,GL) do{ SBAR(); \
    const lds_cptr vp_=vp0+sl_prev; \
    VRD(0); SBAR(); float sacc=(P0[0]+P0[1]); \
    GAPA(C0=__builtin_amdgcn_mfma_f32_32x32x16_bf16(kf[0],qr[0],negm,0,0,0), P0[2],P0[3],P0[4],P0[5],     pw0[0]=PKW(P0,0), pw0[1]=PKW(P0,2), pw0); \
    VRD(4); SBAR(); GAPA(C1=__builtin_amdgcn_mfma_f32_32x32x16_bf16(kf[1],qr[0],negm,0,0,0), P0[6],P0[7],P0[8],P0[9],     pw0[2]=PKW(P0,4), pw0[3]=PKW(P0,6), pw0); \
    VRD(1); SBAR(); GAPA(C0=__builtin_amdgcn_mfma_f32_32x32x16_bf16(kf[2],qr[1],C0,0,0,0),   P0[10],P0[11],P0[12],P0[13], pw1[0]=PKW(P0,8), pw1[1]=PKW(P0,10), pw1); \
    VRD(5); SBAR(); GAPA(C1=__builtin_amdgcn_mfma_f32_32x32x16_bf16(kf[3],qr[1],C1,0,0,0),   P0[14],P0[15],P1[0],P1[1],   pw1[2]=PKW(P0,12),pw1[3]=PKW(P0,14), pw1); \
    VRD(2); SBAR(); GAPA(C0=__builtin_amdgcn_mfma_f32_32x32x16_bf16(kf[4],qr[2],C0,0,0,0),   P1[2],P1[3],P1[4],P1[5],     pw2[0]=PKW(P1,0), pw2[1]=PKW(P1,2), pw2); \
    VRD(6); SBAR(); GAPA(C1=__builtin_amdgcn_mfma_f32_32x32x16_bf16(kf[5],qr[2],C1,0,0,0),   P1[6],P1[7],P1[8],P1[9],     pw2[2]=PKW(P1,4), pw2[3]=PKW(P1,6), pw2); \
    VRD(3); SBAR(); GAPA(C0=__builtin_amdgcn_mfma_f32_32x32x16_bf16(kf[6],qr[3],C0,0,0,0),   P1[10],P1[11],P1[12],P1[13], pw3[0]=PKW(P1,8), pw3[1]=PKW(P1,10), pw3); \
    VRD(7); SBAR(); GAPA(C1=__builtin_amdgcn_mfma_f32_32x32x16_bf16(kf[7],qr[3],C1,0,0,0),   P1[14],P1[15],0.f,0.f,       pw3[2]=PKW(P1,12),pw3[3]=PKW(P1,14), pw3); \
    l_reg+=sacc; \
    if(GK){DMA_K((t)+3,sl_cur);} if(GV){DMA_V((t)+1,sl_next);} \
    CMASK(C0,C1,t); \
    SBAR(); \
    GAPB(o[0]=__builtin_amdgcn_mfma_f32_32x32x16_bf16(PAF(0),VFR(0),o[0],0,0,0), C0,0); \
    GAPB(o[1]=__builtin_amdgcn_mfma_f32_32x32x16_bf16(PAF(0),VFR(4),o[1],0,0,0), C0,4); \
    KRD(GL,0); GAPB(o[0]=__builtin_amdgcn_mfma_f32_32x32x16_bf16(PAF(1),VFR(1),o[0],0,0,0), C0,8); \
    KRD(GL,1); GAPB(o[1]=__builtin_amdgcn_mfma_f32_32x32x16_bf16(PAF(1),VFR(5),o[1],0,0,0), C0,12); \
    KRD(GL,2); GAPB(o[0]=__builtin_amdgcn_mfma_f32_32x32x16_bf16(PAF(2),VFR(2),o[0],0,0,0), C1,0); \
    KRD(GL,3); GAPB(o[1]=__builtin_amdgcn_mfma_f32_32x32x16_bf16(PAF(2),VFR(6),o[1],0,0,0), C1,4); \
    GAPB(o[0]=__builtin_amdgcn_mfma_f32_32x32x16_bf16(PAF(3),VFR(3),o[0],0,0,0), C1,8); \
    GAPB(o[1]=__builtin_amdgcn_mfma_f32_32x32x16_bf16(PAF(3),VFR(7),o[1],0,0,0), C1,12); \
    }while(0)
  int t=1;
  #undef CMASK
  #define CMASK(P0,P1,t) do{}while(0)
  for(;t+5<NT;t+=2){
    STEP(pB0,pB1,pA0,pA1,t,true,true,true);     WAIT_BAR(2); RESC(); ROT();
    STEP(pA0,pA1,pB0,pB1,t+1,true,true,true);   WAIT_BAR(2); RESC(); ROT();
  }
  #undef CMASK
  #define CMASK(P0,P1,t) do{}while(0)
  #define ENDW(tt) do{ if((tt)+3<NT){WAIT_BAR(2);} else if((tt)+2<NT){WAIT_BAR(1);} else {WAIT_BAR(0);} }while(0)
  for(;t+1<NT;t+=2){
    STEP(pB0,pB1,pA0,pA1,t,(t+3<NT),(t+1<NT),(t+1<NT));       ENDW(t);   RESC(); ROT();
    STEP(pA0,pA1,pB0,pB1,t+1,(t+4<NT),(t+2<NT),(t+2<NT));     ENDW(t+1); RESC(); ROT();
  }
  STEP(pB0,pB1,pA0,pA1,NT-1,false,false,false); RESC();
  { float sacc=pB0[0]+pB0[1]; _Pragma("unroll") for(int r=2;r<16;++r)sacc+=pB0[r]; _Pragma("unroll") for(int r=0;r<16;++r)sacc+=pB1[r]; l_reg+=sacc;
    pw0=(u32x4){PKW(pB0,0),PKW(pB0,2),PKW(pB0,4),PKW(pB0,6)};pw1=(u32x4){PKW(pB0,8),PKW(pB0,10),PKW(pB0,12),PKW(pB0,14)};pw2=(u32x4){PKW(pB1,0),PKW(pB1,2),PKW(pB1,4),PKW(pB1,6)};pw3=(u32x4){PKW(pB1,8),PKW(pB1,10),PKW(pB1,12),PKW(pB1,14)};
    SBAR(); pv(o,vb0+sl_cur,PAF(0),PAF(1),PAF(2),PAF(3)); }
  #undef PKW
  #undef PAF
  #undef VFR
  #undef PIN
  #undef MX3
  #undef GAPA
  #undef GAPB
  #undef EX
  #undef VRD
  #undef KRD
  #undef STEP
  #undef ENDW
  {auto rr=__builtin_amdgcn_permlane32_swap(__float_as_uint(l_reg),__float_as_uint(l_reg),false,false);l_reg=__uint_as_float(rr[0])+__uint_as_float(rr[1]);}
  if(hi==0)wsf[32+r32]=l_reg;asm volatile("s_waitcnt lgkmcnt(0)":::"memory");
  float rli[16];
  #pragma unroll
  for(int r=0;r<16;++r)rli[r]=__builtin_amdgcn_rcpf(wsf[32+crow(r,hi)]);
  bf16*Ow=O+(rowbase+q0+wid*QBLK)*OP+h*D;
  { bf16*stg=(bf16*)(shm+LDS_OST)+wid*2048;
    #pragma unroll
    for(int r=0;r<16;++r){const int orow=crow(r,hi);
      #pragma unroll
      for(int d0=0;d0<2;++d0)stg[orow*64+d0*32+r32]=__float2bfloat16(o[d0][r]*rli[r]);}
    asm volatile("s_waitcnt lgkmcnt(0)":::"memory");
    #pragma unroll
    for(int i=0;i<4;++i){const int row=i*8+(lane>>3),ch=lane&7; const u32x4 v=*(const u32x4*)(stg+row*64+ch*8); ATTN_STORE16(Ow+(long)row*OP+ch*8,v);
      float q=0.f; { const unsigned w4[4]={v.x,v.y,v.z,v.w};
        #pragma unroll
        for(int k=0;k<4;++k){const float a=__uint_as_float(w4[k]<<16),b2=__uint_as_float(w4[k]&0xffff0000u); q+=a*a+b2*b2;} }
      q+=__builtin_bit_cast(float,__builtin_amdgcn_update_dpp(0,__builtin_bit_cast(int,q),0xB1,0xF,0xF,true));
      q+=__builtin_bit_cast(float,__builtin_amdgcn_update_dpp(0,__builtin_bit_cast(int,q),0x4E,0xF,0xF,true));
      q+=__builtin_bit_cast(float,__builtin_amdgcn_update_dpp(0,__builtin_bit_cast(int,q),0x141,0xF,0xF,true));
      if(ch==0)SS[(rowbase+q0+wid*QBLK+row)*8+h]=q; } }
  asm volatile("s_waitcnt lgkmcnt(0)\n\ts_barrier":::"memory");
  #undef DMA_K
  #undef DMA_V
  #undef CMASK
  #undef START
  #undef RESC
  #undef ROT
}
constexpr int ATTN_LDS_BYTES=LDS_BYTES;
struct AttnTensors { const bf16* Q; const bf16* K; const bf16* V; bf16* O; float* SS; };
struct AttnUnit { int b, h, kvh, qb; };
struct StaticOrder {
  int vcu, G;
  __device__ __forceinline__ explicit StaticOrder(int grid,int block):vcu((grid%8==0)?(block%8)*(grid/8)+block/8:block),G(grid){}
  __device__ __forceinline__ bool next(int i,AttnUnit&u)const{ const int id=vcu+i*G; const int per=NQB*BATCH*NKV; if(id>=4*per)return false;
    const int hq=id/per, rem=id%per, bk=rem/NQB; u.qb=rem%NQB; u.b=bk/NKV; u.kvh=bk%NKV; u.h=u.kvh*4+hq; return true; }
  __device__ __forceinline__ void a_ready(const AttnUnit&)const{}
  __device__ __forceinline__ void done(const AttnUnit&)const{}
};
template<class Sched,int THRL=8> __device__ __forceinline__ void attn_phase(char*lds,const AttnTensors&T,const Sched&S,float cb){
  AttnUnit u;
  for(int i=0;S.next(i,u);++i){ S.a_ready(u); attn_unit<THRL>(cb,u.b,u.h,u.kvh,u.qb,T.Q,T.K,T.V,T.O,T.SS,lds); S.done(u); }
}
#undef SBAR
#undef WAIT_BAR
}

namespace attn8 {
typedef int v8i __attribute__((ext_vector_type(8)));
using f32x16 = __attribute__((ext_vector_type(16))) float;
using u32x4 = __attribute__((ext_vector_type(4))) unsigned;
typedef __attribute__((address_space(3))) const unsigned char* lds_cptr;
constexpr int SEQ = 8192, QB = 256, NQB = SEQ / QB, KVT = 64, NT = SEQ / KVT, OP = 1024;
constexpr int NSLOT = 8, SLOTB = 8192, LDS_OST = NSLOT * SLOTB, LDS_BYTES = LDS_OST + 8 * 4096;
__device__ __forceinline__ int crow(int r, int hi) { return (r & 3) + 8 * (r >> 2) + 4 * hi; }
__device__ __forceinline__ unsigned f2bf_rne(float f) { const unsigned u = __float_as_uint(f); return (u + 0x7fffu + ((u >> 16) & 1u)) >> 16; }
__host__ __device__ __forceinline__ int kpos(int kappa) { return 32 * ((kappa >> 2) & 1) + 16 * (kappa >> 5) + (kappa & 3) + 4 * ((kappa & 31) >> 3); }
__device__ __forceinline__ void glds16(const void* gsrc, unsigned lds_dst) { unsigned keep;
    asm volatile("s_mov_b32 %0, m0\n\ts_mov_b32 m0, %2\n\ts_nop 0\n\tglobal_load_lds_dwordx4 %1, off\n\ts_mov_b32 m0, %0" : "=&s"(keep) : "v"(gsrc), "s"(lds_dst) : "memory"); }
#define A8_MFMA(a, b, c) __builtin_amdgcn_mfma_scale_f32_32x32x64_f8f6f4(a, b, c, 0, 0, 0, 0x7F7F7F7F, 0, 0x7F7F7F7F)
struct Tensors { const unsigned char* Q8; const unsigned char* K8; const unsigned char* V8T; unsigned short* O; float* SS; };

__device__ __forceinline__ void unit(float cb8, int b, int h, int kvh, int qb, const Tensors& T, char* shm) {
    const int tid = threadIdx.x, lane = tid & 63, r32 = lane & 31, hi = lane >> 5; const int wid = __builtin_amdgcn_readfirstlane(tid >> 6);
    const long rowbase = (long)b * SEQ; const int q0 = qb * QB;
    const unsigned lds0 = (unsigned)(uintptr_t)shm;
    const int prow = 16 * (wid & 3) + (lane >> 2), pch = (lane & 3) ^ ((prow >> 2) & 3);
    const unsigned char* src = (wid < 4) ? T.K8 + (size_t)(rowbase + prow) * 128 + kvh * 64 + pch * 16
                                         : T.V8T + ((size_t)((b * 2 + kvh) * 64 + prow)) * SEQ + pch * 16;
    const long tstep = (wid < 4) ? (long)KVT * 128 : (long)KVT;
    const unsigned dst0 = lds0 + (wid < 4 ? 0 : 4096) + (wid & 3) * 1024;
#define A8_DMA(t, slot) glds16(src + (long)(t) * tstep, (unsigned)__builtin_amdgcn_readfirstlane(dst0 + (slot) * SLOTB))
    A8_DMA(0, 0); A8_DMA(1, 1); A8_DMA(2, 2);
    v8i qv; { const unsigned char* qp = T.Q8 + (size_t)(rowbase + q0 + wid * 32 + r32) * 512 + h * 64 + 32 * hi;
              const u32x4 a = *(const u32x4*)qp, c = *(const u32x4*)(qp + 16); qv = (v8i){(int)a.x, (int)a.y, (int)a.z, (int)a.w, (int)c.x, (int)c.y, (int)c.z, (int)c.w}; }
    const int f = (r32 >> 2) & 3;
    const int o0 = r32 * 64 + 16 * ((2 * hi) ^ f), o1 = r32 * 64 + 16 * ((2 * hi + 1) ^ f);
    const lds_cptr sh3 = (lds_cptr)shm;
    f32x16 negc, O0 = f32x16{}, O1 = f32x16{};
#pragma unroll
    for (int r = 0; r < 16; ++r) negc[r] = -cb8;
    f32x16 L = f32x16{}; v8i ones = {0x38383838, 0x38383838, 0x38383838, 0x38383838, 0x38383838, 0x38383838, 0x38383838, 0x38383838};
    asm volatile("" : "+v"(ones));
#define A8_FRAG(p, blk) ({ const u32x4 x_ = *(const __attribute__((address_space(3))) u32x4*)((p) + (blk) * 2048 + o0), y_ = *(const __attribute__((address_space(3))) u32x4*)((p) + (blk) * 2048 + o1); \
                           (v8i){(int)x_.x, (int)x_.y, (int)x_.z, (int)x_.w, (int)y_.x, (int)y_.y, (int)y_.z, (int)y_.w}; })
#define A8_SB __builtin_amdgcn_sched_barrier(0)
#define A8_E(S, r) S[r] = __builtin_amdgcn_exp2f(S[r])
#define A8_C(PW, w, S, d) { PW[w] = __builtin_amdgcn_cvt_pk_fp8_f32(S[4 * (d)], S[4 * (d) + 1], PW[w], false); PW[w] = __builtin_amdgcn_cvt_pk_fp8_f32(S[4 * (d) + 2], S[4 * (d) + 3], PW[w], true); }
#define A8_ITER(t, SA0, SA1, SB0, SB1, PW, PR, PV) { \
        asm volatile("s_waitcnt vmcnt(1) lgkmcnt(0)\n\ts_barrier" ::: "memory");        \
        { const int tn = (t) + 3 < NT ? (t) + 3 : NT - 1; A8_DMA(tn, ((t) + 3) & (NSLOT - 1)); }     \
        const lds_cptr kn = sh3 + (((t) + 1) & (NSLOT - 1)) * SLOTB, vb = sh3 + (((t) + NSLOT - 1) & (NSLOT - 1)) * SLOTB + 4096; \
        const v8i k0 = A8_FRAG(kn, 0), k1 = A8_FRAG(kn, 1); v8i v0 = k0, v1 = k1; if (PV) { v0 = A8_FRAG(vb, 0); v1 = A8_FRAG(vb, 1); } \
        A8_SB; A8_E(SA0, 0); A8_E(SA0, 1); A8_E(SA0, 2); A8_E(SA0, 3); A8_E(SA0, 4); A8_E(SA0, 5); A8_SB; \
        SB0 = A8_MFMA(k0, qv, negc); A8_SB; \
        A8_E(SA0, 6); A8_E(SA0, 7); A8_E(SA0, 8); A8_E(SA0, 9); A8_E(SA0, 10); A8_E(SA0, 11); A8_E(SA0, 12); A8_SB; \
        SB1 = A8_MFMA(k1, qv, negc); A8_SB; \
        A8_E(SA0, 13); A8_E(SA0, 14); A8_E(SA0, 15); A8_E(SA1, 0); A8_E(SA1, 1); A8_E(SA1, 2); A8_E(SA1, 3); A8_SB; \
        if (PV) O0 = A8_MFMA(v0, PR, O0); A8_SB; \
        A8_E(SA1, 4); A8_E(SA1, 5); A8_E(SA1, 6); A8_E(SA1, 7); A8_E(SA1, 8); A8_E(SA1, 9); A8_SB; \
        if (PV) O1 = A8_MFMA(v1, PR, O1); A8_SB; \
        A8_E(SA1, 10); A8_E(SA1, 11); A8_E(SA1, 12); A8_E(SA1, 13); A8_E(SA1, 14); A8_E(SA1, 15); A8_C(PW, 0, SA0, 0); A8_C(PW, 1, SA0, 1); A8_SB; \
        if (PV) L = A8_MFMA(ones, PR, L); A8_SB; \
        A8_C(PW, 2, SA0, 2); A8_C(PW, 3, SA0, 3); A8_C(PW, 4, SA1, 0); A8_C(PW, 5, SA1, 1); A8_C(PW, 6, SA1, 2); A8_C(PW, 7, SA1, 3); A8_SB; }
    asm volatile("s_waitcnt vmcnt(2) lgkmcnt(0)\n\ts_barrier" ::: "memory");
    f32x16 Sa0, Sa1, Sb0, Sb1; v8i pA = {0, 0, 0, 0, 0, 0, 0, 0}, pB = {0, 0, 0, 0, 0, 0, 0, 0};
    { const v8i k0 = A8_FRAG(sh3, 0), k1 = A8_FRAG(sh3, 1); Sa0 = A8_MFMA(k0, qv, negc); Sa1 = A8_MFMA(k1, qv, negc); }
    A8_ITER(0, Sa0, Sa1, Sb0, Sb1, pA, pB, false);
    A8_ITER(1, Sb0, Sb1, Sa0, Sa1, pB, pA, true);
    for (int t = 2; t < NT; t += 2) {
        A8_ITER(t, Sa0, Sa1, Sb0, Sb1, pA, pB, true);
        A8_ITER(t + 1, Sb0, Sb1, Sa0, Sa1, pB, pA, true);
    }
    { const lds_cptr vb = sh3 + ((NT - 1) & (NSLOT - 1)) * SLOTB + 4096; const v8i v0 = A8_FRAG(vb, 0), v1 = A8_FRAG(vb, 1);
      O0 = A8_MFMA(v0, pB, O0); O1 = A8_MFMA(v1, pB, O1); L = A8_MFMA(ones, pB, L); }
#undef A8_ITER
#undef A8_C
#undef A8_E
#undef A8_SB
    const float rl = 1.0f / (8.0f * L[0]);
    unsigned short* stg = (unsigned short*)(shm + LDS_OST) + wid * 2048;
#pragma unroll
    for (int r = 0; r < 16; ++r) { const int d = crow(r, hi);
        stg[r32 * 64 + d] = (unsigned short)(f2bf_rne(O0[r] * rl)); stg[r32 * 64 + 32 + d] = (unsigned short)(f2bf_rne(O1[r] * rl)); }
    asm volatile("s_waitcnt lgkmcnt(0)" ::: "memory");
    unsigned short* Ow = T.O + (rowbase + q0 + wid * 32) * OP + h * 64;
#pragma unroll
    for (int i = 0; i < 4; ++i) { const int row = i * 8 + (lane >> 3), ch = lane & 7; const u32x4 v = *(const u32x4*)(stg + row * 64 + ch * 8); *(u32x4*)(Ow + (long)row * OP + ch * 8) = v;
        float q = 0.f; { const unsigned w4[4] = {v.x, v.y, v.z, v.w};
#pragma unroll
            for (int k = 0; k < 4; ++k) { const float a = __uint_as_float(w4[k] << 16), b2 = __uint_as_float(w4[k] & 0xffff0000u); q += a * a + b2 * b2; } }
        q += __builtin_bit_cast(float, __builtin_amdgcn_update_dpp(0, __builtin_bit_cast(int, q), 0xB1, 0xF, 0xF, true));
        q += __builtin_bit_cast(float, __builtin_amdgcn_update_dpp(0, __builtin_bit_cast(int, q), 0x4E, 0xF, 0xF, true));
        q += __builtin_bit_cast(float, __builtin_amdgcn_update_dpp(0, __builtin_bit_cast(int, q), 0x141, 0xF, 0xF, true));
        if (ch == 0) T.SS[(rowbase + q0 + wid * 32 + row) * 8 + h] = q; }
    asm volatile("s_waitcnt vmcnt(0) lgkmcnt(0)\n\ts_barrier" ::: "memory");
#undef A8_DMA
#undef A8_FRAG
}
__device__ __forceinline__ void phase(char* lds, const Tensors& T, int grid, int block, float cb8) {
    const int vcu = (grid % 8 == 0) ? (block % 8) * (grid / 8) + block / 8 : block;
    for (int id = vcu; id < 4 * NQB * 8; id += grid) {
        const int per = NQB * 8, hq = id / per, rem = id % per, bk = rem / NQB, qb = rem % NQB, b = bk / 2, kvh = bk % 2;
        unit(cb8, b, kvh * 4 + hq, kvh, qb, T, lds);
    }
}
#undef A8_MFMA
}

namespace natten {
using bf16x8 = __attribute__((ext_vector_type(8))) short;
using s16x4 = __attribute__((ext_vector_type(4))) short;
using f32x4 = __attribute__((ext_vector_type(4))) float;
using u32x4 = __attribute__((ext_vector_type(4))) unsigned;
using u32x2 = __attribute__((ext_vector_type(2))) unsigned;
typedef unsigned short bf16_t;
typedef __attribute__((address_space(3))) unsigned char* lds_ptr;
typedef short v4i16_t __attribute__((ext_vector_type(4)));
constexpr int SEQ = 8192, GW = 64, ROWS = 128, PP = 2304, OP = 1024, KH = 8, KW = 16;
constexpr int LDS_K = 0, LDS_V = 9 * 64 * 128, LDS_BIAS = 2 * LDS_V, LDS_BYTES = LDS_BIAS + 15 * 64 * 4;
__device__ __forceinline__ int clampi(int v, int lo, int hi) { return v < lo ? lo : (v > hi ? hi : v); }
__device__ __forceinline__ unsigned cvtpk(float lo, float hi) { unsigned r; asm volatile("v_cvt_pk_bf16_f32 %0, %1, %2" : "=v"(r) : "v"(lo), "v"(hi)); return r; }
__device__ __forceinline__ s16x4 vtr(const __attribute__((address_space(3))) unsigned char* p) { return __builtin_bit_cast(s16x4, __builtin_amdgcn_ds_read_tr16_b64_v4i16((__attribute__((address_space(3))) v4i16_t*)p)); }

__device__ __forceinline__ int win_lo(int rp) { return clampi(2 * rp - 4, 0, ROWS - KH); }
__device__ __forceinline__ int win_hi(int rp) { const int lo = win_lo(rp); return lo + ((ROWS - lo) < 9 ? (ROWS - lo) : 9) - 1; }
__device__ __forceinline__ void stage_chunk(lds_ptr lds, int row, int col, int c, bool isv, u32x4 v) {
    const int s = row % 9;
    if (!isv) *(__attribute__((address_space(3))) u32x4*)(lds + LDS_K + s * 8192 + col * 128 + 16 * (c ^ ((col >> 1) & 7))) = v;
    else      *(__attribute__((address_space(3))) u32x4*)(lds + LDS_V + s * 8192 + col * 128 + 32 * ((c >> 1) ^ ((col >> 1) & 3)) + 16 * (c & 1)) = v;
}
__device__ __forceinline__ void natten_block(int b, int h, int rp0, int nun, const bf16_t* Qb, const bf16_t* Kb, const bf16_t* Vb, const float* rpb, bf16_t* O, float* SS, lds_ptr lds) {
    const int tid = threadIdx.x, lane = tid & 63, wid = __builtin_amdgcn_readfirstlane(tid >> 6);
    for (int n = tid; n < 15 * 64; n += 512) {
        const int dr = n >> 6, x = (n & 63) - 16;
        const float v = (x >= 0 && x < 31) ? rpb[(h * 15 + dr) * 31 + x] * 1.4426950408889634f : 0.f;
        *(__attribute__((address_space(3))) float*)(lds + LDS_BIAS + n * 4) = v;
    }
    int have_hi = win_hi(rp0);
    { const int lo = win_lo(rp0), nr = have_hi - lo + 1;
      for (int n = tid; n < nr * 1024; n += 512) {
          const int r = n >> 10, m = n & 1023, isv = m >> 9, col = (m & 511) >> 3, c = m & 7;
          const size_t tokk = (size_t)b * SEQ + (size_t)(lo + r) * GW + col;
          stage_chunk(lds, lo + r, col, c, isv, *(const u32x4*)((isv ? Vb : Kb) + tokk * PP + h * 64 + c * 8));
      } }
    __syncthreads();
    const int g = lane >> 4, i16 = lane & 15, q4 = i16 >> 2, p4 = lane & 3;
    for (int u = 0; u < nun; ++u) {
        const int rp = rp0 + u;
        u32x4 pf[4]; int nnew = 0;
        if (u + 1 < nun) { nnew = win_hi(rp + 1) - have_hi;
#pragma unroll
            for (int i = 0; i < 4; ++i) { const int n = tid + 512 * i; const int r = n >> 10, m = n & 1023, isv = m >> 9, col = (m & 511) >> 3, c = m & 7;
                if (r < nnew) { const size_t tokk = (size_t)b * SEQ + (size_t)(have_hi + 1 + r) * GW + col; pf[i] = *(const u32x4*)((isv ? Vb : Kb) + tokk * PP + h * 64 + c * 8); } } }
        const int rq = 2 * rp + (wid >> 2), c0 = 16 * (wid & 3), cw = clampi(c0 - 8, 0, 32), rs = clampi(rq - 4, 0, ROWS - KH);
        const int cq = c0 + i16, csq = clampi(cq - 8, 0, GW - KW);
        const size_t tok = (size_t)b * SEQ + (size_t)rq * GW + cq;
        bf16x8 qf[2];
#pragma unroll
        for (int ks = 0; ks < 2; ++ks) qf[ks] = *(const bf16x8*)(Qb + tok * PP + h * 64 + 32 * ks + 8 * g);
        const int swk = ((cw + i16) >> 1) & 7;
        const lds_ptr kp0 = lds + LDS_K + (cw + i16) * 128 + 16 * ((0 + g) ^ swk);
        const lds_ptr kp1 = lds + LDS_K + (cw + i16) * 128 + 16 * ((4 + g) ^ swk);
        int sl[8];
#pragma unroll
        for (int j = 0; j < 8; ++j) sl[j] = ((rs + j) % 9) * 8192;
        f32x4 s[16];
#pragma unroll
        for (int kb = 0; kb < 16; ++kb) {
            const int off = sl[kb >> 1] + (16 * (kb & 1)) * 128;
            const bf16x8 a0 = *(const __attribute__((address_space(3))) bf16x8*)(kp0 + off);
            const bf16x8 a1 = *(const __attribute__((address_space(3))) bf16x8*)(kp1 + off);
            f32x4 z = {0.f, 0.f, 0.f, 0.f};
            z = __builtin_amdgcn_mfma_f32_16x16x32_bf16(a0, qf[0], z, 0, 0, 0);
            s[kb] = __builtin_amdgcn_mfma_f32_16x16x32_bf16(a1, qf[1], z, 0, 0, 0);
        }
        const lds_ptr bp = lds + LDS_BIAS + ((rs - rq + 7) * 64 + (cw + 4 * g - cq + 31)) * 4;
        bool ok[2][4];
#pragma unroll
        for (int hh = 0; hh < 2; ++hh)
#pragma unroll
            for (int r = 0; r < 4; ++r) ok[hh][r] = (unsigned)(cw + 16 * hh + 4 * g + r - csq) < 16u;
        float mx = -3.0e38f;
#pragma unroll
        for (int kb = 0; kb < 16; ++kb)
#pragma unroll
            for (int r = 0; r < 4; ++r) {
                const float bias = *(const __attribute__((address_space(3))) float*)(bp + ((kb >> 1) * 64 + 16 * (kb & 1) + r) * 4);
                const float v = ok[kb & 1][r] ? s[kb][r] + bias : -3.0e38f;
                s[kb][r] = v; mx = fmaxf(mx, v);
            }
        mx = fmaxf(mx, __shfl_xor(mx, 16)); mx = fmaxf(mx, __shfl_xor(mx, 32));
        float l = 0.f;
#pragma unroll
        for (int kb = 0; kb < 16; ++kb)
#pragma unroll
            for (int r = 0; r < 4; ++r) { const float p = __builtin_amdgcn_exp2f(s[kb][r] - mx); s[kb][r] = p; l += p; }
        l += __shfl_xor(l, 16); l += __shfl_xor(l, 32);
        const int swv = (2 * g + (q4 >> 1)) & 3;
        lds_ptr vp[4];
#pragma unroll
        for (int db = 0; db < 4; ++db) vp[db] = lds + LDS_V + (cw + 4 * g + q4) * 128 + 32 * (db ^ swv) + 8 * p4;
        f32x4 o[4];
#pragma unroll
        for (int db = 0; db < 4; ++db) o[db] = (f32x4){0.f, 0.f, 0.f, 0.f};
#pragma unroll
        for (int kk = 0; kk < 8; ++kk) {
            u32x4 pw; pw.x = cvtpk(s[2 * kk][0], s[2 * kk][1]); pw.y = cvtpk(s[2 * kk][2], s[2 * kk][3]); pw.z = cvtpk(s[2 * kk + 1][0], s[2 * kk + 1][1]); pw.w = cvtpk(s[2 * kk + 1][2], s[2 * kk + 1][3]);
            const bf16x8 pb = __builtin_bit_cast(bf16x8, pw);
#pragma unroll
            for (int db = 0; db < 4; ++db) {
                const s16x4 lo = vtr(vp[db] + sl[kk]), hi = vtr(vp[db] + sl[kk] + 16 * 128);
                const bf16x8 a = (bf16x8){lo[0], lo[1], lo[2], lo[3], hi[0], hi[1], hi[2], hi[3]};
                o[db] = __builtin_amdgcn_mfma_f32_16x16x32_bf16(a, pb, o[db], 0, 0, 0);
            }
        }
        const float rl = 1.0f / l;
        bf16_t* op = O + tok * OP + 512 + h * 64 + 4 * g;
        float qs = 0.f;
#pragma unroll
        for (int db = 0; db < 4; ++db) { u32x2 w; w.x = cvtpk(o[db][0] * rl, o[db][1] * rl); w.y = cvtpk(o[db][2] * rl, o[db][3] * rl); *(u32x2*)(op + 16 * db) = w;
            const float a0 = __uint_as_float(w.x << 16), a1 = __uint_as_float(w.x & 0xffff0000u), a2 = __uint_as_float(w.y << 16), a3 = __uint_as_float(w.y & 0xffff0000u); qs += (a0 * a0 + a1 * a1) + (a2 * a2 + a3 * a3); }
        qs += __shfl_xor(qs, 16); qs += __shfl_xor(qs, 32);
        if (g == 0) SS[tok * 8 + h] = qs;
        __syncthreads();
        if (u + 1 < nun) {
#pragma unroll
            for (int i = 0; i < 4; ++i) { const int n = tid + 512 * i; const int r = n >> 10, m = n & 1023, isv = m >> 9, col = (m & 511) >> 3, c = m & 7;
                if (r < nnew) stage_chunk(lds, have_hi + 1 + r, col, c, isv, pf[i]); }
            have_hi += nnew;
            __syncthreads();
        }
    }
}
__device__ __forceinline__ void natten_phase(lds_ptr lds, const bf16_t* Qb, const bf16_t* Kb, const bf16_t* Vb, const float* rpb, bf16_t* O, float* SS, int vcu, int G) {
    for (int it = vcu; it < 256; it += G) { natten_block(it >> 6, (it >> 3) & 7, (it & 7) * 8, 8, Qb, Kb, Vb, rpb, O, SS, lds); __syncthreads(); }
}
}

namespace peer {
using bf16x8 = __attribute__((ext_vector_type(8))) short;
using f32x4 = __attribute__((ext_vector_type(4))) float;
using u32x4 = __attribute__((ext_vector_type(4))) unsigned;
typedef unsigned short bf16_t;
typedef __bf16 bf16x2_t __attribute__((ext_vector_type(2)));
typedef __attribute__((address_space(3))) unsigned char* lds_ptr;
constexpr int LDS_SK = 0, LDS_TAB = 65536, LDS_WV = LDS_TAB + 256, LDS_BYTES = LDS_WV + 8 * 4096;
constexpr float LOG2E = 1.4426950408889634f;

#define PEER_CE(a, b) do { const float hi_ = fmaxf(a, b), lo_ = fminf(a, b); a = hi_; b = lo_; } while (0)
template <int N, bool DESC> __device__ __forceinline__ void bitonic_sort(float (&v)[N]) {
#pragma unroll
    for (int k = 2; k <= N; k <<= 1)
#pragma unroll
        for (int j = k >> 1; j > 0; j >>= 1)
#pragma unroll
            for (int i = 0; i < N; ++i) { const int l = i ^ j; if (l > i) { const bool d = (((i & k) == 0) == DESC); if (d) PEER_CE(v[i], v[l]); else PEER_CE(v[l], v[i]); } }
}
template <bool DESC> __device__ __forceinline__ void oem_sort16(float (&v)[16]) {
#pragma unroll
    for (int p = 1; p < 16; p <<= 1)
#pragma unroll
        for (int k = p; k >= 1; k >>= 1)
#pragma unroll
            for (int j = k % p; j <= 15 - k; j += 2 * k)
#pragma unroll
                for (int i = 0; i < k; ++i) { if (i <= 15 - j - k && ((i + j) / (2 * p) == (i + j + k) / (2 * p))) { if (DESC) PEER_CE(v[i + j], v[i + j + k]); else PEER_CE(v[i + j + k], v[i + j]); } }
}
__device__ __forceinline__ void bitonic_merge16_desc(float (&v)[16]) {
#pragma unroll
    for (int j = 8; j > 0; j >>= 1)
#pragma unroll
        for (int i = 0; i < 16; ++i) { const int l = i ^ j; if (l > i) PEER_CE(v[i], v[l]); }
}
__device__ __forceinline__ void xlane_merge16(float (&v)[16], int mask) {
    float t[16];
#pragma unroll
    for (int i = 0; i < 16; ++i) t[i] = fmaxf(v[i], __shfl_xor(v[15 - i], mask));
#pragma unroll
    for (int i = 0; i < 16; ++i) v[i] = t[i];
    bitonic_merge16_desc(v);
}
__device__ __forceinline__ float gelu_erf(float v) {
    const float av = fabsf(v), t = 1.0f / (1.0f + 0.2316418882f * av);
    float q = t * 0.5307027145f + (-0.7265760135f); q = q * t + 0.7107068705f; q = q * t + (-0.142248368f); q = q * t + 0.127414796f; q = q * t;
    const float e = __builtin_amdgcn_exp2f((v * v) * (-0.72134752044f));
    const float m = v * (q * e);
    return v < 0.f ? m : v - m;
}
__device__ __forceinline__ float dot8(u32x4 a, u32x4 b, float acc) {
    typedef __bf16 bf16x8_t __attribute__((ext_vector_type(8)));
    const bf16x8_t va = __builtin_bit_cast(bf16x8_t, a), vb = __builtin_bit_cast(bf16x8_t, b);
    acc = __builtin_amdgcn_fdot2_f32_bf16((bf16x2_t){va[0], va[1]}, (bf16x2_t){vb[0], vb[1]}, acc, false);
    acc = __builtin_amdgcn_fdot2_f32_bf16((bf16x2_t){va[2], va[3]}, (bf16x2_t){vb[2], vb[3]}, acc, false);
    acc = __builtin_amdgcn_fdot2_f32_bf16((bf16x2_t){va[4], va[5]}, (bf16x2_t){vb[4], vb[5]}, acc, false);
    acc = __builtin_amdgcn_fdot2_f32_bf16((bf16x2_t){va[6], va[7]}, (bf16x2_t){vb[6], vb[7]}, acc, false);
    return acc;
}
__device__ __forceinline__ float blo(unsigned w) { return __uint_as_float(w << 16); }
__device__ __forceinline__ float bhi(unsigned w) { return __uint_as_float(w & 0xffff0000u); }

struct PeerArgs {
    const bf16_t* PQ;
    const bf16_t* SK;
    const bf16_t* H2;
    const unsigned char* U; const unsigned char* V;
    const float* US; const float* VS;
    int* eidx; float* egate2; float* wts;
    const bf16_t* xin; float* xout;
    const float* mod;
    const float* fg;
};

__device__ __forceinline__ void route16(const PeerArgs& A, lds_ptr lds, int tok0, int wid, int lane) {
    const int g = lane >> 4, i16 = lane & 15;
    const lds_ptr wv = lds + LDS_WV + wid * 4096;
    const bf16_t* qrow = A.PQ + (size_t)(tok0 + i16) * 2048;
    bf16x8 qn[4];
#pragma unroll
    for (int ks = 0; ks < 4; ++ks) qn[ks] = *(const bf16x8*)(qrow + 32 * ks + 8 * g);
    for (int h = 0; h < 8; ++h) {
        if (((h ^ (wid >> 2)) & 1) != 0) __builtin_amdgcn_s_setprio(1); else __builtin_amdgcn_s_setprio(0);
        float top[2][16];
#pragma unroll
        for (int half = 0; half < 2; ++half) {
            bf16x8 qf[4];
#pragma unroll
            for (int ks = 0; ks < 4; ++ks) qf[ks] = qn[ks];
            { const int nx = (2 * h + half + 1) & 15;
#pragma unroll
              for (int ks = 0; ks < 4; ++ks) qn[ks] = *(const bf16x8*)(qrow + nx * 128 + 32 * ks + 8 * g); }
            float v[32];
#pragma unroll
            for (int kb = 0; kb < 8; ++kb) {
                f32x4 s = {0.f, 0.f, 0.f, 0.f};
#pragma unroll
                for (int ks = 0; ks < 4; ++ks) {
                    const int row = 16 * kb + i16, c = 4 * ks + g;
                    const bf16x8 a = *(const __attribute__((address_space(3))) bf16x8*)(lds + LDS_SK + half * 32768 + row * 256 + 16 * (c ^ i16));
                    s = __builtin_amdgcn_mfma_f32_16x16x32_bf16(a, qf[ks], s, 0, 0, 0);
                }
#pragma unroll
                for (int r = 0; r < 4; ++r) v[4 * kb + r] = __uint_as_float((__float_as_uint(s[r]) & ~127u) | (unsigned)(16 * kb + 4 * g + r));
            }
            float a16[16], b16[16];
#pragma unroll
            for (int i = 0; i < 16; ++i) { a16[i] = v[i]; b16[i] = v[16 + i]; }
            oem_sort16<true>(a16); oem_sort16<false>(b16);
#pragma unroll
            for (int i = 0; i < 16; ++i) a16[i] = fmaxf(a16[i], b16[i]);
            bitonic_merge16_desc(a16);
            xlane_merge16(a16, 16); xlane_merge16(a16, 32);
#pragma unroll
            for (int i = 0; i < 16; ++i) top[half][i] = a16[i];
        }
        if (g == 0) {
#pragma unroll
            for (int i = 0; i < 16; ++i) { *(__attribute__((address_space(3))) float*)(wv + (i16 * 32 + i) * 4) = top[0][i]; *(__attribute__((address_space(3))) float*)(wv + (i16 * 32 + 16 + i) * 4) = top[1][i]; }
        }
        float cs[16];
#pragma unroll
        for (int j = 0; j < 16; ++j) {
            constexpr int A1[16] = {1, 1, 1, 1, 1, 1, 1, 1, 4, 4, 4, 5, 5, 8, 9, 10}, B1[16] = {0, 1, 2, 3, 4, 5, 6, 7, 0, 1, 2, 0, 1, 0, 0, 0};
            constexpr int A2[16] = {2, 2, 2, 2, 2, 3, 3, 3, 3, 6, 6, 7, 7, 11, 12, 13}, B2[16] = {0, 1, 2, 3, 4, 0, 1, 2, 3, 0, 1, 0, 1, 0, 0, 0};
            constexpr int A3[16] = {14, 15, 0, 0, 0, 0, 0, 0, 0, 0, 0, 0, 0, 0, 0, 0};
            const float x1 = g == 0 ? top[0][0] : (g == 1 ? top[0][A1[j]] : (g == 2 ? top[0][A2[j]] : top[0][A3[j]]));
            const float x2 = g == 0 ? top[1][j] : (g == 1 ? top[1][B1[j]] : (g == 2 ? top[1][B2[j]] : top[1][0]));
            float sm = __uint_as_float(__float_as_uint(x1) & ~127u) + __uint_as_float(__float_as_uint(x2) & ~127u);
            if (g == 3 && j >= 2) sm = -3.0e38f;
            cs[j] = __uint_as_float((__float_as_uint(sm) & ~63u) | (unsigned)(g * 16 + j));
        }
        oem_sort16<true>(cs);
        xlane_merge16(cs, 16); xlane_merge16(cs, 32);
        float mxs = __uint_as_float(__float_as_uint(cs[0]) & ~63u);
        float val[4]; int ex[4]; float es = 0.f;
#pragma unroll
        for (int k = 0; k < 4; ++k) {
            const float e = g == 0 ? cs[k] : (g == 1 ? cs[4 + k] : (g == 2 ? cs[8 + k] : cs[12 + k]));
            const unsigned slot = __float_as_uint(e) & 63u;
            const unsigned ab = *(const __attribute__((address_space(3))) unsigned char*)(lds + LDS_TAB + slot);
            const unsigned p1 = __float_as_uint(*(const __attribute__((address_space(3))) float*)(wv + (i16 * 32 + (ab >> 4)) * 4));
            const unsigned p2 = __float_as_uint(*(const __attribute__((address_space(3))) float*)(wv + (i16 * 32 + 16 + (ab & 15)) * 4));
            ex[k] = (int)((p1 & 127u) * 128u + (p2 & 127u));
            val[k] = __builtin_amdgcn_exp2f((__uint_as_float(p1 & ~127u) + __uint_as_float(p2 & ~127u) - mxs) * LOG2E);
            es += val[k];
        }
        es += __shfl_xor(es, 16); es += __shfl_xor(es, 32);
        const float ri = 1.0f / es;
        int* ep = A.eidx + (size_t)(tok0 + i16) * 128 + h * 16 + 4 * g;
        float* gp = A.egate2 + ((size_t)(tok0 + i16) * 128 + h * 16 + 4 * g) * 2;
        *(int4*)ep = make_int4(ex[0], ex[1], ex[2], ex[3]);
        *(float4*)gp = make_float4(A.US[ex[0]], val[0] * ri * A.VS[ex[0]], A.US[ex[1]], val[1] * ri * A.VS[ex[1]]);
        *(float4*)(gp + 4) = make_float4(A.US[ex[2]], val[2] * ri * A.VS[ex[2]], A.US[ex[3]], val[3] * ri * A.VS[ex[3]]);
    }
    __builtin_amdgcn_s_setprio(0);
}

typedef float f32x2 __attribute__((ext_vector_type(2)));
__device__ __forceinline__ float row16_sum(float x) {
    x += __builtin_bit_cast(float, __builtin_amdgcn_update_dpp(0, __builtin_bit_cast(int, x), 0xB1, 0xF, 0xF, true));
    x += __builtin_bit_cast(float, __builtin_amdgcn_update_dpp(0, __builtin_bit_cast(int, x), 0x4E, 0xF, 0xF, true));
    x += __builtin_bit_cast(float, __builtin_amdgcn_update_dpp(0, __builtin_bit_cast(int, x), 0x141, 0xF, 0xF, true));
    x += __builtin_bit_cast(float, __builtin_amdgcn_update_dpp(0, __builtin_bit_cast(int, x), 0x140, 0xF, 0xF, true));
    return x;
}
__device__ __forceinline__ f32x2 dot16_fp8(u32x4 w, const f32x2 (&h)[8], f32x2 acc) {
    acc += __builtin_amdgcn_cvt_pk_f32_fp8(w.x, false) * h[0]; acc += __builtin_amdgcn_cvt_pk_f32_fp8(w.x, true) * h[1];
    acc += __builtin_amdgcn_cvt_pk_f32_fp8(w.y, false) * h[2]; acc += __builtin_amdgcn_cvt_pk_f32_fp8(w.y, true) * h[3];
    acc += __builtin_amdgcn_cvt_pk_f32_fp8(w.z, false) * h[4]; acc += __builtin_amdgcn_cvt_pk_f32_fp8(w.z, true) * h[5];
    acc += __builtin_amdgcn_cvt_pk_f32_fp8(w.w, false) * h[6]; acc += __builtin_amdgcn_cvt_pk_f32_fp8(w.w, true) * h[7];
    return acc;
}
__device__ __forceinline__ void axpy16_fp8(u32x4 v, float wt, f32x2 (&acc)[8]) {
    const f32x2 w2 = {wt, wt};
    acc[0] += w2 * __builtin_amdgcn_cvt_pk_f32_fp8(v.x, false); acc[1] += w2 * __builtin_amdgcn_cvt_pk_f32_fp8(v.x, true);
    acc[2] += w2 * __builtin_amdgcn_cvt_pk_f32_fp8(v.y, false); acc[3] += w2 * __builtin_amdgcn_cvt_pk_f32_fp8(v.y, true);
    acc[4] += w2 * __builtin_amdgcn_cvt_pk_f32_fp8(v.z, false); acc[5] += w2 * __builtin_amdgcn_cvt_pk_f32_fp8(v.z, true);
    acc[6] += w2 * __builtin_amdgcn_cvt_pk_f32_fp8(v.w, false); acc[7] += w2 * __builtin_amdgcn_cvt_pk_f32_fp8(v.w, true);
}
typedef unsigned v6u __attribute__((ext_vector_type(6)));
typedef float v32f __attribute__((ext_vector_type(32)));
typedef __bf16 v32bf __attribute__((ext_vector_type(32)));
typedef unsigned u32x2 __attribute__((ext_vector_type(2)));
__device__ __forceinline__ float dot32_bf16(v32bf c, u32x4 h0, u32x4 h1, u32x4 h2, u32x4 h3, float acc) {
    typedef __bf16 bf16x8_t __attribute__((ext_vector_type(8)));
    const bf16x8_t a0 = __builtin_bit_cast(bf16x8_t, h0), a1 = __builtin_bit_cast(bf16x8_t, h1), a2 = __builtin_bit_cast(bf16x8_t, h2), a3 = __builtin_bit_cast(bf16x8_t, h3);
#pragma unroll
    for (int i = 0; i < 4; ++i) {
        acc = __builtin_amdgcn_fdot2_f32_bf16((bf16x2_t){c[2 * i], c[2 * i + 1]}, (bf16x2_t){a0[2 * i], a0[2 * i + 1]}, acc, false);
        acc = __builtin_amdgcn_fdot2_f32_bf16((bf16x2_t){c[8 + 2 * i], c[8 + 2 * i + 1]}, (bf16x2_t){a1[2 * i], a1[2 * i + 1]}, acc, false);
        acc = __builtin_amdgcn_fdot2_f32_bf16((bf16x2_t){c[16 + 2 * i], c[16 + 2 * i + 1]}, (bf16x2_t){a2[2 * i], a2[2 * i + 1]}, acc, false);
        acc = __builtin_amdgcn_fdot2_f32_bf16((bf16x2_t){c[24 + 2 * i], c[24 + 2 * i + 1]}, (bf16x2_t){a3[2 * i], a3[2 * i + 1]}, acc, false);
    }
    return acc;
}
__device__ __forceinline__ float udot64(u32x4 p0, u32x4 p1, u32x4 p2, const u32x4 (&hp)[8]) {
    const v6u ga = {p0.x, p0.y, p0.z, p0.w, p1.x, p1.y}, gb = {p1.z, p1.w, p2.x, p2.y, p2.z, p2.w};
    const v32bf ca = __builtin_amdgcn_cvt_scalef32_pk32_bf16_fp6(ga, 1.0f), cb = __builtin_amdgcn_cvt_scalef32_pk32_bf16_fp6(gb, 1.0f);
    float d = dot32_bf16(ca, hp[0], hp[1], hp[2], hp[3], 0.f);
    return dot32_bf16(cb, hp[4], hp[5], hp[6], hp[7], d);
}
__device__ __forceinline__ void upass_token(const PeerArgs& A, int tok, int lane) {
    const int e4 = lane >> 4, l16 = lane & 15;
    u32x4 hp[8];
#pragma unroll
    for (int k = 0; k < 8; ++k) hp[k] = *(const u32x4*)(A.H2 + (size_t)tok * 1024 + 64 * l16 + 8 * k);
    const int2* ei = (const int2*)(A.eidx + (size_t)tok * 128 + e4 * 32); const f32x4* eg = (const f32x4*)(A.egate2 + ((size_t)tok * 128 + e4 * 32) * 2); float* wo = A.wts + (size_t)tok * 128 + e4 * 32;
    const unsigned char* ub = A.U + l16 * 16;
    int2 id[5]; u32x4 buf[3][6]; f32x4 gs[3];
#define U_IDS(st) do { id[(st) % 5] = ei[(st)]; } while (0)
#define U_GATHER(st) do { const unsigned char* pa = ub + (size_t)id[(st) % 5].x * 768; const unsigned char* pb = ub + (size_t)id[(st) % 5].y * 768; \
        buf[(st) % 3][0] = *(const u32x4*)pa; buf[(st) % 3][1] = *(const u32x4*)(pa + 256); buf[(st) % 3][2] = *(const u32x4*)(pa + 512); \
        buf[(st) % 3][3] = *(const u32x4*)pb; buf[(st) % 3][4] = *(const u32x4*)(pb + 256); buf[(st) % 3][5] = *(const u32x4*)(pb + 512); gs[(st) % 3] = eg[(st)]; } while (0)
    U_IDS(0); U_IDS(1); U_IDS(2); U_IDS(3);
    U_GATHER(0); U_GATHER(1);
#pragma unroll
    for (int st = 0; st < 16; ++st) {
        if (st + 4 < 16) U_IDS(st + 4);
        if (st + 2 < 16) U_GATHER(st + 2);
        const f32x4 g = gs[st % 3];
        const float ta = row16_sum(udot64(buf[st % 3][0], buf[st % 3][1], buf[st % 3][2], hp)) * g[0];
        const float tb = row16_sum(udot64(buf[st % 3][3], buf[st % 3][4], buf[st % 3][5], hp)) * g[2];
        if (l16 == 0) *(f32x2*)(wo + 2 * st) = (f32x2){gelu_erf(ta) * g[1], gelu_erf(tb) * g[3]};
    }
#undef U_IDS
#undef U_GATHER
}
__device__ __forceinline__ int grab(lds_ptr cnt, int lane) {
    int t = 0;
    if (lane == 0) t = __hip_atomic_fetch_add((__attribute__((address_space(3))) int*)cnt, 1, __ATOMIC_RELAXED, __HIP_MEMORY_SCOPE_WORKGROUP);
    return __builtin_amdgcn_readfirstlane(t);
}
template <bool DYN> __device__ __forceinline__ void vpass_wave(const PeerArgs& A, int tok0, int tstride, int ntok, int lane, lds_ptr cnt = nullptr) {
    const int hw = lane >> 5, l32 = lane & 31;
    const unsigned char* vb = A.V + l32 * 16; const unsigned char* vc = A.V + 512 + l32 * 8;
    int4 id[4]; f32x4 wg[4]; u32x4 p0[4][4]; u32x2 p1[4][4];
#define V_EI(t) ((const int4*)(A.eidx + (size_t)(t) * 128 + hw * 64))
#define V_WI(t) ((const f32x4*)(A.wts + (size_t)(t) * 128 + hw * 64))
#define V_IDS(t, gr) do { id[(gr) % 4] = V_EI(t)[(gr) % 16]; wg[(gr) % 4] = V_WI(t)[(gr) % 16]; } while (0)
#define V_GATHER(gr) do { const int4 t_ = id[(gr) % 4]; \
        p0[(gr) % 4][0] = *(const u32x4*)(vb + (size_t)t_.x * 768); p1[(gr) % 4][0] = *(const u32x2*)(vc + (size_t)t_.x * 768); \
        p0[(gr) % 4][1] = *(const u32x4*)(vb + (size_t)t_.y * 768); p1[(gr) % 4][1] = *(const u32x2*)(vc + (size_t)t_.y * 768); \
        p0[(gr) % 4][2] = *(const u32x4*)(vb + (size_t)t_.z * 768); p1[(gr) % 4][2] = *(const u32x2*)(vc + (size_t)t_.z * 768); \
        p0[(gr) % 4][3] = *(const u32x4*)(vb + (size_t)t_.w * 768); p1[(gr) % 4][3] = *(const u32x2*)(vc + (size_t)t_.w * 768); } while (0)
    int cur = 0, nxt = 1;
    if (DYN) { cur = grab(cnt, lane); if (cur >= ntok) return; nxt = grab(cnt, lane); tok0 += cur; }
    V_IDS(tok0, 0); V_IDS(tok0, 1); V_IDS(tok0, 2);
    V_GATHER(0); V_GATHER(1);
    int tokd = tok0;
    for (int t = 0; DYN || t < ntok; ++t) {
        const int tok = DYN ? tokd : tok0 + t * tstride, tokn = DYN ? (nxt < ntok ? tok - cur + nxt : tok) : ((t + 1 < ntok) ? tok + tstride : tok);
        v32f acc;
#pragma unroll
        for (int i = 0; i < 32; ++i) acc[i] = 0.f;
#pragma unroll
        for (int gr = 0; gr < 16; ++gr) {
            V_GATHER(gr + 2);
            const f32x4 w = wg[gr % 4];
            if (gr + 3 < 16) V_IDS(tok, gr + 3); else V_IDS(tokn, gr + 3);
#pragma unroll
            for (int k = 0; k < 4; ++k) {
                const v6u g = {p0[gr % 4][k].x, p0[gr % 4][k].y, p0[gr % 4][k].z, p0[gr % 4][k].w, p1[gr % 4][k].x, p1[gr % 4][k].y};
                const v32f c = __builtin_amdgcn_cvt_scalef32_pk32_f32_fp6(g, 1.0f);
                acc += c * w[k];
            }
        }
#pragma unroll
        for (int i = 0; i < 32; ++i) acc[i] += __shfl_xor(acc[i], 32);
        float f[16];
#pragma unroll
        for (int i = 0; i < 16; ++i) f[i] = hw ? acc[16 + i] : acc[i];
        const int b = tok >> 13, col = 32 * l32 + 16 * hw;
        const bf16_t* xr = A.xin + (size_t)tok * 1024 + col; float* xo = A.xout + (size_t)tok * 1024 + col; const float* g2 = A.mod + b * 6144 + 5120 + col; const float* fgp = A.fg + col;
        float y[16]; float ss = 0.f;
        { const u32x4 xa = *(const u32x4*)xr, xb = *(const u32x4*)(xr + 8);
          y[0] = blo(xa.x); y[1] = bhi(xa.x); y[2] = blo(xa.y); y[3] = bhi(xa.y); y[4] = blo(xa.z); y[5] = bhi(xa.z); y[6] = blo(xa.w); y[7] = bhi(xa.w);
          y[8] = blo(xb.x); y[9] = bhi(xb.x); y[10] = blo(xb.y); y[11] = bhi(xb.y); y[12] = blo(xb.z); y[13] = bhi(xb.z); y[14] = blo(xb.w); y[15] = bhi(xb.w); }
#pragma unroll
        for (int q = 0; q < 4; ++q) {
            const f32x4 gv = *(const f32x4*)(g2 + 4 * q);
#pragma unroll
            for (int i = 0; i < 4; ++i) { y[4 * q + i] = y[4 * q + i] + gv[i] * f[4 * q + i]; ss += y[4 * q + i] * y[4 * q + i]; }
        }
#pragma unroll
        for (int o = 1; o < 64; o <<= 1) ss += __shfl_xor(ss, o);
        const float rinv = 1.0f / sqrtf(ss * (1.0f / 1024.0f) + 1e-6f);
#pragma unroll
        for (int q = 0; q < 4; ++q) {
            const f32x4 fv = *(const f32x4*)(fgp + 4 * q); f32x4 o;
#pragma unroll
            for (int i = 0; i < 4; ++i) o[i] = y[4 * q + i] * rinv * fv[i];
            *(f32x4*)(xo + 4 * q) = o;
        }
        if (DYN) { if (nxt >= ntok) break; tokd = tokn; cur = nxt; nxt = grab(cnt, lane); }
    }
#undef V_EI
#undef V_WI
#undef V_IDS
#undef V_GATHER
}

__device__ __forceinline__ void peer_phase(lds_ptr lds, const PeerArgs& A, int vcu, int G, int wid) {
    const int lane = (int)__builtin_amdgcn_mbcnt_hi(~0u, __builtin_amdgcn_mbcnt_lo(~0u, 0u)), tid = wid * 64 + lane;
    for (int n = tid; n < 2 * 128 * 16; n += 512) {
        const int tb = n >> 11, row = (n >> 4) & 127, c = n & 15;
        *(__attribute__((address_space(3))) u32x4*)(lds + LDS_SK + tb * 32768 + row * 256 + 16 * (c ^ (row & 15))) = *(const u32x4*)(A.SK + (size_t)tb * 16384 + row * 128 + c * 8);
    }
    if (tid < 64) {
        const unsigned long long A1 = 0xA985544411111111ull, B1 = 0x0001021076543210ull, A2 = 0xDCB7766333322222ull, B2 = 0x0001010321043210ull;
        const int gq = tid >> 4, j = tid & 15; int a = 0, b = 0;
        if (gq == 0) { a = 0; b = j; } else if (gq == 1) { a = (int)((A1 >> (4 * j)) & 15); b = (int)((B1 >> (4 * j)) & 15); } else if (gq == 2) { a = (int)((A2 >> (4 * j)) & 15); b = (int)((B2 >> (4 * j)) & 15); } else { a = j == 0 ? 14 : 15; b = 0; }
        *(__attribute__((address_space(3))) unsigned char*)(lds + LDS_TAB + tid) = (unsigned char)((a << 4) | b);
    }
    __syncthreads();
    const lds_ptr cU = lds + 160 * 1024 - 256 + 24 * 4, cV = cU + 4;
    for (int task_ = vcu; task_ < 256; task_ += G) {
        const int task = __builtin_amdgcn_readfirstlane(task_);
        if (tid == 0) { *(__attribute__((address_space(3))) int*)cU = 0; *(__attribute__((address_space(3))) int*)cV = 0; }
        const int tok0 = task * 128 + wid * 16;
        { int ln_ = lane; asm volatile("" : "+v"(ln_)); route16(A, lds, tok0, wid, ln_); }
        int lane2 = lane;
        asm volatile("s_waitcnt vmcnt(0) lgkmcnt(0)" : "+v"(lane2) :: "memory");
        __syncthreads();
        for (int t = grab(cU, lane2); t < 128; t = grab(cU, lane2)) upass_token(A, task * 128 + t, lane2);
        asm volatile("s_waitcnt vmcnt(0)" ::: "memory");
        __syncthreads();
        vpass_wave<true>(A, task * 128, 1, 128, lane2, cV);
        __syncthreads();
    }
}
__device__ __forceinline__ void peer_vphase_local(const PeerArgs& A, int vcu, int G) {
    const int lane = threadIdx.x & 63, wid = __builtin_amdgcn_readfirstlane(threadIdx.x >> 6);
    asm volatile("s_waitcnt vmcnt(0)" ::: "memory");
    for (int task = vcu; task < 256; task += G) vpass_wave<false>(A, task * 128 + wid * 16, 1, 16, lane);
}
__device__ __forceinline__ void peer_vphase(const PeerArgs& A, int vcu, int G) {
    const int lane = threadIdx.x & 63, wid = __builtin_amdgcn_readfirstlane(threadIdx.x >> 6);
    { const int w0 = vcu * 8 + wid, nw = G * 8; if (w0 < 32768) vpass_wave<false>(A, w0, nw, (32768 - w0 + nw - 1) / nw, lane); }
}
#undef PEER_CE
}

constexpr int NWAVES = 8;
#ifndef MK_N_LAUNCHES
#define MK_N_LAUNCHES 1
#endif
constexpr int PER_PHASE = 10;
constexpr int N_LAUNCHES = MK_N_LAUNCHES;

constexpr int BATCH = 4, T = 8192, D = 1024, M = BATCH * T, NIN = 2304, NPQ = 2048, NEXP = 16384;
constexpr float EPS = 1e-6f;
constexpr float C2 = 0.125f * 1.4426950408889634f;

constexpr size_t MiB = 1u << 20;
constexpr size_t WS_CTL = 0, CTL_ZERO_BYTES = 1 * MiB;
constexpr size_t WS_TAB = 1 * MiB;
constexpr size_t WS_WIN = 2 * MiB, WS_WOUT = 8 * MiB, WS_WQ = 10 * MiB, WS_SK = 14 * MiB;
constexpr size_t WS_U = 16 * MiB, WS_V = 32 * MiB;
constexpr size_t WS_US = 48 * MiB, WS_VS = 49 * MiB, WS_XS = 50 * MiB  ;
constexpr size_t WS_H = 80 * MiB;
constexpr size_t WS_P = 144 * MiB;
constexpr size_t WS_O = 288 * MiB;
constexpr size_t WS_EI = 352 * MiB, WS_EG = 368 * MiB  , WS_EW = 400 * MiB, WS_SSA = 416 * MiB, WS_SSB = 417 * MiB, WS_X1 = 420 * MiB, WS_END = 484 * MiB;
constexpr size_t WS_Q8 = 420 * MiB, WS_K8 = 436 * MiB, WS_V8T = 440 * MiB;
constexpr int CW_BAR = 4096;
constexpr int CW_PCNT = 8192;
constexpr int CW_MOD = 131072;

constexpr int LDS_BYTES = 160 * 1024;
constexpr int MISC_OFF = LDS_BYTES - 256;

#define GAS __attribute__((address_space(1)))
#define LAS __attribute__((address_space(3)))
typedef unsigned short bf16;
typedef unsigned v4u __attribute__((ext_vector_type(4)));
typedef float f32x4 __attribute__((ext_vector_type(4)));
typedef GAS unsigned gu32;
#define RLX_AGENT __ATOMIC_RELAXED, __HIP_MEMORY_SCOPE_AGENT
#define LDS_WAIT() asm volatile("s_waitcnt lgkmcnt(0)" ::: "memory")
__device__ __forceinline__ unsigned f2bf(float f) { unsigned u = __builtin_bit_cast(unsigned, f); return (u + 0x7fffu + ((u >> 16) & 1u)) >> 16; }
__device__ __forceinline__ unsigned pk2(float lo, float hi) { return f2bf(lo) | (f2bf(hi) << 16); }

#define XB_TMO      128
#define XB_XCNT(j)  (256  + 64 * (j))
#define XB_XSUB(j)  (1280 + 64 * (j))
#define XB_XGEN(j)  (2304 + 64 * (j))
#define XB_TOP      3328
#define XB_TOPGEN   3392
#define XCD_BAR_WORDS 3456
#define XB_SPIN_CAP (1u << 20)

__device__ __forceinline__ unsigned xb_ld(unsigned* p)              { return __hip_atomic_load(p, __ATOMIC_RELAXED, __HIP_MEMORY_SCOPE_AGENT); }
__device__ __forceinline__ unsigned xb_add(unsigned* p, unsigned v) { return __hip_atomic_fetch_add(p, v, __ATOMIC_RELAXED, __HIP_MEMORY_SCOPE_AGENT); }
__device__ __forceinline__ unsigned xb_xcc_id() { return (unsigned)__builtin_amdgcn_s_getreg((3 << 11) | 20) & 0xFu; }
#define XB_SPIN(cond, bar) do { unsigned _sp = 0; while (cond) { __builtin_amdgcn_s_sleep(1); \
    if ((++_sp & 255u) == 0u) { if (xb_ld(&(bar)[XB_TMO])) break; if (_sp > XB_SPIN_CAP) { atomicAdd(&(bar)[XB_TMO], 1u); break; } } } } while (0)

struct XcdBarrier { unsigned* bar; unsigned x; volatile LAS unsigned* st; };

__device__ __forceinline__ XcdBarrier xcd_barrier_post(unsigned* bar, volatile LAS unsigned* st) {
    XcdBarrier b; b.bar = bar; b.x = xb_xcc_id(); b.st = st;
    if (threadIdx.x == 0) (void)xb_add(&bar[XB_XCNT(b.x)], 1u);
    return b;
}
__device__ __forceinline__ void xcd_barrier_complete(unsigned* bar, unsigned x, unsigned& nloc, unsigned& nx) {
    const unsigned G = gridDim.x * gridDim.y * gridDim.z;
    unsigned sum, cnt, mine, sp = 0u;
    for (;;) {
        sum = 0u; cnt = 0u; mine = 0u;
#pragma unroll
        for (unsigned j = 0; j < 16; ++j) { const unsigned c = xb_ld(&bar[XB_XCNT(j)]); sum += c; cnt += (c > 0u) ? 1u : 0u; mine = (j == x) ? c : mine; }
        if (sum == G) break;
        __builtin_amdgcn_s_sleep(1);
        if ((++sp & 255u) == 0u) { if (xb_ld(&bar[XB_TMO])) break; if (sp > XB_SPIN_CAP) { atomicAdd(&bar[XB_TMO], 1u); break; } }
    }
    nloc = mine > 0u ? mine : 1u; nx = cnt > 0u ? cnt : 1u;
}
__device__ __forceinline__ void xcd_barrier(const XcdBarrier& b) {
    asm volatile("s_waitcnt vmcnt(0)" ::: "memory");
    __syncthreads();
    if (threadIdx.x == 0) {
        unsigned* bar = b.bar;
        __builtin_amdgcn_s_waitcnt(0);
        unsigned nloc = b.st[0], nx = b.st[1];
        if (nloc == 0u) { xcd_barrier_complete(bar, b.x, nloc, nx); b.st[0] = nloc; b.st[1] = nx; }
        const unsigned old = xb_add(&bar[XB_XSUB(b.x)], 1u);
        const unsigned gen = old / nloc;
        if (old + 1u == (gen + 1u) * nloc) {
            __builtin_amdgcn_fence(__ATOMIC_RELEASE, "agent");
            asm volatile("s_waitcnt vmcnt(0)" ::: "memory");
            const unsigned og = xb_add(&bar[XB_TOP], 1u);
            const unsigned tg = og / nx;
            if (og + 1u == (tg + 1u) * nx) xb_add(&bar[XB_TOPGEN], 1u);
            else XB_SPIN(xb_ld(&bar[XB_TOPGEN]) == tg, bar);
            __builtin_amdgcn_fence(__ATOMIC_ACQUIRE, "agent");
            xb_add(&bar[XB_XGEN(b.x)], 1u);
            asm volatile("s_waitcnt vmcnt(0)" ::: "memory");
        } else {
            XB_SPIN(xb_ld(&bar[XB_XGEN(b.x)]) == gen, bar);
            __builtin_amdgcn_fence(__ATOMIC_ACQUIRE, "agent");
            asm volatile("s_waitcnt vmcnt(0)" ::: "memory");
        }
    }
    __syncthreads();
}

__device__ __forceinline__ float wave_sum(float v) {
#pragma unroll
    for (int o = 1; o < 64; o <<= 1) v += __shfl_xor(v, o);
    return v;
}
template <bool PERMUTE> __device__ __forceinline__ void p0_transpose_item(const float* W, int K, int N, bf16* WT, LAS float* scr, int item, int lane, const float* ks0 = nullptr, const float* ks1 = nullptr) {
    const int nblk = N / 32, kb = item / nblk, nb = item % nblk, k0 = 64 * kb, n0 = 32 * nb;
    int r0 = n0;
    if (PERMUTE) { const int tile = nb >> 3, ob = nb & 7, wc = ob >> 1, bj = ob & 1; r0 = tile * 256 + 32 * (4 * bj + wc); }
#pragma unroll 8
    for (int i = 0; i < 32; ++i) { const int kk = 2 * i + (lane >> 5); const int kg = k0 + kk; const float sc = ks0 ? (kg < 512 ? ks0[kg] : ks1[kg - 512]) : 1.0f; scr[kk * 33 + (lane & 31)] = W[(size_t)kg * N + n0 + (lane & 31)] * sc; }
    LDS_WAIT(); asm volatile("" ::: "memory");
    const int c = lane & 7;
#pragma unroll
    for (int j = 0; j < 4; ++j) { const int n = (lane >> 3) + 8 * j; const LAS float* s = scr + (8 * c) * 33 + n;
        v4u o; o.x = pk2(s[0 * 33], s[1 * 33]); o.y = pk2(s[2 * 33], s[3 * 33]); o.z = pk2(s[4 * 33], s[5 * 33]); o.w = pk2(s[6 * 33], s[7 * 33]);
        *(GAS v4u*)(WT + (size_t)(r0 + n) * K + k0 + 8 * c) = o; }
    LDS_WAIT(); asm volatile("" ::: "memory");
}
__device__ __forceinline__ void sincos_d(double a, double& s, double& c) {
    const double TWO_PI = 6.283185307179586476925286766559, INV = 0.15915494309189533576888376337251;
    const double k = __builtin_rint(a * INV); const double x = a - k * TWO_PI; const double x2 = x * x;
    double ts = x, tc = 1.0, ss = x, cc = 1.0;
#pragma unroll
    for (int n = 1; n <= 16; ++n) { tc = -tc * x2 / (double)((2 * n - 1) * (2 * n)); ts = -ts * x2 / (double)((2 * n) * (2 * n + 1)); cc += tc; ss += ts; }
    s = ss; c = cc;
}
__device__ __forceinline__ float silu_f(float v) { return v / (1.0f + __expf(-v)); }

struct Ptrs {
    const float *x, *c, *w_ada, *b_ada, *n1g, *w_in, *qng, *kng, *rpb, *gag, *gbg, *w_out, *n2g, *wq, *sk1, *sk2, *pu, *pv, *fng;
    float* out; unsigned char* ws;
};

template <int PART> __device__ __forceinline__ void p0_prologue(const Ptrs& A, LAS unsigned char* lds, int vcu, int G, int wave, int lane, int gw, int NGW) {
    LAS float* scr = (LAS float*)(lds + wave * 16384);
    bf16* Win_t = (bf16*)(A.ws + WS_WIN); bf16* Wout_t = (bf16*)(A.ws + WS_WOUT); bf16* Wq_t = (bf16*)(A.ws + WS_WQ);
    constexpr int I_IN = (D / 64) * (NIN / 32), I_OUT = (D / 64) * (D / 32), I_Q = (D / 64) * (NPQ / 32);
    if (PART == 0) { for (int it = gw; it < I_IN; it += NGW) p0_transpose_item<true>(A.w_in, D, NIN, Win_t, scr, it, lane); }
    else for (int it = gw; it < I_OUT + I_Q; it += NGW) {
        int r = it;
        if (r < I_OUT) { p0_transpose_item<false>(A.w_out, D, D, Wout_t, scr, r, lane, A.gag, A.gbg); continue; } r -= I_OUT;
        p0_transpose_item<false>(A.wq, D, NPQ, Wq_t, scr, r, lane);
    }
    if (PART == 1) {
        typedef float v16f __attribute__((ext_vector_type(16))); typedef unsigned v6u __attribute__((ext_vector_type(6)));
        unsigned char* U6 = A.ws + WS_U; unsigned char* V6 = A.ws + WS_V; float* USc = (float*)(A.ws + WS_US); float* VSc = (float*)(A.ws + WS_VS);
        const int hw = lane >> 5, l32 = lane & 31;
        const int wg_ = gw / NWAVES, nwg_ = NGW / NWAVES;
        LAS int* tkc = (LAS int*)(lds + LDS_BYTES - 256 + 26 * 4);
        for (;;) {
            int k_ = 0; if (lane == 0) k_ = __hip_atomic_fetch_add(tkc, 1, __ATOMIC_RELAXED, __HIP_MEMORY_SCOPE_WORKGROUP);
            const int it = wg_ + __builtin_amdgcn_readfirstlane(k_) * nwg_;
            if (it >= NEXP) break;
            const int r = 2 * it + hw; const bool isv = r >= NEXP; const int row = isv ? r - NEXP : r;
            const float* src = (isv ? A.pv : A.pu) + (size_t)row * D + l32 * 32;
            f32x4 v[8]; float mx = 0.f;
#pragma unroll
            for (int j = 0; j < 8; ++j) { v[j] = *(const GAS f32x4*)(src + 4 * j); mx = fmaxf(mx, fmaxf(fmaxf(fabsf(v[j][0]), fabsf(v[j][1])), fmaxf(fabsf(v[j][2]), fabsf(v[j][3])))); }
#pragma unroll
            for (int o = 1; o < 32; o <<= 1) mx = fmaxf(mx, __shfl_xor(mx, o));
            const float sc = mx > 0.f ? __uint_as_float(__float_as_uint(7.5f / mx) & 0x7f800000u) : 1.0f;
            v16f a, b;
#pragma unroll
            for (int j = 0; j < 4; ++j)
#pragma unroll
                for (int i = 0; i < 4; ++i) { a[4 * j + i] = v[2 * j + (i >> 1)][2 * (i & 1)] * sc; b[4 * j + i] = v[2 * j + (i >> 1)][2 * (i & 1) + 1] * sc; }
            const v6u q = __builtin_amdgcn_cvt_scalef32_2xpk16_fp6_f32(a, b, 1.0f);
            if (isv) {
                unsigned char* dst = V6 + (size_t)row * 768;
                *(GAS v4u*)(dst + 16 * l32) = (v4u){q[0], q[1], q[2], q[3]};
                *(GAS unsigned long long*)(dst + 512 + 8 * l32) = (unsigned long long)q[4] | ((unsigned long long)q[5] << 32);
            } else {
                unsigned char* dst = U6 + (size_t)row * 768 + 16 * (l32 >> 1);
                if ((l32 & 1) == 0) { *(GAS v4u*)dst = (v4u){q[0], q[1], q[2], q[3]}; *(GAS unsigned long long*)(dst + 256) = (unsigned long long)q[4] | ((unsigned long long)q[5] << 32); }
                else { *(GAS unsigned long long*)(dst + 256 + 8) = (unsigned long long)q[0] | ((unsigned long long)q[1] << 32); *(GAS v4u*)(dst + 512) = (v4u){q[2], q[3], q[4], q[5]}; }
            }
            if (l32 == 0) (isv ? VSc : USc)[row] = 1.0f / sc;
        }
        bf16* SKb = (bf16*)(A.ws + WS_SK);
        for (int it = gw; it < 64; it += NGW) {
            const float* src = it < 32 ? A.sk1 : A.sk2; const int r = it & 31;
            const size_t e = (size_t)r * 512 + lane * 8;
            const f32x4 a = *(const GAS f32x4*)(src + e), b = *(const GAS f32x4*)(src + e + 4);
            v4u o; o.x = pk2(a[0], a[1]); o.y = pk2(a[2], a[3]); o.z = pk2(b[0], b[1]); o.w = pk2(b[2], b[3]);
            *(GAS v4u*)(SKb + (it < 32 ? 0 : 16384) + e) = o;
        }
    }
    if (PART == 0) {
        float* rc = (float*)(A.ws + WS_TAB); float* rs = rc + 128 * 16;
        const int gt = gw * 64 + lane;
        if (gt < 128 * 16) {
            const int pos = gt >> 4, i = gt & 15;
            const double f4[4] = {1.0, 0.56234132519034908039495103977648, 0.31622776601683793319988935444327, 0.17782794100389228012254211951927};
            double fr = (i & 3) == 0 ? f4[0] : ((i & 3) == 1 ? f4[1] : ((i & 3) == 2 ? f4[2] : f4[3]));
            fr *= (i >> 2) == 0 ? 1.0 : ((i >> 2) == 1 ? 0.1 : ((i >> 2) == 2 ? 0.01 : 0.001));
            double s, c; sincos_d((double)pos * fr, s, c);
            rc[gt] = (float)c; rs[gt] = (float)s;
        }
    }
    if (PART == 0) {
        float* mod = (float*)(A.ws + WS_CTL) + CW_MOD;
        LAS float* part = (LAS float*)(lds + 131072);
        LAS float* sc_l = (LAS float*)(lds + 131072 + 8192);
        if (vcu < 96) { for (int i = threadIdx.x; i < 4096; i += 512) sc_l[i] = silu_f(A.c[i]); __syncthreads(); }
        for (int it = vcu; it < 96; it += G) {
            const int col = it * 64 + lane;
            float acc[4] = {0.f, 0.f, 0.f, 0.f};
#pragma unroll 16
            for (int k = 0; k < 128; ++k) {
                const int kk = wave * 128 + k;
                const float w = A.w_ada[(size_t)kk * 6144 + col];
#pragma unroll
                for (int b = 0; b < 4; ++b) acc[b] += w * sc_l[b * 1024 + kk];
            }
#pragma unroll
            for (int b = 0; b < 4; ++b) part[(wave * 4 + b) * 64 + lane] = acc[b];
            __syncthreads();
            if (wave < 4) {
                float s = A.b_ada[col];
#pragma unroll
                for (int w8 = 0; w8 < 8; ++w8) s += part[(w8 * 4 + wave) * 64 + lane];
                mod[wave * 6144 + col] = s;
            }
            __syncthreads();
        }
    }
}
__device__ __forceinline__ void modnorm_row(const float* xrow, const float* g, const float* shift, const float* scale, bf16* orow, int lane) {
    const GAS f32x4* xr = (const GAS f32x4*)xrow + lane;
    f32x4 v[4]; float s = 0.f;
#pragma unroll
    for (int j = 0; j < 4; ++j) { v[j] = xr[64 * j]; s += (v[j].x * v[j].x + v[j].y * v[j].y) + (v[j].z * v[j].z + v[j].w * v[j].w); }
    const float rinv = 1.0f / sqrtf(wave_sum(s) * (1.0f / D) + EPS);
    GAS unsigned long long* o8 = (GAS unsigned long long*)orow + lane;
#pragma unroll
    for (int j = 0; j < 4; ++j) {
        const f32x4 gv = *((const f32x4*)g + lane + 64 * j), sh = *((const f32x4*)shift + lane + 64 * j), sc = *((const f32x4*)scale + lane + 64 * j);
        const f32x4 y = v[j] * rinv * gv * (sc + 1.0f) + sh;
        o8[64 * j] = (unsigned long long)pk2(y.x, y.y) | ((unsigned long long)pk2(y.z, y.w) << 32);
    }
}
__device__ __forceinline__ void modnorm_row_b(const bf16* xrow, const float* g, const float* shift, const float* scale, bf16* orow, int lane) {
    float f[2][8]; float s = 0.f;
#pragma unroll
    for (int j = 0; j < 2; ++j) { const v4u w = *(const GAS v4u*)(xrow + 512 * j + lane * 8);
        f[j][0] = __uint_as_float(w.x << 16); f[j][1] = __uint_as_float(w.x & 0xffff0000u); f[j][2] = __uint_as_float(w.y << 16); f[j][3] = __uint_as_float(w.y & 0xffff0000u);
        f[j][4] = __uint_as_float(w.z << 16); f[j][5] = __uint_as_float(w.z & 0xffff0000u); f[j][6] = __uint_as_float(w.w << 16); f[j][7] = __uint_as_float(w.w & 0xffff0000u);
#pragma unroll
        for (int i = 0; i < 8; ++i) s += f[j][i] * f[j][i]; }
    const float rinv = 1.0f / sqrtf(wave_sum(s) * (1.0f / D) + EPS);
#pragma unroll
    for (int j = 0; j < 2; ++j) { const int c = 512 * j + lane * 8; float y[8];
#pragma unroll
        for (int q = 0; q < 2; ++q) { const f32x4 gv = *(const f32x4*)(g + c + 4 * q), sh = *(const f32x4*)(shift + c + 4 * q), sc = *(const f32x4*)(scale + c + 4 * q);
#pragma unroll
            for (int i = 0; i < 4; ++i) y[4 * q + i] = f[j][4 * q + i] * rinv * gv[i] * (sc[i] + 1.0f) + sh[i]; }
        v4u o; o.x = pk2(y[0], y[1]); o.y = pk2(y[2], y[3]); o.z = pk2(y[4], y[5]); o.w = pk2(y[6], y[7]);
        *(GAS v4u*)(orow + c) = o; }
}
__device__ __forceinline__ void groupnorm_row(const bf16* orow, const float* ga, const float* gb, bf16* mrow, int lane) {
#pragma unroll
    for (int j = 0; j < 2; ++j) {
        const v4u w = *(const GAS v4u*)(orow + 512 * j + lane * 8);
        float f[8]; f[0] = __uint_as_float(w.x << 16); f[1] = __uint_as_float(w.x & 0xffff0000u); f[2] = __uint_as_float(w.y << 16); f[3] = __uint_as_float(w.y & 0xffff0000u);
        f[4] = __uint_as_float(w.z << 16); f[5] = __uint_as_float(w.z & 0xffff0000u); f[6] = __uint_as_float(w.w << 16); f[7] = __uint_as_float(w.w & 0xffff0000u);
        float s = 0.f;
#pragma unroll
        for (int i = 0; i < 8; ++i) s += f[i] * f[i];
        const float rinv = 1.0f / sqrtf(wave_sum(s) * (1.0f / 512.0f) + EPS);
        const float* gp = (j ? gb : ga) + lane * 8;
        const f32x4 g0 = *(const f32x4*)gp, g1 = *(const f32x4*)(gp + 4);
        v4u o; o.x = pk2(f[0] * rinv * g0[0], f[1] * rinv * g0[1]); o.y = pk2(f[2] * rinv * g0[2], f[3] * rinv * g0[3]); o.z = pk2(f[4] * rinv * g1[0], f[5] * rinv * g1[1]); o.w = pk2(f[6] * rinv * g1[2], f[7] * rinv * g1[3]);
        *(GAS v4u*)(mrow + 512 * j + lane * 8) = o;
    }
}

struct Args { Ptrs p; int ph_lo, ph_hi; };
__global__ void __launch_bounds__(NWAVES * 64, 2) hymba_fwd(Args args) {
    extern __shared__ __attribute__((aligned(16))) unsigned char lds_raw[];
    LAS unsigned char* lds = (LAS unsigned char*)lds_raw;
    volatile LAS unsigned* MISC = (volatile LAS unsigned*)(lds + MISC_OFF);
    const Ptrs& A = args.p;
    const int tid = threadIdx.x, lane = tid & 63, wave = __builtin_amdgcn_readfirstlane(tid >> 6);
    const int G = gridDim.x; const int bx = blockIdx.x; const int vcu = (G % 8 == 0) ? (bx % 8) * (G / 8) + bx / 8 : bx;
    gu32* ctl = (gu32*)(A.ws + WS_CTL);
    if (tid < 64) MISC[tid] = 0u;
    __syncthreads();
    XcdBarrier bar; bar.bar = (unsigned*)(ctl + CW_BAR); bar.x = 0; bar.st = nullptr;
    if (N_LAUNCHES != PER_PHASE) bar = xcd_barrier_post((unsigned*)(ctl + CW_BAR), MISC + 8);
#define GRID_BAR() do { if (N_LAUNCHES != PER_PHASE) xcd_barrier(bar); } while (0)
    const int lo = args.ph_lo, hi = args.ph_hi;
#define IN(k) (lo <= (k) && (k) < hi)
#define BOTH(k) (IN(k) && IN((k) + 1))
    const float* mod = (const float*)(A.ws + WS_CTL) + CW_MOD;
    bf16* Hb = (bf16*)(A.ws + WS_H); bf16* Pb = (bf16*)(A.ws + WS_P); bf16* Ob = (bf16*)(A.ws + WS_O);
    const int gw = vcu * NWAVES + wave, NGW = G * NWAVES;

    if (IN(0)) { p0_prologue<0>(A, lds, vcu, G, wave, lane, gw, NGW); if (BOTH(0)) GRID_BAR(); }
    if (IN(1)) {
        for (int m = gw; m < M; m += NGW) { const float* md = mod + (m >> 13) * 6144; modnorm_row(A.x + (size_t)m * D, A.n1g, md, md + 1024, Hb + (size_t)m * D, lane); }
        if (BOTH(1)) GRID_BAR();
    }
    if (IN(2)) {
        pg8::Gemm g{Hb, (const bf16*)(A.ws + WS_WIN), M, NIN, D}; pg8::StaticOrder S; S.init(M, NIN, G, bx);
        { const float* tab = (const float*)(A.ws + WS_TAB); LAS float* tl = (LAS float*)(lds + 131072);
          for (int i = tid; i < 2 * 128 * 16; i += NWAVES * 64) tl[i] = tab[i];
          __syncthreads(); }
        pg8::EpiInProj E{Pb, A.ws + WS_Q8, A.ws + WS_K8, A.ws + WS_V8T, A.qng, A.kng, (const LAS float*)(lds + 131072), (const LAS float*)(lds + 131072) + 128 * 16, C2};
        pg8::gemm_phase<pg8::EpiInProj, pg8::StaticOrder, true, true>(lds, g, S, E);
        {
            const int nunits = (M / 256) * (NIN / 256), rounds = (nunits + G - 1) / G, busy = nunits - (rounds - 1) * G, nidle = G - busy;
            if (tid == 0) MISC[26] = 0u;
            __syncthreads();
            if (nidle == 0) p0_prologue<1>(A, lds, vcu, G, wave, lane, bx * NWAVES + wave, G * NWAVES);
            else if (bx >= busy) p0_prologue<1>(A, lds, vcu, G, wave, lane, (bx - busy) * NWAVES + wave, nidle * NWAVES);
        }
        if (BOTH(2)) GRID_BAR();
    }
    if (IN(3)) {
        float cb; { const float gq = fabsf(A.qng[lane]), gk = fabsf(A.kng[lane]); float mq = gq, mk = gk;
#pragma unroll
            for (int o = 1; o < 64; o <<= 1) { mq = fmaxf(mq, __shfl_xor(mq, o)); mk = fmaxf(mk, __shfl_xor(mk, o)); }
            cb = 8.0f * 1.4426950408889634f * mq * mk; }
        const attn8::Tensors AT{A.ws + WS_Q8, A.ws + WS_K8, A.ws + WS_V8T, Ob, (float*)(A.ws + WS_SSA)};
        attn8::phase((char*)lds_raw, AT, G, bx, cb - 8.0f);
        __syncthreads();
        natten::natten_phase(lds, Pb + 768, Pb + 1280, Pb + 1792, A.rpb, Ob, (float*)(A.ws + WS_SSB), vcu, G);
        if (BOTH(3)) GRID_BAR();
    }
    if (IN(5)) {
        pg8::Gemm g{Ob, (const bf16*)(A.ws + WS_WOUT), M, D, D}; pg8::StaticOrder S; S.init(M, D, G, bx);
        pg8::EpiX1N E{A.x, (bf16*)(A.ws + WS_X1), Hb, mod, A.n2g, (const float*)(A.ws + WS_SSA), (const float*)(A.ws + WS_SSB), (LAS float*)(lds + 131072), (unsigned*)(A.ws + WS_XS), (unsigned*)(ctl + CW_PCNT)};
        E.prep(S);
        pg8::gemm_phase<pg8::EpiX1N, pg8::StaticOrder, true, true>(lds, g, S, E);
        if (BOTH(5)) GRID_BAR();
    }
    if (IN(7)) {
        pg8::Gemm g{Hb, (const bf16*)(A.ws + WS_WQ), M, NPQ, D}; pg8::StaticOrder S; S.init(M, NPQ, G, bx);
        pg8::EpiBf16 E{Pb, NPQ};
        pg8::gemm_phase<pg8::EpiBf16, pg8::StaticOrder, true, true>(lds, g, S, E);
        if (BOTH(7)) GRID_BAR();
    }
    if (IN(8) || IN(9)) {
        peer::PeerArgs PA{Pb, (const bf16*)(A.ws + WS_SK), Hb, A.ws + WS_U, A.ws + WS_V, (const float*)(A.ws + WS_US), (const float*)(A.ws + WS_VS), (int*)(A.ws + WS_EI), (float*)(A.ws + WS_EG), (float*)(A.ws + WS_EW), (const bf16*)(A.ws + WS_X1), A.out, mod, A.fng};
        if (IN(8)) peer::peer_phase(lds, PA, vcu, G, wave);
    }
#undef IN
#undef BOTH
#undef GRID_BAR
}

extern "C" void kernel_launch(void* const* d_in, const int* in_sizes, int n_in, void* d_out, int out_size, void* d_ws, size_t ws_size, hipStream_t stream) {
    static int grid = 0;
    if (grid == 0) {
        if (n_in != 19 || in_sizes[0] != M * D || out_size != M * D || ws_size < WS_END) { fprintf(stderr, "kernel_launch: unexpected problem shape (n_in %d, in0 %d, out %d, ws %zu); nothing launched\n", n_in, n_in > 0 ? in_sizes[0] : -1, out_size, ws_size); grid = -1; return; }
        int dev = 0, cus = 0, per_cu = 0;
        if (hipGetDevice(&dev) != hipSuccess || hipDeviceGetAttribute(&cus, hipDeviceAttributeMultiprocessorCount, dev) != hipSuccess) { grid = -1; return; }
        if (hipFuncSetAttribute((const void*)hymba_fwd, hipFuncAttributeMaxDynamicSharedMemorySize, LDS_BYTES) != hipSuccess) { fprintf(stderr, "kernel_launch: hipFuncSetAttribute failed\n"); grid = -1; return; }
        if (hipOccupancyMaxActiveBlocksPerMultiprocessor(&per_cu, (const void*)hymba_fwd, NWAVES * 64, LDS_BYTES) != hipSuccess || per_cu < 1) { fprintf(stderr, "kernel_launch: occupancy query reports %d workgroups per CU; nothing launched\n", per_cu); (void)hipGetLastError(); grid = -1; return; }
        grid = cus;
    }
    if (grid < 0) return;
    if (hipMemsetAsync((char*)d_ws + WS_CTL, 0, CTL_ZERO_BYTES, stream) != hipSuccess) { fprintf(stderr, "kernel_launch: hipMemsetAsync failed\n"); return; }
    Args a{};
    a.p.x = (const float*)d_in[0]; a.p.c = (const float*)d_in[1]; a.p.w_ada = (const float*)d_in[2]; a.p.b_ada = (const float*)d_in[3]; a.p.n1g = (const float*)d_in[4];
    a.p.w_in = (const float*)d_in[5]; a.p.qng = (const float*)d_in[6]; a.p.kng = (const float*)d_in[7]; a.p.rpb = (const float*)d_in[8]; a.p.gag = (const float*)d_in[9];
    a.p.gbg = (const float*)d_in[10]; a.p.w_out = (const float*)d_in[11]; a.p.n2g = (const float*)d_in[12]; a.p.wq = (const float*)d_in[13]; a.p.sk1 = (const float*)d_in[14];
    a.p.sk2 = (const float*)d_in[15]; a.p.pu = (const float*)d_in[16]; a.p.pv = (const float*)d_in[17]; a.p.fng = (const float*)d_in[18];
    a.p.out = (float*)d_out; a.p.ws = (unsigned char*)d_ws;
    for (int li = 0; li < N_LAUNCHES; ++li) {
        a.ph_lo = (N_LAUNCHES == PER_PHASE) ? li : 0; a.ph_hi = (N_LAUNCHES == PER_PHASE) ? li + 1 : PER_PHASE;
        hipLaunchKernelGGL(hymba_fwd, dim3(grid), dim3(NWAVES * 64), LDS_BYTES, stream, a);
        const hipError_t le = hipPeekAtLastError();
        if (le != hipSuccess) { fprintf(stderr, "kernel_launch: launch %d failed: %s\n", li, hipGetErrorName(le)); break; }
    }
}
```

```cpp
#include <hip/hip_runtime.h>
#include <hip/hip_bf16.h>
#include <cstdio>
#include <cstdint>
#include <cmath>
namespace pg8 {
#define PG8_LAS __attribute__((address_space(3)))
typedef unsigned short bf16_t;
typedef short bf16x8 __attribute__((ext_vector_type(8)));
typedef float f32x4 __attribute__((ext_vector_type(4)));
typedef unsigned u32x4 __attribute__((ext_vector_type(4)));
typedef unsigned u32x2 __attribute__((ext_vector_type(2)));
constexpr int BM = 256, BK = 64, HALF = 128, HTB = HALF * BK * 2  , STAGE_BYTES = 8 * HTB, NXCD = 8, WGM = 8;

__host__ __device__ __forceinline__ int lds_byte(int r, int c) { const int st = (r >> 4) * 2 + (c >> 5), rr = r & 15, cc = c & 31, ob = rr * 64 + cc * 2; return st * 1024 + (ob ^ (((ob >> 9) & 1) << 5)); }
__host__ __device__ __forceinline__ void stage_rc(int b, int& R, int& C) { const int st = b / 1024, sb = b % 1024, swz = sb ^ (((sb >> 9) & 1) << 5); R = (st >> 1) * 16 + swz / 64; C = (st & 1) * 32 + (swz % 64) / 2; }
__host__ __device__ __forceinline__ int perm32(int rho) { const int n = rho >> 4, i = rho & 15; return 8 * (i >> 2) + 4 * n + (i & 3); }

struct Unit { int pm, pn; };
struct Gemm { const bf16_t* A; const bf16_t* Bt; int M, N, K; };

struct StaticOrder {
    int nM, nN, nwg, G, c;
    __host__ __device__ void init(int M, int N, int G_, int c_) { nM = M / BM; nN = N / BM; nwg = nM * nN; G = G_; c = c_; }
    __host__ __device__ bool next(int i, Unit& u) const {
        const long L = (long)i * G + c; if (L >= nwg) return false;
        int wgid = (int)L; { const int q = nwg / NXCD, r = nwg % NXCD, xcd = wgid % NXCD, off = wgid / NXCD; wgid = (xcd < r ? xcd * (q + 1) : r * (q + 1) + (xcd - r) * q) + off; }
        const int nig = WGM * nN, gid = wgid / nig, fm = gid * WGM, gsz = (nM - fm) < WGM ? (nM - fm) : WGM;
        u.pm = fm + ((wgid % nig) % gsz); u.pn = (wgid % nig) / gsz; return true;
    }
    __device__ __forceinline__ void a_ready(const Unit&) const {}
    __device__ __forceinline__ void done(const Unit&) const {}
};

__device__ __forceinline__ unsigned cvt_pk_bf16(float lo, float hi) { unsigned r; asm volatile("v_cvt_pk_bf16_f32 %0, %1, %2" : "=v"(r) : "v"(lo), "v"(hi)); return r; }

struct EpiBf16 {
    static constexpr bool PERM = true, AFTER_DRAIN = false, MIDSCALE = false, EXCH = false;
    bf16_t* O; int ldc;
    __device__ __forceinline__ void operator()(const f32x4 (&acc)[2][2][4][2], const Unit& u, int wr, int wc, int fr, int fq) const {
        const int row0 = u.pm * BM + wr * 64 + fr; const int col0 = u.pn * BM + wc * 32 + 8 * fq;
#pragma unroll
        for (int ai = 0; ai < 2; ++ai)
#pragma unroll
            for (int m = 0; m < 4; ++m) { bf16_t* rowp = O + (size_t)(row0 + ai * HALF + m * 16) * ldc + col0;
#pragma unroll
                for (int bj = 0; bj < 2; ++bj) { const f32x4 v0 = acc[ai][bj][m][0], v1 = acc[ai][bj][m][1];
                    u32x4 w; w.x = cvt_pk_bf16(v0[0], v0[1]); w.y = cvt_pk_bf16(v0[2], v0[3]); w.z = cvt_pk_bf16(v1[0], v1[1]); w.w = cvt_pk_bf16(v1[2], v1[3]);
                    *(u32x4*)(rowp + bj * HALF) = w; } }
    }
};

typedef unsigned u32x2v __attribute__((__vector_size__(2 * sizeof(unsigned))));
struct EpiInProj {
    static constexpr bool PERM = false, AFTER_DRAIN = false, MIDSCALE = false, EXCH = false;
    bf16_t* P; unsigned char* Q8; unsigned char* K8; unsigned char* V8T;
    const float* qg; const float* kg; const PG8_LAS float* rc; const PG8_LAS float* rs; float c2;
    __device__ __forceinline__ void operator()(const f32x4 (&acc)[2][2][4][2], const Unit& u, int wr, int wc, int fr, int fq) const {
        const int pn = u.pn;
        const bool nq = pn < 2, nk = (pn == 2 && wc < 2), normed = nq || nk;
        const float sc = (nq || pn == 3 || pn == 4) ? c2 : 1.0f;
        const float* g = nq ? qg : kg;
        f32x4 gv[2][2];
#pragma unroll
        for (int bj = 0; bj < 2; ++bj)
#pragma unroll
            for (int n = 0; n < 2; ++n) gv[bj][n] = normed ? *(const f32x4*)(g + 32 * bj + 16 * n + 4 * fq) : (f32x4){1.f, 1.f, 1.f, 1.f};
        const int colb = pn * BM + 64 * wc + 4 * fq;
#pragma unroll
        for (int ai = 0; ai < 2; ++ai)
#pragma unroll
            for (int m = 0; m < 4; ++m) {
                const int row = u.pm * BM + ai * HALF + wr * 64 + m * 16 + fr;
                f32x4 v[2][2];
#pragma unroll
                for (int bj = 0; bj < 2; ++bj)
#pragma unroll
                    for (int n = 0; n < 2; ++n) v[bj][n] = acc[ai][bj][m][n];
                if (normed) {
                    float ss = 0.f;
#pragma unroll
                    for (int bj = 0; bj < 2; ++bj)
#pragma unroll
                        for (int n = 0; n < 2; ++n) { const f32x4 x = v[bj][n]; ss += (x[0] * x[0] + x[1] * x[1]) + (x[2] * x[2] + x[3] * x[3]); }
                    ss += __shfl_xor(ss, 16); ss += __shfl_xor(ss, 32);
                    const float rinv = 1.0f / sqrtf(ss * (1.0f / 64.0f) + 1e-6f);
                    const int t = row & 8191, prow = t >> 6, pcol = t & 63;
#pragma unroll
                    for (int bj = 0; bj < 2; ++bj) {
                        const int pos = bj ? pcol : prow;
                        const f32x4 c4 = *(const PG8_LAS f32x4*)(rc + pos * 16 + 4 * fq), s4 = *(const PG8_LAS f32x4*)(rs + pos * 16 + 4 * fq);
                        const f32x4 x1 = v[bj][0] * rinv * gv[bj][0], x2 = v[bj][1] * rinv * gv[bj][1];
                        v[bj][0] = x1 * c4 - x2 * s4; v[bj][1] = x1 * s4 + x2 * c4;
                    }
                }
                const int coff = (fq & 1) ? 12 + 4 * fq : 4 * fq;
                if (pn > 2) {
                    bf16_t* rowp = P + (size_t)row * 2304 + pn * BM + 64 * wc + coff;
#pragma unroll
                    for (int bj = 0; bj < 2; ++bj) { const f32x4 x = v[bj][0] * sc, y = v[bj][1] * sc;
                        const u32x2v s0 = __builtin_amdgcn_permlane16_swap(cvt_pk_bf16(x[0], x[1]), cvt_pk_bf16(y[0], y[1]), false, false), s1 = __builtin_amdgcn_permlane16_swap(cvt_pk_bf16(x[2], x[3]), cvt_pk_bf16(y[2], y[3]), false, false);
                        u32x4 w; w.x = s0[0]; w.y = s1[0]; w.z = s0[1]; w.w = s1[1]; *(u32x4*)(rowp + 32 * bj) = w; }
                } else {
                    const float fs = nq ? sc * 4.0f : (nk ? 0.25f : 8.0f);
                    if (nq || nk) {
#pragma unroll
                        for (int bj = 0; bj < 2; ++bj) { const f32x4 x = v[bj][0] * fs, y = v[bj][1] * fs;
                            unsigned w0 = (unsigned)__builtin_amdgcn_cvt_pk_fp8_f32(x[0], x[1], 0, false); w0 = (unsigned)__builtin_amdgcn_cvt_pk_fp8_f32(x[2], x[3], (int)w0, true);
                            unsigned w1 = (unsigned)__builtin_amdgcn_cvt_pk_fp8_f32(y[0], y[1], 0, false); w1 = (unsigned)__builtin_amdgcn_cvt_pk_fp8_f32(y[2], y[3], (int)w1, true);
                            const u32x2v s0 = __builtin_amdgcn_permlane16_swap(w0, w1, false, false); u32x2 w; w.x = s0[0]; w.y = s0[1];
                            if (nq) *(u32x2*)(Q8 + (size_t)row * 512 + pn * 256 + 64 * wc + 32 * bj + coff) = w;
                            else    *(u32x2*)(K8 + (size_t)row * 128 + 64 * wc + 32 * bj + coff) = w; }
                    } else
#pragma unroll
                    for (int bj = 0; bj < 2; ++bj)
#pragma unroll
                        for (int n = 0; n < 2; ++n) { const f32x4 x = v[bj][n] * fs;
                            unsigned w = (unsigned)__builtin_amdgcn_cvt_pk_fp8_f32(x[0], x[1], 0, false); w = (unsigned)__builtin_amdgcn_cvt_pk_fp8_f32(x[2], x[3], (int)w, true);
                            const int d = 32 * bj + 16 * n + 4 * fq;
                            { const int t = row & 8191, kap = t & 63; const int kp = 32 * ((kap >> 2) & 1) + 16 * (kap >> 5) + (kap & 3) + 4 * ((kap & 31) >> 3);
                                unsigned char* vp = V8T + ((size_t)(((row >> 13) * 2 + (wc - 2)) * 64 + d)) * 8192 + (t & ~63) + kp;
                                vp[0] = (unsigned char)(w & 0xffu); vp[8192] = (unsigned char)((w >> 8) & 0xffu); vp[2 * 8192] = (unsigned char)((w >> 16) & 0xffu); vp[3 * 8192] = (unsigned char)(w >> 24); } }
                }
            }
    }
};

struct EpiX1 {
    static constexpr bool PERM = true, AFTER_DRAIN = false, MIDSCALE = true, EXCH = false;
    const float* x; bf16_t* out; const float* mod;
    const float* ssa; const float* ssb;
    PG8_LAS float* rsl;
    template <class Sched> __device__ __forceinline__ void prep(const Sched& S) const {
        Unit u;
        for (int i = 0; S.next(i, u); ++i) {
            if (threadIdx.x < 256) { const size_t r = (size_t)(u.pm * BM + threadIdx.x) * 8;
                const f32x4 a0 = *(const f32x4*)(ssa + r), a1 = *(const f32x4*)(ssa + r + 4), b0 = *(const f32x4*)(ssb + r), b1 = *(const f32x4*)(ssb + r + 4);
                const float sa = ((a0[0] + a0[1]) + (a0[2] + a0[3])) + ((a1[0] + a1[1]) + (a1[2] + a1[3])), sb = ((b0[0] + b0[1]) + (b0[2] + b0[3])) + ((b1[0] + b1[1]) + (b1[2] + b1[3]));
                const float ra = 1.0f / sqrtf(sa * (1.0f / 512.0f) + 1e-6f), rb = 1.0f / sqrtf(sb * (1.0f / 512.0f) + 1e-6f);
                rsl[(i * 256 + threadIdx.x) * 2] = ra / rb; rsl[(i * 256 + threadIdx.x) * 2 + 1] = rb; }
        }
        __syncthreads();
    }
    __device__ __forceinline__ void mid_scale(f32x4 (&acc)[2][2][4][2], int ui, int wr, int fr) const {
#pragma unroll
        for (int ai = 0; ai < 2; ++ai)
#pragma unroll
            for (int m = 0; m < 4; ++m) { const float sc = rsl[(ui * 256 + ai * HALF + wr * 64 + m * 16 + fr) * 2];
#pragma unroll
                for (int bj = 0; bj < 2; ++bj)
#pragma unroll
                    for (int n = 0; n < 2; ++n) acc[ai][bj][m][n] = acc[ai][bj][m][n] * sc; }
    }
    __device__ __forceinline__ void operator()(const f32x4 (&acc)[2][2][4][2], const Unit& u, int wr, int wc, int fr, int fq, int ui) const {
        const int col0 = u.pn * BM + wc * 32 + 8 * fq;
        const int b = (u.pm * BM) >> 13;
        f32x4 gt[2][2];
#pragma unroll
        for (int bj = 0; bj < 2; ++bj)
#pragma unroll
            for (int n = 0; n < 2; ++n) gt[bj][n] = *(const f32x4*)(mod + b * 6144 + 2048 + col0 + bj * HALF + 4 * n);
#pragma unroll
        for (int ai = 0; ai < 2; ++ai) {
            f32x4 xv[4][2][2];
#pragma unroll
            for (int m = 0; m < 4; ++m) { const size_t off = (size_t)(u.pm * BM + ai * HALF + wr * 64 + m * 16 + fr) * 1024 + col0;
#pragma unroll
                for (int bj = 0; bj < 2; ++bj)
#pragma unroll
                    for (int n = 0; n < 2; ++n) xv[m][bj][n] = *(const f32x4*)(x + off + bj * HALF + 4 * n); }
#pragma unroll
            for (int m = 0; m < 4; ++m) { const size_t off = (size_t)(u.pm * BM + ai * HALF + wr * 64 + m * 16 + fr) * 1024 + col0;
                const float fin = rsl[(ui * 256 + ai * HALF + wr * 64 + m * 16 + fr) * 2 + 1];
#pragma unroll
                for (int bj = 0; bj < 2; ++bj) { const f32x4 y0 = xv[m][bj][0] + gt[bj][0] * (acc[ai][bj][m][0] * fin), y1 = xv[m][bj][1] + gt[bj][1] * (acc[ai][bj][m][1] * fin);
                    u32x4 w; w.x = cvt_pk_bf16(y0[0], y0[1]); w.y = cvt_pk_bf16(y0[2], y0[3]); w.z = cvt_pk_bf16(y1[0], y1[1]); w.w = cvt_pk_bf16(y1[2], y1[3]);
                    *(u32x4*)(out + off + bj * HALF) = w; } }
        }
    }
};

struct EpiX1N {
    static constexpr bool PERM = true, AFTER_DRAIN = false, MIDSCALE = true, EXCH = true;
    const float* x; bf16_t* out; bf16_t* h2; const float* mod; const float* n2g;
    const float* ssa; const float* ssb;
    PG8_LAS float* rsl;
    unsigned* xs; unsigned* cnt;
    template <class Sched> __device__ __forceinline__ void prep(const Sched& S) const {
        Unit u;
        for (int i = 0; S.next(i, u); ++i) {
            if (threadIdx.x < 256) { const size_t r = (size_t)(u.pm * BM + threadIdx.x) * 8;
                const f32x4 a0 = *(const f32x4*)(ssa + r), a1 = *(const f32x4*)(ssa + r + 4), b0 = *(const f32x4*)(ssb + r), b1 = *(const f32x4*)(ssb + r + 4);
                const float sa = ((a0[0] + a0[1]) + (a0[2] + a0[3])) + ((a1[0] + a1[1]) + (a1[2] + a1[3])), sb = ((b0[0] + b0[1]) + (b0[2] + b0[3])) + ((b1[0] + b1[1]) + (b1[2] + b1[3]));
                const float ra = 1.0f / sqrtf(sa * (1.0f / 512.0f) + 1e-6f), rb = 1.0f / sqrtf(sb * (1.0f / 512.0f) + 1e-6f);
                rsl[(i * 256 + threadIdx.x) * 2] = ra / rb; rsl[(i * 256 + threadIdx.x) * 2 + 1] = rb; }
        }
        __syncthreads();
    }
    __device__ __forceinline__ void mid_scale(f32x4 (&acc)[2][2][4][2], int ui, int wr, int fr) const {
#pragma unroll
        for (int ai = 0; ai < 2; ++ai)
#pragma unroll
            for (int m = 0; m < 4; ++m) { const float sc = rsl[(ui * 256 + ai * HALF + wr * 64 + m * 16 + fr) * 2];
#pragma unroll
                for (int bj = 0; bj < 2; ++bj)
#pragma unroll
                    for (int n = 0; n < 2; ++n) acc[ai][bj][m][n] = acc[ai][bj][m][n] * sc; }
    }
    __device__ __forceinline__ void operator()(f32x4 (&acc)[2][2][4][2], const Unit& u, int wr, int wc, int fr, int fq, int ui, int wid, int lane) const {
        unsigned lb = (unsigned)(size_t)rsl; asm volatile("" : "+s"(lb));
        PG8_LAS float* R = (PG8_LAS float*)lb; PG8_LAS float* P = R + 1024; PG8_LAS float* S = R + 2048;
        int r0 = wr * 64 + fr; asm volatile("" : "+v"(r0));
        const int col0 = u.pn * BM + wc * 32 + 8 * fq;
        const int b = (u.pm * BM) >> 13;
        {
            f32x4 gt[2][2];
#pragma unroll
            for (int bj = 0; bj < 2; ++bj)
#pragma unroll
                for (int n = 0; n < 2; ++n) gt[bj][n] = *(const f32x4*)(mod + b * 6144 + 2048 + col0 + bj * HALF + 4 * n);
#pragma unroll
            for (int ai = 0; ai < 2; ++ai) {
                f32x4 xv[4][2][2];
#pragma unroll
                for (int m = 0; m < 4; ++m) { const size_t off = (size_t)(u.pm * BM + ai * HALF + m * 16 + r0) * 1024 + col0;
#pragma unroll
                    for (int bj = 0; bj < 2; ++bj)
#pragma unroll
                        for (int n = 0; n < 2; ++n) xv[m][bj][n] = *(const f32x4*)(x + off + bj * HALF + 4 * n); }
#pragma unroll
                for (int m = 0; m < 4; ++m) { const int r = ai * HALF + m * 16 + r0;
                    const float fin = R[(ui * 256 + r) * 2 + 1]; float s = 0.f;
#pragma unroll
                    for (int bj = 0; bj < 2; ++bj)
#pragma unroll
                        for (int n = 0; n < 2; ++n) { const f32x4 y = xv[m][bj][n] + gt[bj][n] * (acc[ai][bj][m][n] * fin); acc[ai][bj][m][n] = y; s += (y[0] * y[0] + y[1] * y[1]) + (y[2] * y[2] + y[3] * y[3]); }
                    s += __shfl_xor(s, 16); s += __shfl_xor(s, 32);
                    if (fq == 0) P[r * 4 + wc] = s; }
            }
        }
        asm volatile("s_waitcnt lgkmcnt(0)" ::: "memory"); __builtin_amdgcn_s_barrier(); asm volatile("" ::: "memory");
        int row = wid * 32 + (lane & 31); asm volatile("" : "+v"(row));
        if (lane < 32) { const f32x4 p = *(const PG8_LAS f32x4*)(P + row * 4);
            __hip_atomic_store(xs + (size_t)(u.pm * BM + row) * 4 + u.pn, __builtin_bit_cast(unsigned, (p[0] + p[1]) + (p[2] + p[3])), __ATOMIC_RELAXED, __HIP_MEMORY_SCOPE_AGENT); }
        asm volatile("s_waitcnt vmcnt(0)" ::: "memory");
        if (lane == 0) __hip_atomic_fetch_add(cnt + 64 * u.pm, 1u, __ATOMIC_RELAXED, __HIP_MEMORY_SCOPE_AGENT);
        if (wid == 0) {
            unsigned sp = 0u;
            while ((unsigned)__builtin_amdgcn_readfirstlane(__hip_atomic_load(cnt + 64 * u.pm, __ATOMIC_RELAXED, __HIP_MEMORY_SCOPE_AGENT)) < 32u) { __builtin_amdgcn_s_sleep(1); if (++sp > (1u << 22)) break; }
            __builtin_amdgcn_fence(__ATOMIC_ACQUIRE, "agent");
        }
        asm volatile("s_waitcnt vmcnt(0) lgkmcnt(0)" ::: "memory"); __builtin_amdgcn_s_barrier(); asm volatile("" ::: "memory");
        if (lane < 32) { const unsigned* sl = xs + (size_t)(u.pm * BM + row) * 4; float t = 0.f;
#pragma unroll
            for (int k = 0; k < 4; ++k) t += __builtin_bit_cast(float, __hip_atomic_load(sl + k, __ATOMIC_RELAXED, __HIP_MEMORY_SCOPE_AGENT));
            S[row] = 1.0f / sqrtf(t * (1.0f / 1024.0f) + 1e-6f); }
        asm volatile("s_waitcnt lgkmcnt(0)" ::: "memory"); __builtin_amdgcn_s_barrier(); asm volatile("" ::: "memory");
        f32x4 wv[2][2], sv[2][2];
#pragma unroll
        for (int bj = 0; bj < 2; ++bj)
#pragma unroll
            for (int n = 0; n < 2; ++n) { const int c = col0 + bj * HALF + 4 * n;
                wv[bj][n] = *(const f32x4*)(n2g + c) * (*(const f32x4*)(mod + b * 6144 + 4096 + c) + 1.0f); sv[bj][n] = *(const f32x4*)(mod + b * 6144 + 3072 + c); }
#pragma unroll
        for (int ai = 0; ai < 2; ++ai)
#pragma unroll
            for (int m = 0; m < 4; ++m) { const int r = ai * HALF + m * 16 + r0; const size_t off = (size_t)(u.pm * BM + r) * 1024 + col0; const float ri = S[r];
#pragma unroll
                for (int bj = 0; bj < 2; ++bj) { const f32x4 y0 = acc[ai][bj][m][0], y1 = acc[ai][bj][m][1];
                    u32x4 w; w.x = cvt_pk_bf16(y0[0], y0[1]); w.y = cvt_pk_bf16(y0[2], y0[3]); w.z = cvt_pk_bf16(y1[0], y1[1]); w.w = cvt_pk_bf16(y1[2], y1[3]);
                    *(u32x4*)(out + off + bj * HALF) = w;
                    const f32x4 h0 = (y0 * ri) * wv[bj][0] + sv[bj][0], h1 = (y1 * ri) * wv[bj][1] + sv[bj][1];
                    u32x4 g; g.x = cvt_pk_bf16(h0[0], h0[1]); g.y = cvt_pk_bf16(h0[2], h0[3]); g.z = cvt_pk_bf16(h1[0], h1[1]); g.w = cvt_pk_bf16(h1[2], h1[3]);
                    *(u32x4*)(h2 + off + bj * HALF) = g; } }
    }
};


template <class Epi, class Sched, bool ALIGN_EPI = false, bool SP2 = false>
__device__ __forceinline__ void gemm_phase(PG8_LAS unsigned char* lds, const Gemm g, const Sched& S, const Epi& E) {
    const int tid = threadIdx.x, wid = __builtin_amdgcn_readfirstlane(tid >> 6), lane = tid & 63, wr = wid >> 2, wc = wid & 3, fr = lane & 15, fq = lane >> 4;
    const int K = g.K, nt = K / BK;
    unsigned voffA[2], voffB[2];
#pragma unroll
    for (int i = 0; i < 2; ++i) { int R, C; stage_rc(tid * 16 + i * 8192, R, C); const int Rb = Epi::PERM ? ((R & ~31) + perm32(R & 31)) : R;
        voffA[i] = (unsigned)(R * K + C) * 2u; voffB[i] = (unsigned)(Rb * K + C) * 2u; }
    const size_t kstep = (size_t)(BK * 2);
    const size_t hstep = (size_t)HALF * K * 2;
    const size_t tstep = 2 * hstep;
    const unsigned ldsw = (unsigned)wid * 1024u;
    const int aoff = lds_byte(wr * 64 + fr, fq * 8), boff = lds_byte(wc * 32 + fr, fq * 8);
#define PG8_SA(b, h) (((b) * 2 + (h)) * HTB)
#define PG8_SB(b, h) ((4 + (b) * 2 + (h)) * HTB)
#define PG8_STAGE(bufoff, gbase, voff) do { _Pragma("unroll") for (int _i = 0; _i < 2; ++_i) \
        __builtin_amdgcn_global_load_lds((const unsigned*)((const char*)(gbase) + (voff)[_i]), (PG8_LAS unsigned*)(lds + (bufoff) + ldsw + _i * 8192), 16, 0, 0); } while (0)
#define PG8_LDA(dst, b, h) do { _Pragma("unroll") for (int m = 0; m < 4; ++m) _Pragma("unroll") for (int k = 0; k < 2; ++k) dst[m][k] = *(const PG8_LAS bf16x8*)(lds + PG8_SA(b, h) + aoff + m * 2048 + k * 1024); } while (0)
#define PG8_LDB(dst, b, h) do { _Pragma("unroll") for (int n = 0; n < 2; ++n) _Pragma("unroll") for (int k = 0; k < 2; ++k) dst[n][k] = *(const PG8_LAS bf16x8*)(lds + PG8_SB(b, h) + boff + n * 2048 + k * 1024); } while (0)
#define PG8_MMA(ai, bj, At, Bt) do { __builtin_amdgcn_s_setprio(1); _Pragma("unroll") for (int m = 0; m < 4; ++m) _Pragma("unroll") for (int n = 0; n < 2; ++n) _Pragma("unroll") for (int k = 0; k < 2; ++k) \
        acc[ai][bj][m][n] = __builtin_amdgcn_mfma_f32_16x16x32_bf16(Bt[n][k], At[m][k], acc[ai][bj][m][n], 0, 0, 0); __builtin_amdgcn_s_setprio(0); } while (0)
#define PG8_WAIT_V(n) asm volatile("s_waitcnt vmcnt(" #n ")" ::: "memory")
#define PG8_WAIT_L(n) asm volatile("s_waitcnt lgkmcnt(" #n ")" ::: "memory")
#define PG8_BAR __builtin_amdgcn_s_barrier()
#define PG8_SCHED __builtin_amdgcn_sched_barrier(0)
    Unit cur, nxt; int ui = 0;
    if (!S.next(0, cur)) return;
    f32x4 acc[2][2][4][2];
#pragma unroll
    for (int a = 0; a < 2; ++a)
#pragma unroll
        for (int b = 0; b < 2; ++b)
#pragma unroll
            for (int m = 0; m < 4; ++m)
#pragma unroll
                for (int n = 0; n < 2; ++n) acc[a][b][m][n] = (f32x4){0.f, 0.f, 0.f, 0.f};
    bf16x8 At[4][2], B0[2][2], B1[2][2];
    const char* cA = (const char*)g.A + (size_t)cur.pm * tstep; const char* cB = (const char*)g.Bt + (size_t)cur.pn * tstep;
    S.a_ready(cur);
    if constexpr (SP2) {
        PG8_STAGE(PG8_SB(0, 0), cB, voffB); PG8_STAGE(PG8_SB(0, 1), cB + hstep, voffB); PG8_STAGE(PG8_SA(0, 0), cA, voffA); PG8_STAGE(PG8_SA(0, 1), cA + hstep, voffA);
        if (wr == 1) PG8_BAR;
        PG8_WAIT_V(2); PG8_BAR;
        PG8_STAGE(PG8_SB(1, 0), cB + kstep, voffB); PG8_STAGE(PG8_SA(1, 0), cA + kstep, voffA); PG8_STAGE(PG8_SB(1, 1), cB + hstep + kstep, voffB);
        PG8_WAIT_V(6); PG8_BAR;
    } else {
        PG8_STAGE(PG8_SB(0, 0), cB, voffB); PG8_STAGE(PG8_SA(0, 0), cA, voffA); PG8_STAGE(PG8_SB(0, 1), cB + hstep, voffB); PG8_STAGE(PG8_SA(0, 1), cA + hstep, voffA);
        if (wr == 1) PG8_BAR;
        PG8_WAIT_V(4); PG8_BAR;
        PG8_STAGE(PG8_SB(1, 0), cB + kstep, voffB); PG8_STAGE(PG8_SA(1, 0), cA + kstep, voffA); PG8_STAGE(PG8_SB(1, 1), cB + hstep + kstep, voffB);
        PG8_WAIT_V(6); PG8_BAR;
    }
    for (;;) {
        const bool has_next = S.next(ui + 1, nxt);
        const char* nA = has_next ? (const char*)g.A + (size_t)nxt.pm * tstep : cA; const char* nB = has_next ? (const char*)g.Bt + (size_t)nxt.pn * tstep : cB;
        for (int t = 0; t < nt; t += 2) {
            if constexpr (Epi::MIDSCALE) { if (t == nt / 2) E.mid_scale(acc, ui, wr, fr); }
            const bool last = (t == nt - 2);
            const char* a1 = cA + (size_t)(t + 1) * kstep;
            const char* a2 = last ? nA : cA + (size_t)(t + 2) * kstep; const char* b2 = last ? nB : cB + (size_t)(t + 2) * kstep;
            const char* a3 = a2 + kstep; const char* b3 = b2 + kstep;
            if (last && has_next) S.a_ready(nxt);
            if constexpr (SP2) {
            PG8_LDB(B0, 0, 0); PG8_LDB(B1, 0, 1); PG8_SCHED; PG8_LDA(At, 0, 0); PG8_STAGE(PG8_SA(1, 1), a1 + hstep, voffA);
            PG8_WAIT_V(8); PG8_WAIT_L(0); PG8_BAR; PG8_MMA(0, 0, At, B0); PG8_MMA(0, 1, At, B1); PG8_BAR; PG8_SCHED;
            PG8_LDA(At, 0, 1); PG8_STAGE(PG8_SB(0, 0), b2, voffB); PG8_STAGE(PG8_SB(0, 1), b2 + hstep, voffB); PG8_STAGE(PG8_SA(0, 0), a2, voffA);
            PG8_WAIT_V(8); PG8_WAIT_L(0); PG8_BAR; PG8_MMA(1, 0, At, B0); PG8_MMA(1, 1, At, B1); PG8_BAR; PG8_SCHED;
            PG8_LDB(B0, 1, 0); PG8_LDB(B1, 1, 1); PG8_SCHED; PG8_LDA(At, 1, 0); PG8_STAGE(PG8_SA(0, 1), a2 + hstep, voffA);
            PG8_WAIT_V(8); PG8_WAIT_L(0); PG8_BAR; PG8_MMA(0, 0, At, B0); PG8_MMA(0, 1, At, B1); PG8_BAR; PG8_SCHED;
            PG8_LDA(At, 1, 1); PG8_STAGE(PG8_SB(1, 0), b3, voffB); PG8_STAGE(PG8_SB(1, 1), b3 + hstep, voffB); PG8_STAGE(PG8_SA(1, 0), a3, voffA);
            PG8_WAIT_V(8); PG8_WAIT_L(0); PG8_BAR; PG8_MMA(1, 0, At, B0); PG8_MMA(1, 1, At, B1); PG8_BAR; PG8_SCHED;
            } else {
            PG8_LDB(B0, 0, 0); PG8_SCHED; PG8_LDA(At, 0, 0); PG8_STAGE(PG8_SA(1, 1), a1 + hstep, voffA);
            PG8_WAIT_L(8); PG8_BAR; PG8_WAIT_L(0); PG8_MMA(0, 0, At, B0); PG8_BAR; PG8_SCHED;
            PG8_LDB(B1, 0, 1); PG8_STAGE(PG8_SB(0, 0), b2, voffB);
            PG8_BAR; PG8_WAIT_L(0); PG8_MMA(0, 1, At, B1); PG8_BAR;
            PG8_LDA(At, 0, 1); PG8_STAGE(PG8_SA(0, 0), a2, voffA);
            PG8_BAR; PG8_WAIT_L(0); PG8_MMA(1, 0, At, B0); PG8_BAR; PG8_SCHED;
            PG8_STAGE(PG8_SB(0, 1), b2 + hstep, voffB);
            PG8_WAIT_V(6); PG8_BAR; PG8_MMA(1, 1, At, B1); PG8_BAR;
            PG8_LDB(B0, 1, 0); PG8_SCHED; PG8_LDA(At, 1, 0); PG8_STAGE(PG8_SA(0, 1), a2 + hstep, voffA);
            PG8_WAIT_L(8); PG8_BAR; PG8_WAIT_L(0); PG8_MMA(0, 0, At, B0); PG8_BAR; PG8_SCHED;
            PG8_LDB(B1, 1, 1); PG8_STAGE(PG8_SB(1, 0), b3, voffB);
            PG8_BAR; PG8_WAIT_L(0); PG8_MMA(0, 1, At, B1); PG8_BAR;
            PG8_LDA(At, 1, 1); PG8_STAGE(PG8_SA(1, 0), a3, voffA);
            PG8_BAR; PG8_WAIT_L(0); PG8_MMA(1, 0, At, B0); PG8_BAR; PG8_SCHED;
            PG8_STAGE(PG8_SB(1, 1), b3 + hstep, voffB);
            PG8_WAIT_V(6); PG8_BAR; PG8_MMA(1, 1, At, B1); PG8_BAR;
            }
        }
        if constexpr (ALIGN_EPI) { if (wr == 0) PG8_BAR; }
        if constexpr (!Epi::AFTER_DRAIN) { if constexpr (Epi::EXCH) E(acc, cur, wr, wc, fr, fq, ui, wid, lane); else if constexpr (Epi::MIDSCALE) E(acc, cur, wr, wc, fr, fq, ui); else E(acc, cur, wr, wc, fr, fq); S.done(cur); }
        if (!has_next) break;
#pragma unroll
        for (int a = 0; a < 2; ++a)
#pragma unroll
            for (int b = 0; b < 2; ++b)
#pragma unroll
                for (int m = 0; m < 4; ++m)
#pragma unroll
                    for (int n = 0; n < 2; ++n) acc[a][b][m][n] = (f32x4){0.f, 0.f, 0.f, 0.f};
        cur = nxt; cA = nA; cB = nB; ++ui;
        if constexpr (ALIGN_EPI) { if (wr == 1) PG8_BAR; }
    }
    PG8_WAIT_V(0);
    if constexpr (!ALIGN_EPI) { if (wr == 0) PG8_BAR; }
    PG8_BAR;
    if constexpr (Epi::AFTER_DRAIN) { E.fused(acc, cur, wr, wc, fr, fq, lds, wid, lane); S.done(cur); }
#undef PG8_SA
#undef PG8_SB
#undef PG8_STAGE
#undef PG8_LDA
#undef PG8_LDB
#undef PG8_MMA
#undef PG8_WAIT_V
#undef PG8_WAIT_L
#undef PG8_BAR
#undef PG8_SCHED
}
}

namespace attn_body {
using bf16=__hip_bfloat16;
using bf16x8=__attribute__((ext_vector_type(8)))short;
using s16x4=__attribute__((ext_vector_type(4)))short;
using f32x16=__attribute__((ext_vector_type(16)))float;
using u32x4=__attribute__((ext_vector_type(4)))unsigned;
constexpr int BATCH=4,NHEAD=8,NKV=2,SEQ=8192,D=64,PP=2304,OP=1024;
constexpr int NW=8,QBLK=32,QB=QBLK*NW,KVBLK=64,NQB=SEQ/QB;
constexpr int ATTN_UNIT_ROWS=QB;
__device__ __forceinline__ int crow(int r,int hi){return (r&3)+8*(r>>2)+4*hi;}
#define SBAR() __builtin_amdgcn_sched_barrier(0)
__device__ __forceinline__ void cmask(f32x16&p0,f32x16&p1,int jb,int qrel,int hi){
  const float NEG=-INFINITY; int kb=64*jb+4*hi;
  #pragma unroll
  for(int r=0;r<16;++r){int kv=kb+(r&3)+8*(r>>2); if(kv>qrel)p0[r]=NEG; if(kv+32>qrel)p1[r]=NEG;}
}

constexpr int NSLOT=3, SLOTB=8192;
constexpr int LDS_K=0, LDS_V=NSLOT*SLOTB, LDS_WS=2*NSLOT*SLOTB, LDS_OST=LDS_WS+NW*64*4, LDS_BYTES=LDS_OST+NW*4096;
constexpr float C2=0.125f*1.4426950408889634f;
__device__ __forceinline__ void glds16(const void*gsrc,unsigned lds_dst){unsigned keep;
  asm volatile("s_mov_b32 %0, m0\n\ts_mov_b32 m0, %2\n\ts_nop 0\n\tglobal_load_lds_dwordx4 %1, off\n\ts_mov_b32 m0, %0":"=&s"(keep):"v"(gsrc),"s"(lds_dst):"memory");}
__device__ __forceinline__ float max3f(float a,float b,float c){float r;asm("v_max3_f32 %0, %1, %2, %3":"=v"(r):"v"(a),"v"(b),"v"(c));return r;}
__device__ __forceinline__ float max2f(float a,float b){float r;asm("v_max_f32_e32 %0, %1, %2":"=v"(r):"v"(a),"v"(b));return r;}
__device__ __forceinline__ float fadd_s(float a,float b){float r;asm("v_add_f32_e32 %0, %1, %2":"=v"(r):"v"(a),"v"(b));return r;}
__device__ __forceinline__ float fsub_s(float a,float b){float r;asm("v_sub_f32_e32 %0, %1, %2":"=v"(r):"v"(a),"v"(b));return r;}
typedef float f32x2_t __attribute__((ext_vector_type(2))); typedef __bf16 bf16x2_t __attribute__((ext_vector_type(2)));
__device__ __forceinline__ unsigned cvtpk_s(float lo,float hi){f32x2_t v={lo,hi};bf16x2_t b=__builtin_convertvector(v,bf16x2_t);return __builtin_bit_cast(unsigned,b);}
#define WAIT_BAR(N) asm volatile("s_waitcnt vmcnt(" #N ") lgkmcnt(0)\n\ts_barrier":::"memory")

__device__ __forceinline__ void qkt(f32x16&p0,f32x16&p1,const char*Kslot,const bf16x8*qr,const f32x16&negm,int r32,int hi){
  const char*kb=Kslot+hi*1024+r32*16;
  #pragma unroll
  for(int d0=0;d0<4;++d0){
    const bf16x8 b0=*reinterpret_cast<const bf16x8*>(kb+d0*2048);
    const bf16x8 b1=*reinterpret_cast<const bf16x8*>(kb+d0*2048+512);
    if(d0==0){p0=__builtin_amdgcn_mfma_f32_32x32x16_bf16(b0,qr[0],negm,0,0,0);p1=__builtin_amdgcn_mfma_f32_32x32x16_bf16(b1,qr[0],negm,0,0,0);}
    else{p0=__builtin_amdgcn_mfma_f32_32x32x16_bf16(b0,qr[d0],p0,0,0,0);p1=__builtin_amdgcn_mfma_f32_32x32x16_bf16(b1,qr[d0],p1,0,0,0);}}
}
typedef __attribute__((address_space(3))) const char* lds_cptr;
typedef short v4i16_t __attribute__((ext_vector_type(4)));
__device__ __forceinline__ void kload8(bf16x8*kf,lds_cptr kp){
  kf[0]=*(const __attribute__((address_space(3))) bf16x8*)(kp);      kf[1]=*(const __attribute__((address_space(3))) bf16x8*)(kp+512);
  kf[2]=*(const __attribute__((address_space(3))) bf16x8*)(kp+2048); kf[3]=*(const __attribute__((address_space(3))) bf16x8*)(kp+2560);
  kf[4]=*(const __attribute__((address_space(3))) bf16x8*)(kp+4096); kf[5]=*(const __attribute__((address_space(3))) bf16x8*)(kp+4608);
  kf[6]=*(const __attribute__((address_space(3))) bf16x8*)(kp+6144); kf[7]=*(const __attribute__((address_space(3))) bf16x8*)(kp+6656);
}
__device__ __forceinline__ void kload2(bf16x8*kf,lds_cptr kp,int j){ kf[2*j]=*(const __attribute__((address_space(3))) bf16x8*)(kp+j*2048); kf[2*j+1]=*(const __attribute__((address_space(3))) bf16x8*)(kp+j*2048+512); }
__device__ __forceinline__ s16x4 vtr(lds_cptr p){ return __builtin_bit_cast(s16x4,__builtin_amdgcn_ds_read_tr16_b64_v4i16((__attribute__((address_space(3))) v4i16_t*)p)); }
__device__ __forceinline__ float rowmax(const f32x16&p0,const f32x16&p1){
  float a=max3f(p0[0],p0[1],p1[0]),b=max3f(p0[2],p0[3],p1[1]);a=max3f(a,p1[2],p1[3]);
  #pragma unroll
  for(int r=4;r<16;r+=4){a=max3f(a,p0[r],p0[r+1]);b=max3f(b,p0[r+2],p0[r+3]);a=max3f(a,p1[r],p1[r+1]);b=max3f(b,p1[r+2],p1[r+3]);}
  const float m=max2f(a,b);
  auto rr=__builtin_amdgcn_permlane32_swap(__float_as_uint(m),__float_as_uint(m),false,false);
  return max2f(__uint_as_float(rr[0]),__uint_as_float(rr[1]));
}
__device__ __forceinline__ void pv(f32x16*o,int vb,bf16x8 pa0,bf16x8 pa1,bf16x8 pa2,bf16x8 pa3){
  #pragma unroll
  for(int d0=0;d0<2;++d0){s16x4 lo[4],hi[4];
    #pragma unroll
    for(int ks=0;ks<4;++ks){
      asm volatile("ds_read_b64_tr_b16 %0,%1 offset:%c2":"=&v"(lo[ks]):"v"(vb),"i"(d0*4096+ks*1024):"memory");
      asm volatile("ds_read_b64_tr_b16 %0,%1 offset:%c2":"=&v"(hi[ks]):"v"(vb),"i"(d0*4096+ks*1024+512):"memory");}
    asm volatile("s_waitcnt lgkmcnt(0)":::"memory");SBAR();
    #define PK(k) (bf16x8){lo[k][0],lo[k][1],lo[k][2],lo[k][3],hi[k][0],hi[k][1],hi[k][2],hi[k][3]}
    o[d0]=__builtin_amdgcn_mfma_f32_32x32x16_bf16(pa0,PK(0),o[d0],0,0,0);
    o[d0]=__builtin_amdgcn_mfma_f32_32x32x16_bf16(pa1,PK(1),o[d0],0,0,0);
    o[d0]=__builtin_amdgcn_mfma_f32_32x32x16_bf16(pa2,PK(2),o[d0],0,0,0);
    o[d0]=__builtin_amdgcn_mfma_f32_32x32x16_bf16(pa3,PK(3),o[d0],0,0,0);
    #undef PK
  }
}

#ifndef ATTN_STORE16
#define ATTN_STORE16(p,v) (*(u32x4*)(p)=(v))
#endif
template<int THRL> __device__ __forceinline__ void attn_unit(float cb,int b,int h,int kvh,int qb,const bf16*Q,const bf16*__restrict__ K,const bf16*__restrict__ V,bf16*O,float*SS,char*shm){
  const int tid=threadIdx.x,lane=tid&63,r32=lane&31,hi=lane>>5; const int wid=__builtin_amdgcn_readfirstlane(tid>>6);
  const long rowbase=(long)b*SEQ; const int q0=qb*QB;
  const bf16*Qw=Q+(rowbase+q0+wid*QBLK)*PP+h*D;
  const bf16*Kh=K+rowbase*PP+kvh*D,*Vh=V+rowbase*PP+kvh*D;
  const unsigned lds0=(unsigned)(uintptr_t)shm;
  float*wsf=(float*)(shm+LDS_WS)+wid*64;
  const bf16*ksrc=Kh+(long)lane*PP+wid*8;
  const bf16*vsrc=Vh+(long)(16*(wid&3)+(lane>>2))*PP+(wid>>2)*32+(lane&3)*8;
  const unsigned kdst=lds0+LDS_K+wid*1024, vdst=lds0+LDS_V+wid*1024;
  #define DMA_K(t,slot) glds16(ksrc+(long)(t)*KVBLK*PP,(unsigned)__builtin_amdgcn_readfirstlane(kdst+(slot)))
  #define DMA_V(t,slot) glds16(vsrc+(long)(t)*KVBLK*PP,(unsigned)__builtin_amdgcn_readfirstlane(vdst+(slot)))
  const int vb0=(int)(lds0+LDS_V)+((lane>>4)&1)*32+(lane&3)*8+(4*hi+((lane&15)>>2))*64;
  const char*Kbase=shm+LDS_K; bf16x8 kf[8];
  const lds_cptr shm3=(lds_cptr)shm; const lds_cptr kp0=shm3+LDS_K+hi*1024+r32*16; const lds_cptr vp0=shm3+LDS_V+((lane>>4)&1)*32+(lane&3)*8+(4*hi+((lane&15)>>2))*64;
  const int NT=SEQ/KVBLK;
  DMA_K(0,0);DMA_V(0,0);DMA_K(1,SLOTB);
  bf16x8 qr[4];
  #pragma unroll
  for(int d0=0;d0<4;++d0)qr[d0]=*reinterpret_cast<const bf16x8*>(&Qw[(long)r32*PP+d0*16+hi*8]);
  float l_reg=0.f;f32x16 o[2];o[0]=f32x16{};o[1]=f32x16{};f32x16 negm;
  #pragma unroll
  for(int r=0;r<16;++r)negm[r]=-cb;
  asm volatile("":"+v"(negm));
  const int qrel=wid*QBLK+r32;
  #define CMASK(P0,P1,t) do{}while(0)
  #define START(P0,P1) do{ _Pragma("unroll") for(int r=0;r<16;++r)P0[r]=__builtin_amdgcn_exp2f(P0[r]); }while(0)
  #define RESC() do{}while(0)
  f32x16 pA0,pA1,pB0,pB1;
  int sl_prev=0,sl_cur=0,sl_next=SLOTB;
  #define ROT() do{sl_prev=sl_cur;sl_cur=sl_next;sl_next=(sl_next==(NSLOT-1)*SLOTB)?0:sl_next+SLOTB;}while(0)
  DMA_K(2,2*SLOTB);
  WAIT_BAR(3);
  qkt(pA0,pA1,Kbase,qr,negm,r32,hi);asm volatile("s_nop 15\n\ts_nop 7":"+v"(pA0),"+v"(pA1));CMASK(pA0,pA1,0);
  START(pA0,pA1);
  _Pragma("unroll") for(int r=0;r<16;++r)pA1[r]=__builtin_amdgcn_exp2f(pA1[r]);
  WAIT_BAR(0);
  DMA_K(3,0);DMA_V(1,SLOTB);
  ROT();
  kload8(kf,kp0+sl_cur);
  WAIT_BAR(2);
  s16x4 vlo[8],vhi[8]; u32x4 pw0,pw1,pw2,pw3;
  #define PKW(P,B) cvtpk_s(P[B],P[B+1])
  #define PAF(k) __builtin_bit_cast(bf16x8,pw##k)
  #define VFR(i) (bf16x8){vlo[i][0],vlo[i][1],vlo[i][2],vlo[i][3],vhi[i][0],vhi[i][1],vhi[i][2],vhi[i][3]}
  #define PIN(x) asm volatile("":"+v"(x))
  #define MX3(a,b,c) __builtin_fmaxf(__builtin_fmaxf((a),(b)),(c))
  #define GAPA(MF,A0,A1,A2,A3,W0,W1,PW) do{ MF; sacc+=A0; sacc+=A1; sacc+=A2; sacc+=A3; PIN(sacc); W0; W1; PIN(PW); SBAR(); }while(0)
  #define EX(v) __builtin_amdgcn_exp2f(v)
  #define GAPB(MF,X,B) do{ MF; X[B]=EX(X[B]); X[B+1]=EX(X[B+1]); X[B+2]=EX(X[B+2]); X[B+3]=EX(X[B+3]); PIN(X); SBAR(); }while(0)
  #define VRD(i) do{ vlo[i]=vtr(vp_+(((i)>>2)*4096+((i)&3)*1024)); vhi[i]=vtr(vp_+(((i)>>2)*4096+((i)&3)*1024+512)); }while(0)
  #define KRD(G,j) do{ if(G){ kload2(kf,kp0+sl_next,j); SBAR(); } }while(0)
  #define STEP(C0,C1,P0,P1,t,GK,GV,GL) do{ SBAR(); \
    const lds_cptr vp_=vp0+sl_prev; \
    VRD(0); SBAR(); float sacc=(P0[0]+P0[1]); \
    GAPA(C0=__builtin_amdgcn_mfma_f32_32x32x16_bf16(kf[0],qr[0],negm,0,0,0), P0[2],P0[3],P0[4],P0[5],     pw0[0]=PKW(P0,0), pw0[1]=PKW(P0,2), pw0); \
    VRD(4); SBAR(); GAPA(C1=__builtin_amdgcn_mfma_f32_32x32x16_bf16(kf[1],qr[0],negm,0,0,0), P0[6],P0[7],P0[8],P0[9],     pw0[2]=PKW(P0,4), pw0[3]=PKW(P0,6), pw0); \
    VRD(1); SBAR(); GAPA(C0=__builtin_amdgcn_mfma_f32_32x32x16_bf16(kf[2],qr[1],C0,0,0,0),   P0[10],P0[11],P0[12],P0[13], pw1[0]=PKW(P0,8), pw1[1]=PKW(P0,10), pw1); \
    VRD(5); SBAR(); GAPA(C1=__builtin_amdgcn_mfma_f32_32x32x16_bf16(kf[3],qr[1],C1,0,0,0),   P0[14],P0[15],P1[0],P1[1],   pw1[2]=PKW(P0,12),pw1[3]=PKW(P0,14), pw1); \
    VRD(2); SBAR(); GAPA(C0=__builtin_amdgcn_mfma_f32_32x32x16_bf16(kf[4],qr[2],C0,0,0,0),   P1[2],P1[3],P1[4],P1[5],     pw2[0]=PKW(P1,0), pw2[1]=PKW(P1,2), pw2); \
    VRD(6); SBAR(); GAPA(C1=__builtin_amdgcn_mfma_f32_32x32x16_bf16(kf[5],qr[2],C1,0,0,0),   P1[6],P1[7],P1[8],P1[9],     pw2[2]=PKW(P1,4), pw2[3]=PKW(P1,6), pw2); \
    VRD(3); SBAR(); GAPA(C0=__builtin_amdgcn_mfma_f32_32x32x16_bf16(kf[6],qr[3],C0,0,0,0),   P1[10],P1[11],P1[12],P1[13], pw3[0]=PKW(P1,8), pw3[1]=PKW(P1,10), pw3); \
    VRD(7); SBAR(); GAPA(C1=__builtin_amdgcn_mfma_f32_32x32x16_bf16(kf[7],qr[3],C1,0,0,0),   P1[14],P1[15],0.f,0.f,       pw3[2]=PKW(P1,12),pw3[3]=PKW(P1,14), pw3); \
    l_reg+=sacc; \
    if(GK){DMA_K((t)+3,sl_cur);} if(GV){DMA_V((t)+1,sl_next);} \
    CMASK(C0,C1,t); \
    SBAR(); \
    GAPB(o[0]=__builtin_amdgcn_mfma_f32_32x32x16_bf16(PAF(0),VFR(0),o[0],0,0,0), C0,0); \
    GAPB(o[1]=__builtin_amdgcn_mfma_f32_32x32x16_bf16(PAF(0),VFR(4),o[1],0,0,0), C0,4); \
    KRD(GL,0); GAPB(o[0]=__builtin_amdgcn_mfma_f32_32x32x16_bf16(PAF(1),VFR(1),o[0],0,0,0), C0,8); \
    KRD(GL,1); GAPB(o[1]=__builtin_amdgcn_mfma_f32_32x32x16_bf16(PAF(1),VFR(5),o[1],0,0,0), C0,12); \
    KRD(GL,2); GAPB(o[0]=__builtin_amdgcn_mfma_f32_32x32x16_bf16(PAF(2),VFR(2),o[0],0,0,0), C1,0); \
    KRD(GL,3); GAPB(o[1]=__builtin_amdgcn_mfma_f32_32x32x16_bf16(PAF(2),VFR(6),o[1],0,0,0), C1,4); \
    GAPB(o[0]=__builtin_amdgcn_mfma_f32_32x32x16_bf16(PAF(3),VFR(3),o[0],0,0,0), C1,8); \
    GAPB(o[1]=__builtin_amdgcn_mfma_f32_32x32x16_bf16(PAF(3),VFR(7),o[1],0,0,0), C1,12); \
    }while(0)
  int t=1;
  #undef CMASK
  #define CMASK(P0,P1,t) do{}while(0)
  for(;t+5<NT;t+=2){
    STEP(pB0,pB1,pA0,pA1,t,true,true,true);     WAIT_BAR(2); RESC(); ROT();
    STEP(pA0,pA1,pB0,pB1,t+1,true,true,true);   WAIT_BAR(2); RESC(); ROT();
  }
  #undef CMASK
  #define CMASK(P0,P1,t) do{}while(0)
  #define ENDW(tt) do{ if((tt)+3<NT){WAIT_BAR(2);} else if((tt)+2<NT){WAIT_BAR(1);} else {WAIT_BAR(0);} }while(0)
  for(;t+1<NT;t+=2){
    STEP(pB0,pB1,pA0,pA1,t,(t+3<NT),(t+1<NT),(t+1<NT));       ENDW(t);   RESC(); ROT();
    STEP(pA0,pA1,pB0,pB1,t+1,(t+4<NT),(t+2<NT),(t+2<NT));     ENDW(t+1); RESC(); ROT();
  }
  STEP(pB0,pB1,pA0,pA1,NT-1,false,false,false); RESC();
  { float sacc=pB0[0]+pB0[1]; _Pragma("unroll") for(int r=2;r<16;++r)sacc+=pB0[r]; _Pragma("unroll") for(int r=0;r<16;++r)sacc+=pB1[r]; l_reg+=sacc;
    pw0=(u32x4){PKW(pB0,0),PKW(pB0,2),PKW(pB0,4),PKW(pB0,6)};pw1=(u32x4){PKW(pB0,8),PKW(pB0,10),PKW(pB0,12),PKW(pB0,14)};pw2=(u32x4){PKW(pB1,0),PKW(pB1,2),PKW(pB1,4),PKW(pB1,6)};pw3=(u32x4){PKW(pB1,8),PKW(pB1,10),PKW(pB1,12),PKW(pB1,14)};
    SBAR(); pv(o,vb0+sl_cur,PAF(0),PAF(1),PAF(2),PAF(3)); }
  #undef PKW
  #undef PAF
  #undef VFR
  #undef PIN
  #undef MX3
  #undef GAPA
  #undef GAPB
  #undef EX
  #undef VRD
  #undef KRD
  #undef STEP
  #undef ENDW
  {auto rr=__builtin_amdgcn_permlane32_swap(__float_as_uint(l_reg),__float_as_uint(l_reg),false,false);l_reg=__uint_as_float(rr[0])+__uint_as_float(rr[1]);}
  if(hi==0)wsf[32+r32]=l_reg;asm volatile("s_waitcnt lgkmcnt(0)":::"memory");
  float rli[16];
  #pragma unroll
  for(int r=0;r<16;++r)rli[r]=__builtin_amdgcn_rcpf(wsf[32+crow(r,hi)]);
  bf16*Ow=O+(rowbase+q0+wid*QBLK)*OP+h*D;
  { bf16*stg=(bf16*)(shm+LDS_OST)+wid*2048;
    #pragma unroll
    for(int r=0;r<16;++r){const int orow=crow(r,hi);
      #pragma unroll
      for(int d0=0;d0<2;++d0)stg[orow*64+d0*32+r32]=__float2bfloat16(o[d0][r]*rli[r]);}
    asm volatile("s_waitcnt lgkmcnt(0)":::"memory");
    #pragma unroll
    for(int i=0;i<4;++i){const int row=i*8+(lane>>3),ch=lane&7; const u32x4 v=*(const u32x4*)(stg+row*64+ch*8); ATTN_STORE16(Ow+(long)row*OP+ch*8,v);
      float q=0.f; { const unsigned w4[4]={v.x,v.y,v.z,v.w};
        #pragma unroll
        for(int k=0;k<4;++k){const float a=__uint_as_float(w4[k]<<16),b2=__uint_as_float(w4[k]&0xffff0000u); q+=a*a+b2*b2;} }
      q+=__builtin_bit_cast(float,__builtin_amdgcn_update_dpp(0,__builtin_bit_cast(int,q),0xB1,0xF,0xF,true));
      q+=__builtin_bit_cast(float,__builtin_amdgcn_update_dpp(0,__builtin_bit_cast(int,q),0x4E,0xF,0xF,true));
      q+=__builtin_bit_cast(float,__builtin_amdgcn_update_dpp(0,__builtin_bit_cast(int,q),0x141,0xF,0xF,true));
      if(ch==0)SS[(rowbase+q0+wid*QBLK+row)*8+h]=q; } }
  asm volatile("s_waitcnt lgkmcnt(0)\n\ts_barrier":::"memory");
  #undef DMA_K
  #undef DMA_V
  #undef CMASK
  #undef START
  #undef RESC
  #undef ROT
}
constexpr int ATTN_LDS_BYTES=LDS_BYTES;
struct AttnTensors { const bf16* Q; const bf16* K; const bf16* V; bf16* O; float* SS; };
struct AttnUnit { int b, h, kvh, qb; };
struct StaticOrder {
  int vcu, G;
  __device__ __forceinline__ explicit StaticOrder(int grid,int block):vcu((grid%8==0)?(block%8)*(grid/8)+block/8:block),G(grid){}
  __device__ __forceinline__ bool next(int i,AttnUnit&u)const{ const int id=vcu+i*G; const int per=NQB*BATCH*NKV; if(id>=4*per)return false;
    const int hq=id/per, rem=id%per, bk=rem/NQB; u.qb=rem%NQB; u.b=bk/NKV; u.kvh=bk%NKV; u.h=u.kvh*4+hq; return true; }
  __device__ __forceinline__ void a_ready(const AttnUnit&)const{}
  __device__ __forceinline__ void done(const AttnUnit&)const{}
};
template<class Sched,int THRL=8> __device__ __forceinline__ void attn_phase(char*lds,const AttnTensors&T,const Sched&S,float cb){
  AttnUnit u;
  for(int i=0;S.next(i,u);++i){ S.a_ready(u); attn_unit<THRL>(cb,u.b,u.h,u.kvh,u.qb,T.Q,T.K,T.V,T.O,T.SS,lds); S.done(u); }
}
#undef SBAR
#undef WAIT_BAR
}

namespace attn8 {
typedef int v8i __attribute__((ext_vector_type(8)));
using f32x16 = __attribute__((ext_vector_type(16))) float;
using u32x4 = __attribute__((ext_vector_type(4))) unsigned;
typedef __attribute__((address_space(3))) const unsigned char* lds_cptr;
constexpr int SEQ = 8192, QB = 256, NQB = SEQ / QB, KVT = 64, NT = SEQ / KVT, OP = 1024;
constexpr int NSLOT = 8, SLOTB = 8192, LDS_OST = NSLOT * SLOTB, LDS_BYTES = LDS_OST + 8 * 4096;
__device__ __forceinline__ int crow(int r, int hi) { return (r & 3) + 8 * (r >> 2) + 4 * hi; }
__device__ __forceinline__ unsigned f2bf_rne(float f) { const unsigned u = __float_as_uint(f); return (u + 0x7fffu + ((u >> 16) & 1u)) >> 16; }
__host__ __device__ __forceinline__ int kpos(int kappa) { return 32 * ((kappa >> 2) & 1) + 16 * (kappa >> 5) + (kappa & 3) + 4 * ((kappa & 31) >> 3); }
__device__ __forceinline__ void glds16(const void* gsrc, unsigned lds_dst) { unsigned keep;
    asm volatile("s_mov_b32 %0, m0\n\ts_mov_b32 m0, %2\n\ts_nop 0\n\tglobal_load_lds_dwordx4 %1, off\n\ts_mov_b32 m0, %0" : "=&s"(keep) : "v"(gsrc), "s"(lds_dst) : "memory"); }
#define A8_MFMA(a, b, c) __builtin_amdgcn_mfma_scale_f32_32x32x64_f8f6f4(a, b, c, 0, 0, 0, 0x7F7F7F7F, 0, 0x7F7F7F7F)
struct Tensors { const unsigned char* Q8; const unsigned char* K8; const unsigned char* V8T; unsigned short* O; float* SS; };

__device__ __forceinline__ void unit(float cb8, int b, int h, int kvh, int qb, const Tensors& T, char* shm) {
    const int tid = threadIdx.x, lane = tid & 63, r32 = lane & 31, hi = lane >> 5; const int wid = __builtin_amdgcn_readfirstlane(tid >> 6);
    const long rowbase = (long)b * SEQ; const int q0 = qb * QB;
    const unsigned lds0 = (unsigned)(uintptr_t)shm;
    const int prow = 16 * (wid & 3) + (lane >> 2), pch = (lane & 3) ^ ((prow >> 2) & 3);
    const unsigned char* src = (wid < 4) ? T.K8 + (size_t)(rowbase + prow) * 128 + kvh * 64 + pch * 16
                                         : T.V8T + ((size_t)((b * 2 + kvh) * 64 + prow)) * SEQ + pch * 16;
    const long tstep = (wid < 4) ? (long)KVT * 128 : (long)KVT;
    const unsigned dst0 = lds0 + (wid < 4 ? 0 : 4096) + (wid & 3) * 1024;
#define A8_DMA(t, slot) glds16(src + (long)(t) * tstep, (unsigned)__builtin_amdgcn_readfirstlane(dst0 + (slot) * SLOTB))
    A8_DMA(0, 0); A8_DMA(1, 1); A8_DMA(2, 2);
    v8i qv; { const unsigned char* qp = T.Q8 + (size_t)(rowbase + q0 + wid * 32 + r32) * 512 + h * 64 + 32 * hi;
              const u32x4 a = *(const u32x4*)qp, c = *(const u32x4*)(qp + 16); qv = (v8i){(int)a.x, (int)a.y, (int)a.z, (int)a.w, (int)c.x, (int)c.y, (int)c.z, (int)c.w}; }
    const int f = (r32 >> 2) & 3;
    const int o0 = r32 * 64 + 16 * ((2 * hi) ^ f), o1 = r32 * 64 + 16 * ((2 * hi + 1) ^ f);
    const lds_cptr sh3 = (lds_cptr)shm;
    f32x16 negc, O0 = f32x16{}, O1 = f32x16{};
#pragma unroll
    for (int r = 0; r < 16; ++r) negc[r] = -cb8;
    f32x16 L = f32x16{}; v8i ones = {0x38383838, 0x38383838, 0x38383838, 0x38383838, 0x38383838, 0x38383838, 0x38383838, 0x38383838};
    asm volatile("" : "+v"(ones));
#define A8_FRAG(p, blk) ({ const u32x4 x_ = *(const __attribute__((address_space(3))) u32x4*)((p) + (blk) * 2048 + o0), y_ = *(const __attribute__((address_space(3))) u32x4*)((p) + (blk) * 2048 + o1); \
                           (v8i){(int)x_.x, (int)x_.y, (int)x_.z, (int)x_.w, (int)y_.x, (int)y_.y, (int)y_.z, (int)y_.w}; })
#define A8_SB __builtin_amdgcn_sched_barrier(0)
#define A8_E(S, r) S[r] = __builtin_amdgcn_exp2f(S[r])
#define A8_C(PW, w, S, d) { PW[w] = __builtin_amdgcn_cvt_pk_fp8_f32(S[4 * (d)], S[4 * (d) + 1], PW[w], false); PW[w] = __builtin_amdgcn_cvt_pk_fp8_f32(S[4 * (d) + 2], S[4 * (d) + 3], PW[w], true); }
#define A8_ITER(t, SA0, SA1, SB0, SB1, PW, PR, PV) { \
        asm volatile("s_waitcnt vmcnt(1) lgkmcnt(0)\n\ts_barrier" ::: "memory");        \
        { const int tn = (t) + 3 < NT ? (t) + 3 : NT - 1; A8_DMA(tn, ((t) + 3) & (NSLOT - 1)); }     \
        const lds_cptr kn = sh3 + (((t) + 1) & (NSLOT - 1)) * SLOTB, vb = sh3 + (((t) + NSLOT - 1) & (NSLOT - 1)) * SLOTB + 4096; \
        const v8i k0 = A8_FRAG(kn, 0), k1 = A8_FRAG(kn, 1); v8i v0 = k0, v1 = k1; if (PV) { v0 = A8_FRAG(vb, 0); v1 = A8_FRAG(vb, 1); } \
        A8_SB; A8_E(SA0, 0); A8_E(SA0, 1); A8_E(SA0, 2); A8_E(SA0, 3); A8_E(SA0, 4); A8_E(SA0, 5); A8_SB; \
        SB0 = A8_MFMA(k0, qv, negc); A8_SB; \
        A8_E(SA0, 6); A8_E(SA0, 7); A8_E(SA0, 8); A8_E(SA0, 9); A8_E(SA0, 10); A8_E(SA0, 11); A8_E(SA0, 12); A8_SB; \
        SB1 = A8_MFMA(k1, qv, negc); A8_SB; \
        A8_E(SA0, 13); A8_E(SA0, 14); A8_E(SA0, 15); A8_E(SA1, 0); A8_E(SA1, 1); A8_E(SA1, 2); A8_E(SA1, 3); A8_SB; \
        if (PV) O0 = A8_MFMA(v0, PR, O0); A8_SB; \
        A8_E(SA1, 4); A8_E(SA1, 5); A8_E(SA1, 6); A8_E(SA1, 7); A8_E(SA1, 8); A8_E(SA1, 9); A8_SB; \
        if (PV) O1 = A8_MFMA(v1, PR, O1); A8_SB; \
        A8_E(SA1, 10); A8_E(SA1, 11); A8_E(SA1, 12); A8_E(SA1, 13); A8_E(SA1, 14); A8_E(SA1, 15); A8_C(PW, 0, SA0, 0); A8_C(PW, 1, SA0, 1); A8_SB; \
        if (PV) L = A8_MFMA(ones, PR, L); A8_SB; \
        A8_C(PW, 2, SA0, 2); A8_C(PW, 3, SA0, 3); A8_C(PW, 4, SA1, 0); A8_C(PW, 5, SA1, 1); A8_C(PW, 6, SA1, 2); A8_C(PW, 7, SA1, 3); A8_SB; }
    asm volatile("s_waitcnt vmcnt(2) lgkmcnt(0)\n\ts_barrier" ::: "memory");
    f32x16 Sa0, Sa1, Sb0, Sb1; v8i pA = {0, 0, 0, 0, 0, 0, 0, 0}, pB = {0, 0, 0, 0, 0, 0, 0, 0};
    { const v8i k0 = A8_FRAG(sh3, 0), k1 = A8_FRAG(sh3, 1); Sa0 = A8_MFMA(k0, qv, negc); Sa1 = A8_MFMA(k1, qv, negc); }
    A8_ITER(0, Sa0, Sa1, Sb0, Sb1, pA, pB, false);
    A8_ITER(1, Sb0, Sb1, Sa0, Sa1, pB, pA, true);
    for (int t = 2; t < NT; t += 2) {
        A8_ITER(t, Sa0, Sa1, Sb0, Sb1, pA, pB, true);
        A8_ITER(t + 1, Sb0, Sb1, Sa0, Sa1, pB, pA, true);
    }
    { const lds_cptr vb = sh3 + ((NT - 1) & (NSLOT - 1)) * SLOTB + 4096; const v8i v0 = A8_FRAG(vb, 0), v1 = A8_FRAG(vb, 1);
      O0 = A8_MFMA(v0, pB, O0); O1 = A8_MFMA(v1, pB, O1); L = A8_MFMA(ones, pB, L); }
#undef A8_ITER
#undef A8_C
#undef A8_E
#undef A8_SB
    const float rl = 1.0f / (8.0f * L[0]);
    unsigned short* stg = (unsigned short*)(shm + LDS_OST) + wid * 2048;
#pragma unroll
    for (int r = 0; r < 16; ++r) { const int d = crow(r, hi);
        stg[r32 * 64 + d] = (unsigned short)(f2bf_rne(O0[r] * rl)); stg[r32 * 64 + 32 + d] = (unsigned short)(f2bf_rne(O1[r] * rl)); }
    asm volatile("s_waitcnt lgkmcnt(0)" ::: "memory");
    unsigned short* Ow = T.O + (rowbase + q0 + wid * 32) * OP + h * 64;
#pragma unroll
    for (int i = 0; i < 4; ++i) { const int row = i * 8 + (lane >> 3), ch = lane & 7; const u32x4 v = *(const u32x4*)(stg + row * 64 + ch * 8); *(u32x4*)(Ow + (long)row * OP + ch * 8) = v;
        float q = 0.f; { const unsigned w4[4] = {v.x, v.y, v.z, v.w};
#pragma unroll
            for (int k = 0; k < 4; ++k) { const float a = __uint_as_float(w4[k] << 16), b2 = __uint_as_float(w4[k] & 0xffff0000u); q += a * a + b2 * b2; } }
        q += __builtin_bit_cast(float, __builtin_amdgcn_update_dpp(0, __builtin_bit_cast(int, q), 0xB1, 0xF, 0xF, true));
        q += __builtin_bit_cast(float, __builtin_amdgcn_update_dpp(0, __builtin_bit_cast(int, q), 0x4E, 0xF, 0xF, true));
        q += __builtin_bit_cast(float, __builtin_amdgcn_update_dpp(0, __builtin_bit_cast(int, q), 0x141, 0xF, 0xF, true));
        if (ch == 0) T.SS[(rowbase + q0 + wid * 32 + row) * 8 + h] = q; }
    asm volatile("s_waitcnt vmcnt(0) lgkmcnt(0)\n\ts_barrier" ::: "memory");
#undef A8_DMA
#undef A8_FRAG
}
__device__ __forceinline__ void phase(char* lds, const Tensors& T, int grid, int block, float cb8) {
    const int vcu = (grid % 8 == 0) ? (block % 8) * (grid / 8) + block / 8 : block;
    for (int id = vcu; id < 4 * NQB * 8; id += grid) {
        const int per = NQB * 8, hq = id / per, rem = id % per, bk = rem / NQB, qb = rem % NQB, b = bk / 2, kvh = bk % 2;
        unit(cb8, b, kvh * 4 + hq, kvh, qb, T, lds);
    }
}
#undef A8_MFMA
}

namespace natten {
using bf16x8 = __attribute__((ext_vector_type(8))) short;
using s16x4 = __attribute__((ext_vector_type(4))) short;
using f32x4 = __attribute__((ext_vector_type(4))) float;
using u32x4 = __attribute__((ext_vector_type(4))) unsigned;
using u32x2 = __attribute__((ext_vector_type(2))) unsigned;
typedef unsigned short bf16_t;
typedef __attribute__((address_space(3))) unsigned char* lds_ptr;
typedef short v4i16_t __attribute__((ext_vector_type(4)));
constexpr int SEQ = 8192, GW = 64, ROWS = 128, PP = 2304, OP = 1024, KH = 8, KW = 16;
constexpr int LDS_K = 0, LDS_V = 9 * 64 * 128, LDS_BIAS = 2 * LDS_V, LDS_BYTES = LDS_BIAS + 15 * 64 * 4;
__device__ __forceinline__ int clampi(int v, int lo, int hi) { return v < lo ? lo : (v > hi ? hi : v); }
__device__ __forceinline__ unsigned cvtpk(float lo, float hi) { unsigned r; asm volatile("v_cvt_pk_bf16_f32 %0, %1, %2" : "=v"(r) : "v"(lo), "v"(hi)); return r; }
__device__ __forceinline__ s16x4 vtr(const __attribute__((address_space(3))) unsigned char* p) { return __builtin_bit_cast(s16x4, __builtin_amdgcn_ds_read_tr16_b64_v4i16((__attribute__((address_space(3))) v4i16_t*)p)); }

__device__ __forceinline__ int win_lo(int rp) { return clampi(2 * rp - 4, 0, ROWS - KH); }
__device__ __forceinline__ int win_hi(int rp) { const int lo = win_lo(rp); return lo + ((ROWS - lo) < 9 ? (ROWS - lo) : 9) - 1; }
__device__ __forceinline__ void stage_chunk(lds_ptr lds, int row, int col, int c, bool isv, u32x4 v) {
    const int s = row % 9;
    if (!isv) *(__attribute__((address_space(3))) u32x4*)(lds + LDS_K + s * 8192 + col * 128 + 16 * (c ^ ((col >> 1) & 7))) = v;
    else      *(__attribute__((address_space(3))) u32x4*)(lds + LDS_V + s * 8192 + col * 128 + 32 * ((c >> 1) ^ ((col >> 1) & 3)) + 16 * (c & 1)) = v;
}
__device__ __forceinline__ void natten_block(int b, int h, int rp0, int nun, const bf16_t* Qb, const bf16_t* Kb, const bf16_t* Vb, const float* rpb, bf16_t* O, float* SS, lds_ptr lds) {
    const int tid = threadIdx.x, lane = tid & 63, wid = __builtin_amdgcn_readfirstlane(tid >> 6);
    for (int n = tid; n < 15 * 64; n += 512) {
        const int dr = n >> 6, x = (n & 63) - 16;
        const float v = (x >= 0 && x < 31) ? rpb[(h * 15 + dr) * 31 + x] * 1.4426950408889634f : 0.f;
        *(__attribute__((address_space(3))) float*)(lds + LDS_BIAS + n * 4) = v;
    }
    int have_hi = win_hi(rp0);
    { const int lo = win_lo(rp0), nr = have_hi - lo + 1;
      for (int n = tid; n < nr * 1024; n += 512) {
          const int r = n >> 10, m = n & 1023, isv = m >> 9, col = (m & 511) >> 3, c = m & 7;
          const size_t tokk = (size_t)b * SEQ + (size_t)(lo + r) * GW + col;
          stage_chunk(lds, lo + r, col, c, isv, *(const u32x4*)((isv ? Vb : Kb) + tokk * PP + h * 64 + c * 8));
      } }
    __syncthreads();
    const int g = lane >> 4, i16 = lane & 15, q4 = i16 >> 2, p4 = lane & 3;
    for (int u = 0; u < nun; ++u) {
        const int rp = rp0 + u;
        u32x4 pf[4]; int nnew = 0;
        if (u + 1 < nun) { nnew = win_hi(rp + 1) - have_hi;
#pragma unroll
            for (int i = 0; i < 4; ++i) { const int n = tid + 512 * i; const int r = n >> 10, m = n & 1023, isv = m >> 9, col = (m & 511) >> 3, c = m & 7;
                if (r < nnew) { const size_t tokk = (size_t)b * SEQ + (size_t)(have_hi + 1 + r) * GW + col; pf[i] = *(const u32x4*)((isv ? Vb : Kb) + tokk * PP + h * 64 + c * 8); } } }
        const int rq = 2 * rp + (wid >> 2), c0 = 16 * (wid & 3), cw = clampi(c0 - 8, 0, 32), rs = clampi(rq - 4, 0, ROWS - KH);
        const int cq = c0 + i16, csq = clampi(cq - 8, 0, GW - KW);
        const size_t tok = (size_t)b * SEQ + (size_t)rq * GW + cq;
        bf16x8 qf[2];
#pragma unroll
        for (int ks = 0; ks < 2; ++ks) qf[ks] = *(const bf16x8*)(Qb + tok * PP + h * 64 + 32 * ks + 8 * g);
        const int swk = ((cw + i16) >> 1) & 7;
        const lds_ptr kp0 = lds + LDS_K + (cw + i16) * 128 + 16 * ((0 + g) ^ swk);
        const lds_ptr kp1 = lds + LDS_K + (cw + i16) * 128 + 16 * ((4 + g) ^ swk);
        int sl[8];
#pragma unroll
        for (int j = 0; j < 8; ++j) sl[j] = ((rs + j) % 9) * 8192;
        f32x4 s[16];
#pragma unroll
        for (int kb = 0; kb < 16; ++kb) {
            const int off = sl[kb >> 1] + (16 * (kb & 1)) * 128;
            const bf16x8 a0 = *(const __attribute__((address_space(3))) bf16x8*)(kp0 + off);
            const bf16x8 a1 = *(const __attribute__((address_space(3))) bf16x8*)(kp1 + off);
            f32x4 z = {0.f, 0.f, 0.f, 0.f};
            z = __builtin_amdgcn_mfma_f32_16x16x32_bf16(a0, qf[0], z, 0, 0, 0);
            s[kb] = __builtin_amdgcn_mfma_f32_16x16x32_bf16(a1, qf[1], z, 0, 0, 0);
        }
        const lds_ptr bp = lds + LDS_BIAS + ((rs - rq + 7) * 64 + (cw + 4 * g - cq + 31)) * 4;
        bool ok[2][4];
#pragma unroll
        for (int hh = 0; hh < 2; ++hh)
#pragma unroll
            for (int r = 0; r < 4; ++r) ok[hh][r] = (unsigned)(cw + 16 * hh + 4 * g + r - csq) < 16u;
        float mx = -3.0e38f;
#pragma unroll
        for (int kb = 0; kb < 16; ++kb)
#pragma unroll
            for (int r = 0; r < 4; ++r) {
                const float bias = *(const __attribute__((address_space(3))) float*)(bp + ((kb >> 1) * 64 + 16 * (kb & 1) + r) * 4);
                const float v = ok[kb & 1][r] ? s[kb][r] + bias : -3.0e38f;
                s[kb][r] = v; mx = fmaxf(mx, v);
            }
        mx = fmaxf(mx, __shfl_xor(mx, 16)); mx = fmaxf(mx, __shfl_xor(mx, 32));
        float l = 0.f;
#pragma unroll
        for (int kb = 0; kb < 16; ++kb)
#pragma unroll
            for (int r = 0; r < 4; ++r) { const float p = __builtin_amdgcn_exp2f(s[kb][r] - mx); s[kb][r] = p; l += p; }
        l += __shfl_xor(l, 16); l += __shfl_xor(l, 32);
        const int swv = (2 * g + (q4 >> 1)) & 3;
        lds_ptr vp[4];
#pragma unroll
        for (int db = 0; db < 4; ++db) vp[db] = lds + LDS_V + (cw + 4 * g + q4) * 128 + 32 * (db ^ swv) + 8 * p4;
        f32x4 o[4];
#pragma unroll
        for (int db = 0; db < 4; ++db) o[db] = (f32x4){0.f, 0.f, 0.f, 0.f};
#pragma unroll
        for (int kk = 0; kk < 8; ++kk) {
            u32x4 pw; pw.x = cvtpk(s[2 * kk][0], s[2 * kk][1]); pw.y = cvtpk(s[2 * kk][2], s[2 * kk][3]); pw.z = cvtpk(s[2 * kk + 1][0], s[2 * kk + 1][1]); pw.w = cvtpk(s[2 * kk + 1][2], s[2 * kk + 1][3]);
            const bf16x8 pb = __builtin_bit_cast(bf16x8, pw);
#pragma unroll
            for (int db = 0; db < 4; ++db) {
                const s16x4 lo = vtr(vp[db] + sl[kk]), hi = vtr(vp[db] + sl[kk] + 16 * 128);
                const bf16x8 a = (bf16x8){lo[0], lo[1], lo[2], lo[3], hi[0], hi[1], hi[2], hi[3]};
                o[db] = __builtin_amdgcn_mfma_f32_16x16x32_bf16(a, pb, o[db], 0, 0, 0);
            }
        }
        const float rl = 1.0f / l;
        bf16_t* op = O + tok * OP + 512 + h * 64 + 4 * g;
        float qs = 0.f;
#pragma unroll
        for (int db = 0; db < 4; ++db) { u32x2 w; w.x = cvtpk(o[db][0] * rl, o[db][1] * rl); w.y = cvtpk(o[db][2] * rl, o[db][3] * rl); *(u32x2*)(op + 16 * db) = w;
            const float a0 = __uint_as_float(w.x << 16), a1 = __uint_as_float(w.x & 0xffff0000u), a2 = __uint_as_float(w.y << 16), a3 = __uint_as_float(w.y & 0xffff0000u); qs += (a0 * a0 + a1 * a1) + (a2 * a2 + a3 * a3); }
        qs += __shfl_xor(qs, 16); qs += __shfl_xor(qs, 32);
        if (g == 0) SS[tok * 8 + h] = qs;
        __syncthreads();
        if (u + 1 < nun) {
#pragma unroll
            for (int i = 0; i < 4; ++i) { const int n = tid + 512 * i; const int r = n >> 10, m = n & 1023, isv = m >> 9, col = (m & 511) >> 3, c = m & 7;
                if (r < nnew) stage_chunk(lds, have_hi + 1 + r, col, c, isv, pf[i]); }
            have_hi += nnew;
            __syncthreads();
        }
    }
}
__device__ __forceinline__ void natten_phase(lds_ptr lds, const bf16_t* Qb, const bf16_t* Kb, const bf16_t* Vb, const float* rpb, bf16_t* O, float* SS, int vcu, int G) {
    for (int it = vcu; it < 256; it += G) { natten_block(it >> 6, (it >> 3) & 7, (it & 7) * 8, 8, Qb, Kb, Vb, rpb, O, SS, lds); __syncthreads(); }
}
}

namespace peer {
using bf16x8 = __attribute__((ext_vector_type(8))) short;
using f32x4 = __attribute__((ext_vector_type(4))) float;
using u32x4 = __attribute__((ext_vector_type(4))) unsigned;
typedef unsigned short bf16_t;
typedef __bf16 bf16x2_t __attribute__((ext_vector_type(2)));
typedef __attribute__((address_space(3))) unsigned char* lds_ptr;
constexpr int LDS_SK = 0, LDS_TAB = 65536, LDS_WV = LDS_TAB + 256, LDS_BYTES = LDS_WV + 8 * 4096;
constexpr float LOG2E = 1.4426950408889634f;

#define PEER_CE(a, b) do { const float hi_ = fmaxf(a, b), lo_ = fminf(a, b); a = hi_; b = lo_; } while (0)
template <int N, bool DESC> __device__ __forceinline__ void bitonic_sort(float (&v)[N]) {
#pragma unroll
    for (int k = 2; k <= N; k <<= 1)
#pragma unroll
        for (int j = k >> 1; j > 0; j >>= 1)
#pragma unroll
            for (int i = 0; i < N; ++i) { const int l = i ^ j; if (l > i) { const bool d = (((i & k) == 0) == DESC); if (d) PEER_CE(v[i], v[l]); else PEER_CE(v[l], v[i]); } }
}
template <bool DESC> __device__ __forceinline__ void oem_sort16(float (&v)[16]) {
#pragma unroll
    for (int p = 1; p < 16; p <<= 1)
#pragma unroll
        for (int k = p; k >= 1; k >>= 1)
#pragma unroll
            for (int j = k % p; j <= 15 - k; j += 2 * k)
#pragma unroll
                for (int i = 0; i < k; ++i) { if (i <= 15 - j - k && ((i + j) / (2 * p) == (i + j + k) / (2 * p))) { if (DESC) PEER_CE(v[i + j], v[i + j + k]); else PEER_CE(v[i + j + k], v[i + j]); } }
}
__device__ __forceinline__ void bitonic_merge16_desc(float (&v)[16]) {
#pragma unroll
    for (int j = 8; j > 0; j >>= 1)
#pragma unroll
        for (int i = 0; i < 16; ++i) { const int l = i ^ j; if (l > i) PEER_CE(v[i], v[l]); }
}
__device__ __forceinline__ void xlane_merge16(float (&v)[16], int mask) {
    float t[16];
#pragma unroll
    for (int i = 0; i < 16; ++i) t[i] = fmaxf(v[i], __shfl_xor(v[15 - i], mask));
#pragma unroll
    for (int i = 0; i < 16; ++i) v[i] = t[i];
    bitonic_merge16_desc(v);
}
__device__ __forceinline__ float gelu_erf(float v) {
    const float av = fabsf(v), t = 1.0f / (1.0f + 0.2316418882f * av);
    float q = t * 0.5307027145f + (-0.7265760135f); q = q * t + 0.7107068705f; q = q * t + (-0.142248368f); q = q * t + 0.127414796f; q = q * t;
    const float e = __builtin_amdgcn_exp2f((v * v) * (-0.72134752044f));
    const float m = v * (q * e);
    return v < 0.f ? m : v - m;
}
__device__ __forceinline__ float dot8(u32x4 a, u32x4 b, float acc) {
    typedef __bf16 bf16x8_t __attribute__((ext_vector_type(8)));
    const bf16x8_t va = __builtin_bit_cast(bf16x8_t, a), vb = __builtin_bit_cast(bf16x8_t, b);
    acc = __builtin_amdgcn_fdot2_f32_bf16((bf16x2_t){va[0], va[1]}, (bf16x2_t){vb[0], vb[1]}, acc, false);
    acc = __builtin_amdgcn_fdot2_f32_bf16((bf16x2_t){va[2], va[3]}, (bf16x2_t){vb[2], vb[3]}, acc, false);
    acc = __builtin_amdgcn_fdot2_f32_bf16((bf16x2_t){va[4], va[5]}, (bf16x2_t){vb[4], vb[5]}, acc, false);
    acc = __builtin_amdgcn_fdot2_f32_bf16((bf16x2_t){va[6], va[7]}, (bf16x2_t){vb[6], vb[7]}, acc, false);
    return acc;
}
__device__ __forceinline__ float blo(unsigned w) { return __uint_as_float(w << 16); }
__device__ __forceinline__ float bhi(unsigned w) { return __uint_as_float(w & 0xffff0000u); }

struct PeerArgs {
    const bf16_t* PQ;
    const bf16_t* SK;
    const bf16_t* H2;
    const unsigned char* U; const unsigned char* V;
    const float* US; const float* VS;
    int* eidx; float* egate2; float* wts;
    const bf16_t* xin; float* xout;
    const float* mod;
    const float* fg;
};

__device__ __forceinline__ void route16(const PeerArgs& A, lds_ptr lds, int tok0, int wid, int lane) {
    const int g = lane >> 4, i16 = lane & 15;
    const lds_ptr wv = lds + LDS_WV + wid * 4096;
    const bf16_t* qrow = A.PQ + (size_t)(tok0 + i16) * 2048;
    bf16x8 qn[4];
#pragma unroll
    for (int ks = 0; ks < 4; ++ks) qn[ks] = *(const bf16x8*)(qrow + 32 * ks + 8 * g);
    for (int h = 0; h < 8; ++h) {
        if (((h ^ (wid >> 2)) & 1) != 0) __builtin_amdgcn_s_setprio(1); else __builtin_amdgcn_s_setprio(0);
        float top[2][16];
#pragma unroll
        for (int half = 0; half < 2; ++half) {
            bf16x8 qf[4];
#pragma unroll
            for (int ks = 0; ks < 4; ++ks) qf[ks] = qn[ks];
            { const int nx = (2 * h + half + 1) & 15;
#pragma unroll
              for (int ks = 0; ks < 4; ++ks) qn[ks] = *(const bf16x8*)(qrow + nx * 128 + 32 * ks + 8 * g); }
            float v[32];
#pragma unroll
            for (int kb = 0; kb < 8; ++kb) {
                f32x4 s = {0.f, 0.f, 0.f, 0.f};
#pragma unroll
                for (int ks = 0; ks < 4; ++ks) {
                    const int row = 16 * kb + i16, c = 4 * ks + g;
                    const bf16x8 a = *(const __attribute__((address_space(3))) bf16x8*)(lds + LDS_SK + half * 32768 + row * 256 + 16 * (c ^ i16));
                    s = __builtin_amdgcn_mfma_f32_16x16x32_bf16(a, qf[ks], s, 0, 0, 0);
                }
#pragma unroll
                for (int r = 0; r < 4; ++r) v[4 * kb + r] = __uint_as_float((__float_as_uint(s[r]) & ~127u) | (unsigned)(16 * kb + 4 * g + r));
            }
            float a16[16], b16[16];
#pragma unroll
            for (int i = 0; i < 16; ++i) { a16[i] = v[i]; b16[i] = v[16 + i]; }
            oem_sort16<true>(a16); oem_sort16<false>(b16);
#pragma unroll
            for (int i = 0; i < 16; ++i) a16[i] = fmaxf(a16[i], b16[i]);
            bitonic_merge16_desc(a16);
            xlane_merge16(a16, 16); xlane_merge16(a16, 32);
#pragma unroll
            for (int i = 0; i < 16; ++i) top[half][i] = a16[i];
        }
        if (g == 0) {
#pragma unroll
            for (int i = 0; i < 16; ++i) { *(__attribute__((address_space(3))) float*)(wv + (i16 * 32 + i) * 4) = top[0][i]; *(__attribute__((address_space(3))) float*)(wv + (i16 * 32 + 16 + i) * 4) = top[1][i]; }
        }
        float cs[16];
#pragma unroll
        for (int j = 0; j < 16; ++j) {
            constexpr int A1[16] = {1, 1, 1, 1, 1, 1, 1, 1, 4, 4, 4, 5, 5, 8, 9, 10}, B1[16] = {0, 1, 2, 3, 4, 5, 6, 7, 0, 1, 2, 0, 1, 0, 0, 0};
            constexpr int A2[16] = {2, 2, 2, 2, 2, 3, 3, 3, 3, 6, 6, 7, 7, 11, 12, 13}, B2[16] = {0, 1, 2, 3, 4, 0, 1, 2, 3, 0, 1, 0, 1, 0, 0, 0};
            constexpr int A3[16] = {14, 15, 0, 0, 0, 0, 0, 0, 0, 0, 0, 0, 0, 0, 0, 0};
            const float x1 = g == 0 ? top[0][0] : (g == 1 ? top[0][A1[j]] : (g == 2 ? top[0][A2[j]] : top[0][A3[j]]));
            const float x2 = g == 0 ? top[1][j] : (g == 1 ? top[1][B1[j]] : (g == 2 ? top[1][B2[j]] : top[1][0]));
            float sm = __uint_as_float(__float_as_uint(x1) & ~127u) + __uint_as_float(__float_as_uint(x2) & ~127u);
            if (g == 3 && j >= 2) sm = -3.0e38f;
            cs[j] = __uint_as_float((__float_as_uint(sm) & ~63u) | (unsigned)(g * 16 + j));
        }
        oem_sort16<true>(cs);
        xlane_merge16(cs, 16); xlane_merge16(cs, 32);
        float mxs = __uint_as_float(__float_as_uint(cs[0]) & ~63u);
        float val[4]; int ex[4]; float es = 0.f;
#pragma unroll
        for (int k = 0; k < 4; ++k) {
            const float e = g == 0 ? cs[k] : (g == 1 ? cs[4 + k] : (g == 2 ? cs[8 + k] : cs[12 + k]));
            const unsigned slot = __float_as_uint(e) & 63u;
            const unsigned ab = *(const __attribute__((address_space(3))) unsigned char*)(lds + LDS_TAB + slot);
            const unsigned p1 = __float_as_uint(*(const __attribute__((address_space(3))) float*)(wv + (i16 * 32 + (ab >> 4)) * 4));
            const unsigned p2 = __float_as_uint(*(const __attribute__((address_space(3))) float*)(wv + (i16 * 32 + 16 + (ab & 15)) * 4));
            ex[k] = (int)((p1 & 127u) * 128u + (p2 & 127u));
            val[k] = __builtin_amdgcn_exp2f((__uint_as_float(p1 & ~127u) + __uint_as_float(p2 & ~127u) - mxs) * LOG2E);
            es += val[k];
        }
        es += __shfl_xor(es, 16); es += __shfl_xor(es, 32);
        const float ri = 1.0f / es;
        int* ep = A.eidx + (size_t)(tok0 + i16) * 128 + h * 16 + 4 * g;
        float* gp = A.egate2 + ((size_t)(tok0 + i16) * 128 + h * 16 + 4 * g) * 2;
        *(int4*)ep = make_int4(ex[0], ex[1], ex[2], ex[3]);
        *(float4*)gp = make_float4(A.US[ex[0]], val[0] * ri * A.VS[ex[0]], A.US[ex[1]], val[1] * ri * A.VS[ex[1]]);
        *(float4*)(gp + 4) = make_float4(A.US[ex[2]], val[2] * ri * A.VS[ex[2]], A.US[ex[3]], val[3] * ri * A.VS[ex[3]]);
    }
    __builtin_amdgcn_s_setprio(0);
}

typedef float f32x2 __attribute__((ext_vector_type(2)));
__device__ __forceinline__ float row16_sum(float x) {
    x += __builtin_bit_cast(float, __builtin_amdgcn_update_dpp(0, __builtin_bit_cast(int, x), 0xB1, 0xF, 0xF, true));
    x += __builtin_bit_cast(float, __builtin_amdgcn_update_dpp(0, __builtin_bit_cast(int, x), 0x4E, 0xF, 0xF, true));
    x += __builtin_bit_cast(float, __builtin_amdgcn_update_dpp(0, __builtin_bit_cast(int, x), 0x141, 0xF, 0xF, true));
    x += __builtin_bit_cast(float, __builtin_amdgcn_update_dpp(0, __builtin_bit_cast(int, x), 0x140, 0xF, 0xF, true));
    return x;
}
__device__ __forceinline__ f32x2 dot16_fp8(u32x4 w, const f32x2 (&h)[8], f32x2 acc) {
    acc += __builtin_amdgcn_cvt_pk_f32_fp8(w.x, false) * h[0]; acc += __builtin_amdgcn_cvt_pk_f32_fp8(w.x, true) * h[1];
    acc += __builtin_amdgcn_cvt_pk_f32_fp8(w.y, false) * h[2]; acc += __builtin_amdgcn_cvt_pk_f32_fp8(w.y, true) * h[3];
    acc += __builtin_amdgcn_cvt_pk_f32_fp8(w.z, false) * h[4]; acc += __builtin_amdgcn_cvt_pk_f32_fp8(w.z, true) * h[5];
    acc += __builtin_amdgcn_cvt_pk_f32_fp8(w.w, false) * h[6]; acc += __builtin_amdgcn_cvt_pk_f32_fp8(w.w, true) * h[7];
    return acc;
}
__device__ __forceinline__ void axpy16_fp8(u32x4 v, float wt, f32x2 (&acc)[8]) {
    const f32x2 w2 = {wt, wt};
    acc[0] += w2 * __builtin_amdgcn_cvt_pk_f32_fp8(v.x, false); acc[1] += w2 * __builtin_amdgcn_cvt_pk_f32_fp8(v.x, true);
    acc[2] += w2 * __builtin_amdgcn_cvt_pk_f32_fp8(v.y, false); acc[3] += w2 * __builtin_amdgcn_cvt_pk_f32_fp8(v.y, true);
    acc[4] += w2 * __builtin_amdgcn_cvt_pk_f32_fp8(v.z, false); acc[5] += w2 * __builtin_amdgcn_cvt_pk_f32_fp8(v.z, true);
    acc[6] += w2 * __builtin_amdgcn_cvt_pk_f32_fp8(v.w, false); acc[7] += w2 * __builtin_amdgcn_cvt_pk_f32_fp8(v.w, true);
}
typedef unsigned v6u __attribute__((ext_vector_type(6)));
typedef float v32f __attribute__((ext_vector_type(32)));
typedef __bf16 v32bf __attribute__((ext_vector_type(32)));
typedef unsigned u32x2 __attribute__((ext_vector_type(2)));
__device__ __forceinline__ float dot32_bf16(v32bf c, u32x4 h0, u32x4 h1, u32x4 h2, u32x4 h3, float acc) {
    typedef __bf16 bf16x8_t __attribute__((ext_vector_type(8)));
    const bf16x8_t a0 = __builtin_bit_cast(bf16x8_t, h0), a1 = __builtin_bit_cast(bf16x8_t, h1), a2 = __builtin_bit_cast(bf16x8_t, h2), a3 = __builtin_bit_cast(bf16x8_t, h3);
#pragma unroll
    for (int i = 0; i < 4; ++i) {
        acc = __builtin_amdgcn_fdot2_f32_bf16((bf16x2_t){c[2 * i], c[2 * i + 1]}, (bf16x2_t){a0[2 * i], a0[2 * i + 1]}, acc, false);
        acc = __builtin_amdgcn_fdot2_f32_bf16((bf16x2_t){c[8 + 2 * i], c[8 + 2 * i + 1]}, (bf16x2_t){a1[2 * i], a1[2 * i + 1]}, acc, false);
        acc = __builtin_amdgcn_fdot2_f32_bf16((bf16x2_t){c[16 + 2 * i], c[16 + 2 * i + 1]}, (bf16x2_t){a2[2 * i], a2[2 * i + 1]}, acc, false);
        acc = __builtin_amdgcn_fdot2_f32_bf16((bf16x2_t){c[24 + 2 * i], c[24 + 2 * i + 1]}, (bf16x2_t){a3[2 * i], a3[2 * i + 1]}, acc, false);
    }
    return acc;
}
__device__ __forceinline__ float udot64(u32x4 p0, u32x4 p1, u32x4 p2, const u32x4 (&hp)[8]) {
    const v6u ga = {p0.x, p0.y, p0.z, p0.w, p1.x, p1.y}, gb = {p1.z, p1.w, p2.x, p2.y, p2.z, p2.w};
    const v32bf ca = __builtin_amdgcn_cvt_scalef32_pk32_bf16_fp6(ga, 1.0f), cb = __builtin_amdgcn_cvt_scalef32_pk32_bf16_fp6(gb, 1.0f);
    float d = dot32_bf16(ca, hp[0], hp[1], hp[2], hp[3], 0.f);
    return dot32_bf16(cb, hp[4], hp[5], hp[6], hp[7], d);
}
__device__ __forceinline__ void upass_token(const PeerArgs& A, int tok, int lane) {
    const int e4 = lane >> 4, l16 = lane & 15;
    u32x4 hp[8];
#pragma unroll
    for (int k = 0; k < 8; ++k) hp[k] = *(const u32x4*)(A.H2 + (size_t)tok * 1024 + 64 * l16 + 8 * k);
    const int2* ei = (const int2*)(A.eidx + (size_t)tok * 128 + e4 * 32); const f32x4* eg = (const f32x4*)(A.egate2 + ((size_t)tok * 128 + e4 * 32) * 2); float* wo = A.wts + (size_t)tok * 128 + e4 * 32;
    const unsigned char* ub = A.U + l16 * 16;
    int2 id[5]; u32x4 buf[3][6]; f32x4 gs[3];
#define U_IDS(st) do { id[(st) % 5] = ei[(st)]; } while (0)
#define U_GATHER(st) do { const unsigned char* pa = ub + (size_t)id[(st) % 5].x * 768; const unsigned char* pb = ub + (size_t)id[(st) % 5].y * 768; \
        buf[(st) % 3][0] = *(const u32x4*)pa; buf[(st) % 3][1] = *(const u32x4*)(pa + 256); buf[(st) % 3][2] = *(const u32x4*)(pa + 512); \
        buf[(st) % 3][3] = *(const u32x4*)pb; buf[(st) % 3][4] = *(const u32x4*)(pb + 256); buf[(st) % 3][5] = *(const u32x4*)(pb + 512); gs[(st) % 3] = eg[(st)]; } while (0)
    U_IDS(0); U_IDS(1); U_IDS(2); U_IDS(3);
    U_GATHER(0); U_GATHER(1);
#pragma unroll
    for (int st = 0; st < 16; ++st) {
        if (st + 4 < 16) U_IDS(st + 4);
        if (st + 2 < 16) U_GATHER(st + 2);
        const f32x4 g = gs[st % 3];
        const float ta = row16_sum(udot64(buf[st % 3][0], buf[st % 3][1], buf[st % 3][2], hp)) * g[0];
        const float tb = row16_sum(udot64(buf[st % 3][3], buf[st % 3][4], buf[st % 3][5], hp)) * g[2];
        if (l16 == 0) *(f32x2*)(wo + 2 * st) = (f32x2){gelu_erf(ta) * g[1], gelu_erf(tb) * g[3]};
    }
#undef U_IDS
#undef U_GATHER
}
__device__ __forceinline__ int grab(lds_ptr cnt, int lane) {
    int t = 0;
    if (lane == 0) t = __hip_atomic_fetch_add((__attribute__((address_space(3))) int*)cnt, 1, __ATOMIC_RELAXED, __HIP_MEMORY_SCOPE_WORKGROUP);
    return __builtin_amdgcn_readfirstlane(t);
}
template <bool DYN> __device__ __forceinline__ void vpass_wave(const PeerArgs& A, int tok0, int tstride, int ntok, int lane, lds_ptr cnt = nullptr) {
    const int hw = lane >> 5, l32 = lane & 31;
    const unsigned char* vb = A.V + l32 * 16; const unsigned char* vc = A.V + 512 + l32 * 8;
    int4 id[4]; f32x4 wg[4]; u32x4 p0[4][4]; u32x2 p1[4][4];
#define V_EI(t) ((const int4*)(A.eidx + (size_t)(t) * 128 + hw * 64))
#define V_WI(t) ((const f32x4*)(A.wts + (size_t)(t) * 128 + hw * 64))
#define V_IDS(t, gr) do { id[(gr) % 4] = V_EI(t)[(gr) % 16]; wg[(gr) % 4] = V_WI(t)[(gr) % 16]; } while (0)
#define V_GATHER(gr) do { const int4 t_ = id[(gr) % 4]; \
        p0[(gr) % 4][0] = *(const u32x4*)(vb + (size_t)t_.x * 768); p1[(gr) % 4][0] = *(const u32x2*)(vc + (size_t)t_.x * 768); \
        p0[(gr) % 4][1] = *(const u32x4*)(vb + (size_t)t_.y * 768); p1[(gr) % 4][1] = *(const u32x2*)(vc + (size_t)t_.y * 768); \
        p0[(gr) % 4][2] = *(const u32x4*)(vb + (size_t)t_.z * 768); p1[(gr) % 4][2] = *(const u32x2*)(vc + (size_t)t_.z * 768); \
        p0[(gr) % 4][3] = *(const u32x4*)(vb + (size_t)t_.w * 768); p1[(gr) % 4][3] = *(const u32x2*)(vc + (size_t)t_.w * 768); } while (0)
    int cur = 0, nxt = 1;
    if (DYN) { cur = grab(cnt, lane); if (cur >= ntok) return; nxt = grab(cnt, lane); tok0 += cur; }
    V_IDS(tok0, 0); V_IDS(tok0, 1); V_IDS(tok0, 2);
    V_GATHER(0); V_GATHER(1);
    int tokd = tok0;
    for (int t = 0; DYN || t < ntok; ++t) {
        const int tok = DYN ? tokd : tok0 + t * tstride, tokn = DYN ? (nxt < ntok ? tok - cur + nxt : tok) : ((t + 1 < ntok) ? tok + tstride : tok);
        v32f acc;
#pragma unroll
        for (int i = 0; i < 32; ++i) acc[i] = 0.f;
#pragma unroll
        for (int gr = 0; gr < 16; ++gr) {
            V_GATHER(gr + 2);
            const f32x4 w = wg[gr % 4];
            if (gr + 3 < 16) V_IDS(tok, gr + 3); else V_IDS(tokn, gr + 3);
#pragma unroll
            for (int k = 0; k < 4; ++k) {
                const v6u g = {p0[gr % 4][k].x, p0[gr % 4][k].y, p0[gr % 4][k].z, p0[gr % 4][k].w, p1[gr % 4][k].x, p1[gr % 4][k].y};
                const v32f c = __builtin_amdgcn_cvt_scalef32_pk32_f32_fp6(g, 1.0f);
                acc += c * w[k];
            }
        }
#pragma unroll
        for (int i = 0; i < 32; ++i) acc[i] += __shfl_xor(acc[i], 32);
        float f[16];
#pragma unroll
        for (int i = 0; i < 16; ++i) f[i] = hw ? acc[16 + i] : acc[i];
        const int b = tok >> 13, col = 32 * l32 + 16 * hw;
        const bf16_t* xr = A.xin + (size_t)tok * 1024 + col; float* xo = A.xout + (size_t)tok * 1024 + col; const float* g2 = A.mod + b * 6144 + 5120 + col; const float* fgp = A.fg + col;
        float y[16]; float ss = 0.f;
        { const u32x4 xa = *(const u32x4*)xr, xb = *(const u32x4*)(xr + 8);
          y[0] = blo(xa.x); y[1] = bhi(xa.x); y[2] = blo(xa.y); y[3] = bhi(xa.y); y[4] = blo(xa.z); y[5] = bhi(xa.z); y[6] = blo(xa.w); y[7] = bhi(xa.w);
          y[8] = blo(xb.x); y[9] = bhi(xb.x); y[10] = blo(xb.y); y[11] = bhi(xb.y); y[12] = blo(xb.z); y[13] = bhi(xb.z); y[14] = blo(xb.w); y[15] = bhi(xb.w); }
#pragma unroll
        for (int q = 0; q < 4; ++q) {
            const f32x4 gv = *(const f32x4*)(g2 + 4 * q);
#pragma unroll
            for (int i = 0; i < 4; ++i) { y[4 * q + i] = y[4 * q + i] + gv[i] * f[4 * q + i]; ss += y[4 * q + i] * y[4 * q + i]; }
        }
#pragma unroll
        for (int o = 1; o < 64; o <<= 1) ss += __shfl_xor(ss, o);
        const float rinv = 1.0f / sqrtf(ss * (1.0f / 1024.0f) + 1e-6f);
#pragma unroll
        for (int q = 0; q < 4; ++q) {
            const f32x4 fv = *(const f32x4*)(fgp + 4 * q); f32x4 o;
#pragma unroll
            for (int i = 0; i < 4; ++i) o[i] = y[4 * q + i] * rinv * fv[i];
            *(f32x4*)(xo + 4 * q) = o;
        }
        if (DYN) { if (nxt >= ntok) break; tokd = tokn; cur = nxt; nxt = grab(cnt, lane); }
    }
#undef V_EI
#undef V_WI
#undef V_IDS
#undef V_GATHER
}

__device__ __forceinline__ void peer_phase(lds_ptr lds, const PeerArgs& A, int vcu, int G, int wid) {
    const int lane = (int)__builtin_amdgcn_mbcnt_hi(~0u, __builtin_amdgcn_mbcnt_lo(~0u, 0u)), tid = wid * 64 + lane;
    for (int n = tid; n < 2 * 128 * 16; n += 512) {
        const int tb = n >> 11, row = (n >> 4) & 127, c = n & 15;
        *(__attribute__((address_space(3))) u32x4*)(lds + LDS_SK + tb * 32768 + row * 256 + 16 * (c ^ (row & 15))) = *(const u32x4*)(A.SK + (size_t)tb * 16384 + row * 128 + c * 8);
    }
    if (tid < 64) {
        const unsigned long long A1 = 0xA985544411111111ull, B1 = 0x0001021076543210ull, A2 = 0xDCB7766333322222ull, B2 = 0x0001010321043210ull;
        const int gq = tid >> 4, j = tid & 15; int a = 0, b = 0;
        if (gq == 0) { a = 0; b = j; } else if (gq == 1) { a = (int)((A1 >> (4 * j)) & 15); b = (int)((B1 >> (4 * j)) & 15); } else if (gq == 2) { a = (int)((A2 >> (4 * j)) & 15); b = (int)((B2 >> (4 * j)) & 15); } else { a = j == 0 ? 14 : 15; b = 0; }
        *(__attribute__((address_space(3))) unsigned char*)(lds + LDS_TAB + tid) = (unsigned char)((a << 4) | b);
    }
    __syncthreads();
    const lds_ptr cU = lds + 160 * 1024 - 256 + 24 * 4, cV = cU + 4;
    for (int task_ = vcu; task_ < 256; task_ += G) {
        const int task = __builtin_amdgcn_readfirstlane(task_);
        if (tid == 0) { *(__attribute__((address_space(3))) int*)cU = 0; *(__attribute__((address_space(3))) int*)cV = 0; }
        const int tok0 = task * 128 + wid * 16;
        { int ln_ = lane; asm volatile("" : "+v"(ln_)); route16(A, lds, tok0, wid, ln_); }
        int lane2 = lane;
        asm volatile("s_waitcnt vmcnt(0) lgkmcnt(0)" : "+v"(lane2) :: "memory");
        __syncthreads();
        for (int t = grab(cU, lane2); t < 128; t = grab(cU, lane2)) upass_token(A, task * 128 + t, lane2);
        asm volatile("s_waitcnt vmcnt(0)" ::: "memory");
        __syncthreads();
        vpass_wave<true>(A, task * 128, 1, 128, lane2, cV);
        __syncthreads();
    }
}
__device__ __forceinline__ void peer_vphase_local(const PeerArgs& A, int vcu, int G) {
    const int lane = threadIdx.x & 63, wid = __builtin_amdgcn_readfirstlane(threadIdx.x >> 6);
    asm volatile("s_waitcnt vmcnt(0)" ::: "memory");
    for (int task = vcu; task < 256; task += G) vpass_wave<false>(A, task * 128 + wid * 16, 1, 16, lane);
}
__device__ __forceinline__ void peer_vphase(const PeerArgs& A, int vcu, int G) {
    const int lane = threadIdx.x & 63, wid = __builtin_amdgcn_readfirstlane(threadIdx.x >> 6);
    { const int w0 = vcu * 8 + wid, nw = G * 8; if (w0 < 32768) vpass_wave<false>(A, w0, nw, (32768 - w0 + nw - 1) / nw, lane); }
}
#undef PEER_CE
}

constexpr int NWAVES = 8;
#ifndef MK_N_LAUNCHES
#define MK_N_LAUNCHES 1
#endif
constexpr int PER_PHASE = 10;
constexpr int N_LAUNCHES = MK_N_LAUNCHES;

constexpr int BATCH = 4, T = 8192, D = 1024, M = BATCH * T, NIN = 2304, NPQ = 2048, NEXP = 16384;
constexpr float EPS = 1e-6f;
constexpr float C2 = 0.125f * 1.4426950408889634f;

constexpr size_t MiB = 1u << 20;
constexpr size_t WS_CTL = 0, CTL_ZERO_BYTES = 1 * MiB;
constexpr size_t WS_TAB = 1 * MiB;
constexpr size_t WS_WIN = 2 * MiB, WS_WOUT = 8 * MiB, WS_WQ = 10 * MiB, WS_SK = 14 * MiB;
constexpr size_t WS_U = 16 * MiB, WS_V = 32 * MiB;
constexpr size_t WS_US = 48 * MiB, WS_VS = 49 * MiB, WS_XS = 50 * MiB  ;
constexpr size_t WS_H = 80 * MiB;
constexpr size_t WS_P = 144 * MiB;
constexpr size_t WS_O = 288 * MiB;
constexpr size_t WS_EI = 352 * MiB, WS_EG = 368 * MiB  , WS_EW = 400 * MiB, WS_SSA = 416 * MiB, WS_SSB = 417 * MiB, WS_X1 = 420 * MiB, WS_END = 484 * MiB;
constexpr size_t WS_Q8 = 420 * MiB, WS_K8 = 436 * MiB, WS_V8T = 440 * MiB;
constexpr int CW_BAR = 4096;
constexpr int CW_PCNT = 8192;
constexpr int CW_MOD = 131072;

constexpr int LDS_BYTES = 160 * 1024;
constexpr int MISC_OFF = LDS_BYTES - 256;

#define GAS __attribute__((address_space(1)))
#define LAS __attribute__((address_space(3)))
typedef unsigned short bf16;
typedef unsigned v4u __attribute__((ext_vector_type(4)));
typedef float f32x4 __attribute__((ext_vector_type(4)));
typedef GAS unsigned gu32;
#define RLX_AGENT __ATOMIC_RELAXED, __HIP_MEMORY_SCOPE_AGENT
#define LDS_WAIT() asm volatile("s_waitcnt lgkmcnt(0)" ::: "memory")
__device__ __forceinline__ unsigned f2bf(float f) { unsigned u = __builtin_bit_cast(unsigned, f); return (u + 0x7fffu + ((u >> 16) & 1u)) >> 16; }
__device__ __forceinline__ unsigned pk2(float lo, float hi) { return f2bf(lo) | (f2bf(hi) << 16); }

#define XB_TMO      128
#define XB_XCNT(j)  (256  + 64 * (j))
#define XB_XSUB(j)  (1280 + 64 * (j))
#define XB_XGEN(j)  (2304 + 64 * (j))
#define XB_TOP      3328
#define XB_TOPGEN   3392
#define XCD_BAR_WORDS 3456
#define XB_SPIN_CAP (1u << 20)

__device__ __forceinline__ unsigned xb_ld(unsigned* p)              { return __hip_atomic_load(p, __ATOMIC_RELAXED, __HIP_MEMORY_SCOPE_AGENT); }
__device__ __forceinline__ unsigned xb_add(unsigned* p, unsigned v) { return __hip_atomic_fetch_add(p, v, __ATOMIC_RELAXED, __HIP_MEMORY_SCOPE_AGENT); }
__device__ __forceinline__ unsigned xb_xcc_id() { return (unsigned)__builtin_amdgcn_s_getreg((3 << 11) | 20) & 0xFu; }
#define XB_SPIN(cond, bar) do { unsigned _sp = 0; while (cond) { __builtin_amdgcn_s_sleep(1); \
    if ((++_sp & 255u) == 0u) { if (xb_ld(&(bar)[XB_TMO])) break; if (_sp > XB_SPIN_CAP) { atomicAdd(&(bar)[XB_TMO], 1u); break; } } } } while (0)

struct XcdBarrier { unsigned* bar; unsigned x; volatile LAS unsigned* st; };

__device__ __forceinline__ XcdBarrier xcd_barrier_post(unsigned* bar, volatile LAS unsigned* st) {
    XcdBarrier b; b.bar = bar; b.x = xb_xcc_id(); b.st = st;
    if (threadIdx.x == 0) (void)xb_add(&bar[XB_XCNT(b.x)], 1u);
    return b;
}
__device__ __forceinline__ void xcd_barrier_complete(unsigned* bar, unsigned x, unsigned& nloc, unsigned& nx) {
    const unsigned G = gridDim.x * gridDim.y * gridDim.z;
    unsigned sum, cnt, mine, sp = 0u;
    for (;;) {
        sum = 0u; cnt = 0u; mine = 0u;
#pragma unroll
        for (unsigned j = 0; j < 16; ++j) { const unsigned c = xb_ld(&bar[XB_XCNT(j)]); sum += c; cnt += (c > 0u) ? 1u : 0u; mine = (j == x) ? c : mine; }
        if (sum == G) break;
        __builtin_amdgcn_s_sleep(1);
        if ((++sp & 255u) == 0u) { if (xb_ld(&bar[XB_TMO])) break; if (sp > XB_SPIN_CAP) { atomicAdd(&bar[XB_TMO], 1u); break; } }
    }
    nloc = mine > 0u ? mine : 1u; nx = cnt > 0u ? cnt : 1u;
}
__device__ __forceinline__ void xcd_barrier(const XcdBarrier& b) {
    asm volatile("s_waitcnt vmcnt(0)" ::: "memory");
    __syncthreads();
    if (threadIdx.x == 0) {
        unsigned* bar = b.bar;
        __builtin_amdgcn_s_waitcnt(0);
        unsigned nloc = b.st[0], nx = b.st[1];
        if (nloc == 0u) { xcd_barrier_complete(bar, b.x, nloc, nx); b.st[0] = nloc; b.st[1] = nx; }
        const unsigned old = xb_add(&bar[XB_XSUB(b.x)], 1u);
        const unsigned gen = old / nloc;
        if (old + 1u == (gen + 1u) * nloc) {
            __builtin_amdgcn_fence(__ATOMIC_RELEASE, "agent");
            asm volatile("s_waitcnt vmcnt(0)" ::: "memory");
            const unsigned og = xb_add(&bar[XB_TOP], 1u);
            const unsigned tg = og / nx;
            if (og + 1u == (tg + 1u) * nx) xb_add(&bar[XB_TOPGEN], 1u);
            else XB_SPIN(xb_ld(&bar[XB_TOPGEN]) == tg, bar);
            __builtin_amdgcn_fence(__ATOMIC_ACQUIRE, "agent");
            xb_add(&bar[XB_XGEN(b.x)], 1u);
            asm volatile("s_waitcnt vmcnt(0)" ::: "memory");
        } else {
            XB_SPIN(xb_ld(&bar[XB_XGEN(b.x)]) == gen, bar);
            __builtin_amdgcn_fence(__ATOMIC_ACQUIRE, "agent");
            asm volatile("s_waitcnt vmcnt(0)" ::: "memory");
        }
    }
    __syncthreads();
}

__device__ __forceinline__ float wave_sum(float v) {
#pragma unroll
    for (int o = 1; o < 64; o <<= 1) v += __shfl_xor(v, o);
    return v;
}
template <bool PERMUTE> __device__ __forceinline__ void p0_transpose_item(const float* W, int K, int N, bf16* WT, LAS float* scr, int item, int lane, const float* ks0 = nullptr, const float* ks1 = nullptr) {
    const int nblk = N / 32, kb = item / nblk, nb = item % nblk, k0 = 64 * kb, n0 = 32 * nb;
    int r0 = n0;
    if (PERMUTE) { const int tile = nb >> 3, ob = nb & 7, wc = ob >> 1, bj = ob & 1; r0 = tile * 256 + 32 * (4 * bj + wc); }
#pragma unroll 8
    for (int i = 0; i < 32; ++i) { const int kk = 2 * i + (lane >> 5); const int kg = k0 + kk; const float sc = ks0 ? (kg < 512 ? ks0[kg] : ks1[kg - 512]) : 1.0f; scr[kk * 33 + (lane & 31)] = W[(size_t)kg * N + n0 + (lane & 31)] * sc; }
    LDS_WAIT(); asm volatile("" ::: "memory");
    const int c = lane & 7;
#pragma unroll
    for (int j = 0; j < 4; ++j) { const int n = (lane >> 3) + 8 * j; const LAS float* s = scr + (8 * c) * 33 + n;
        v4u o; o.x = pk2(s[0 * 33], s[1 * 33]); o.y = pk2(s[2 * 33], s[3 * 33]); o.z = pk2(s[4 * 33], s[5 * 33]); o.w = pk2(s[6 * 33], s[7 * 33]);
        *(GAS v4u*)(WT + (size_t)(r0 + n) * K + k0 + 8 * c) = o; }
    LDS_WAIT(); asm volatile("" ::: "memory");
}
__device__ __forceinline__ void sincos_d(double a, double& s, double& c) {
    const double TWO_PI = 6.283185307179586476925286766559, INV = 0.15915494309189533576888376337251;
    const double k = __builtin_rint(a * INV); const double x = a - k * TWO_PI; const double x2 = x * x;
    double ts = x, tc = 1.0, ss = x, cc = 1.0;
#pragma unroll
    for (int n = 1; n <= 16; ++n) { tc = -tc * x2 / (double)((2 * n - 1) * (2 * n)); ts = -ts * x2 / (double)((2 * n) * (2 * n + 1)); cc += tc; ss += ts; }
    s = ss; c = cc;
}
__device__ __forceinline__ float silu_f(float v) { return v / (1.0f + __expf(-v)); }

struct Ptrs {
    const float *x, *c, *w_ada, *b_ada, *n1g, *w_in, *qng, *kng, *rpb, *gag, *gbg, *w_out, *n2g, *wq, *sk1, *sk2, *pu, *pv, *fng;
    float* out; unsigned char* ws;
};

template <int PART> __device__ __forceinline__ void p0_prologue(const Ptrs& A, LAS unsigned char* lds, int vcu, int G, int wave, int lane, int gw, int NGW) {
    LAS float* scr = (LAS float*)(lds + wave * 16384);
    bf16* Win_t = (bf16*)(A.ws + WS_WIN); bf16* Wout_t = (bf16*)(A.ws + WS_WOUT); bf16* Wq_t = (bf16*)(A.ws + WS_WQ);
    constexpr int I_IN = (D / 64) * (NIN / 32), I_OUT = (D / 64) * (D / 32), I_Q = (D / 64) * (NPQ / 32);
    if (PART == 0) { for (int it = gw; it < I_IN; it += NGW) p0_transpose_item<true>(A.w_in, D, NIN, Win_t, scr, it, lane); }
    else for (int it = gw; it < I_OUT + I_Q; it += NGW) {
        int r = it;
        if (r < I_OUT) { p0_transpose_item<false>(A.w_out, D, D, Wout_t, scr, r, lane, A.gag, A.gbg); continue; } r -= I_OUT;
        p0_transpose_item<false>(A.wq, D, NPQ, Wq_t, scr, r, lane);
    }
    {
        typedef float v16f __attribute__((ext_vector_type(16))); typedef unsigned v6u __attribute__((ext_vector_type(6)));
        unsigned char* U6 = A.ws + WS_U; unsigned char* V6 = A.ws + WS_V; float* USc = (float*)(A.ws + WS_US); float* VSc = (float*)(A.ws + WS_VS);
        const int hw = lane >> 5, l32 = lane & 31;
        for (int it = (PART == 0 ? NEXP / 2 : 0) + gw; it < (PART == 0 ? NEXP : NEXP / 2); it += NGW) {
            const int r = 2 * it + hw; const bool isv = r >= NEXP; const int row = isv ? r - NEXP : r;
            const float* src = (isv ? A.pv : A.pu) + (size_t)row * D + l32 * 32;
            f32x4 v[8]; float mx = 0.f;
#pragma unroll
            for (int j = 0; j < 8; ++j) { v[j] = *(const GAS f32x4*)(src + 4 * j); mx = fmaxf(mx, fmaxf(fmaxf(fabsf(v[j][0]), fabsf(v[j][1])), fmaxf(fabsf(v[j][2]), fabsf(v[j][3])))); }
#pragma unroll
            for (int o = 1; o < 32; o <<= 1) mx = fmaxf(mx, __shfl_xor(mx, o));
            const float sc = mx > 0.f ? __uint_as_float(__float_as_uint(7.5f / mx) & 0x7f800000u) : 1.0f;
            v16f a, b;
#pragma unroll
            for (int j = 0; j < 4; ++j)
#pragma unroll
                for (int i = 0; i < 4; ++i) { a[4 * j + i] = v[2 * j + (i >> 1)][2 * (i & 1)] * sc; b[4 * j + i] = v[2 * j + (i >> 1)][2 * (i & 1) + 1] * sc; }
            const v6u q = __builtin_amdgcn_cvt_scalef32_2xpk16_fp6_f32(a, b, 1.0f);
            if (isv) {
                unsigned char* dst = V6 + (size_t)row * 768;
                *(GAS v4u*)(dst + 16 * l32) = (v4u){q[0], q[1], q[2], q[3]};
                *(GAS unsigned long long*)(dst + 512 + 8 * l32) = (unsigned long long)q[4] | ((unsigned long long)q[5] << 32);
            } else {
                unsigned char* dst = U6 + (size_t)row * 768 + 16 * (l32 >> 1);
                if ((l32 & 1) == 0) { *(GAS v4u*)dst = (v4u){q[0], q[1], q[2], q[3]}; *(GAS unsigned long long*)(dst + 256) = (unsigned long long)q[4] | ((unsigned long long)q[5] << 32); }
                else { *(GAS unsigned long long*)(dst + 256 + 8) = (unsigned long long)q[0] | ((unsigned long long)q[1] << 32); *(GAS v4u*)(dst + 512) = (v4u){q[2], q[3], q[4], q[5]}; }
            }
            if (l32 == 0) (isv ? VSc : USc)[row] = 1.0f / sc;
        }
        bf16* SKb = (bf16*)(A.ws + WS_SK);
        if (PART == 1) for (int it = gw; it < 64; it += NGW) {
            const float* src = it < 32 ? A.sk1 : A.sk2; const int r = it & 31;
            const size_t e = (size_t)r * 512 + lane * 8;
            const f32x4 a = *(const GAS f32x4*)(src + e), b = *(const GAS f32x4*)(src + e + 4);
            v4u o; o.x = pk2(a[0], a[1]); o.y = pk2(a[2], a[3]); o.z = pk2(b[0], b[1]); o.w = pk2(b[2], b[3]);
            *(GAS v4u*)(SKb + (it < 32 ? 0 : 16384) + e) = o;
        }
    }
    if (PART == 0) {
        float* rc = (float*)(A.ws + WS_TAB); float* rs = rc + 128 * 16;
        const int gt = gw * 64 + lane;
        if (gt < 128 * 16) {
            const int pos = gt >> 4, i = gt & 15;
            const double f4[4] = {1.0, 0.56234132519034908039495103977648, 0.31622776601683793319988935444327, 0.17782794100389228012254211951927};
            double fr = (i & 3) == 0 ? f4[0] : ((i & 3) == 1 ? f4[1] : ((i & 3) == 2 ? f4[2] : f4[3]));
            fr *= (i >> 2) == 0 ? 1.0 : ((i >> 2) == 1 ? 0.1 : ((i >> 2) == 2 ? 0.01 : 0.001));
            double s, c; sincos_d((double)pos * fr, s, c);
            rc[gt] = (float)c; rs[gt] = (float)s;
        }
    }
    if (PART == 0) {
        float* mod = (float*)(A.ws + WS_CTL) + CW_MOD;
        LAS float* part = (LAS float*)(lds + 131072);
        LAS float* sc_l = (LAS float*)(lds + 131072 + 8192);
        if (vcu < 96) { for (int i = threadIdx.x; i < 4096; i += 512) sc_l[i] = silu_f(A.c[i]); __syncthreads(); }
        for (int it = vcu; it < 96; it += G) {
            const int col = it * 64 + lane;
            float acc[4] = {0.f, 0.f, 0.f, 0.f};
#pragma unroll 16
            for (int k = 0; k < 128; ++k) {
                const int kk = wave * 128 + k;
                const float w = A.w_ada[(size_t)kk * 6144 + col];
#pragma unroll
                for (int b = 0; b < 4; ++b) acc[b] += w * sc_l[b * 1024 + kk];
            }
#pragma unroll
            for (int b = 0; b < 4; ++b) part[(wave * 4 + b) * 64 + lane] = acc[b];
            __syncthreads();
            if (wave < 4) {
                float s = A.b_ada[col];
#pragma unroll
                for (int w8 = 0; w8 < 8; ++w8) s += part[(w8 * 4 + wave) * 64 + lane];
                mod[wave * 6144 + col] = s;
            }
            __syncthreads();
        }
    }
}
__device__ __forceinline__ void modnorm_row(const float* xrow, const float* g, const float* shift, const float* scale, bf16* orow, int lane) {
    const GAS f32x4* xr = (const GAS f32x4*)xrow + lane;
    f32x4 v[4]; float s = 0.f;
#pragma unroll
    for (int j = 0; j < 4; ++j) { v[j] = xr[64 * j]; s += (v[j].x * v[j].x + v[j].y * v[j].y) + (v[j].z * v[j].z + v[j].w * v[j].w); }
    const float rinv = 1.0f / sqrtf(wave_sum(s) * (1.0f / D) + EPS);
    GAS unsigned long long* o8 = (GAS unsigned long long*)orow + lane;
#pragma unroll
    for (int j = 0; j < 4; ++j) {
        const f32x4 gv = *((const f32x4*)g + lane + 64 * j), sh = *((const f32x4*)shift + lane + 64 * j), sc = *((const f32x4*)scale + lane + 64 * j);
        const f32x4 y = v[j] * rinv * gv * (sc + 1.0f) + sh;
        o8[64 * j] = (unsigned long long)pk2(y.x, y.y) | ((unsigned long long)pk2(y.z, y.w) << 32);
    }
}
__device__ __forceinline__ void modnorm_row_b(const bf16* xrow, const float* g, const float* shift, const float* scale, bf16* orow, int lane) {
    float f[2][8]; float s = 0.f;
#pragma unroll
    for (int j = 0; j < 2; ++j) { const v4u w = *(const GAS v4u*)(xrow + 512 * j + lane * 8);
        f[j][0] = __uint_as_float(w.x << 16); f[j][1] = __uint_as_float(w.x & 0xffff0000u); f[j][2] = __uint_as_float(w.y << 16); f[j][3] = __uint_as_float(w.y & 0xffff0000u);
        f[j][4] = __uint_as_float(w.z << 16); f[j][5] = __uint_as_float(w.z & 0xffff0000u); f[j][6] = __uint_as_float(w.w << 16); f[j][7] = __uint_as_float(w.w & 0xffff0000u);
#pragma unroll
        for (int i = 0; i < 8; ++i) s += f[j][i] * f[j][i]; }
    const float rinv = 1.0f / sqrtf(wave_sum(s) * (1.0f / D) + EPS);
#pragma unroll
    for (int j = 0; j < 2; ++j) { const int c = 512 * j + lane * 8; float y[8];
#pragma unroll
        for (int q = 0; q < 2; ++q) { const f32x4 gv = *(const f32x4*)(g + c + 4 * q), sh = *(const f32x4*)(shift + c + 4 * q), sc = *(const f32x4*)(scale + c + 4 * q);
#pragma unroll
            for (int i = 0; i < 4; ++i) y[4 * q + i] = f[j][4 * q + i] * rinv * gv[i] * (sc[i] + 1.0f) + sh[i]; }
        v4u o; o.x = pk2(y[0], y[1]); o.y = pk2(y[2], y[3]); o.z = pk2(y[4], y[5]); o.w = pk2(y[6], y[7]);
        *(GAS v4u*)(orow + c) = o; }
}
__device__ __forceinline__ void groupnorm_row(const bf16* orow, const float* ga, const float* gb, bf16* mrow, int lane) {
#pragma unroll
    for (int j = 0; j < 2; ++j) {
        const v4u w = *(const GAS v4u*)(orow + 512 * j + lane * 8);
        float f[8]; f[0] = __uint_as_float(w.x << 16); f[1] = __uint_as_float(w.x & 0xffff0000u); f[2] = __uint_as_float(w.y << 16); f[3] = __uint_as_float(w.y & 0xffff0000u);
        f[4] = __uint_as_float(w.z << 16); f[5] = __uint_as_float(w.z & 0xffff0000u); f[6] = __uint_as_float(w.w << 16); f[7] = __uint_as_float(w.w & 0xffff0000u);
        float s = 0.f;
#pragma unroll
        for (int i = 0; i < 8; ++i) s += f[i] * f[i];
        const float rinv = 1.0f / sqrtf(wave_sum(s) * (1.0f / 512.0f) + EPS);
        const float* gp = (j ? gb : ga) + lane * 8;
        const f32x4 g0 = *(const f32x4*)gp, g1 = *(const f32x4*)(gp + 4);
        v4u o; o.x = pk2(f[0] * rinv * g0[0], f[1] * rinv * g0[1]); o.y = pk2(f[2] * rinv * g0[2], f[3] * rinv * g0[3]); o.z = pk2(f[4] * rinv * g1[0], f[5] * rinv * g1[1]); o.w = pk2(f[6] * rinv * g1[2], f[7] * rinv * g1[3]);
        *(GAS v4u*)(mrow + 512 * j + lane * 8) = o;
    }
}

struct Args { Ptrs p; int ph_lo, ph_hi; };
__global__ void __launch_bounds__(NWAVES * 64, 2) hymba_fwd(Args args) {
    extern __shared__ __attribute__((aligned(16))) unsigned char lds_raw[];
    LAS unsigned char* lds = (LAS unsigned char*)lds_raw;
    volatile LAS unsigned* MISC = (volatile LAS unsigned*)(lds + MISC_OFF);
    const Ptrs& A = args.p;
    const int tid = threadIdx.x, lane = tid & 63, wave = __builtin_amdgcn_readfirstlane(tid >> 6);
    const int G = gridDim.x; const int bx = blockIdx.x; const int vcu = (G % 8 == 0) ? (bx % 8) * (G / 8) + bx / 8 : bx;
    gu32* ctl = (gu32*)(A.ws + WS_CTL);
    if (tid < 64) MISC[tid] = 0u;
    __syncthreads();
    XcdBarrier bar; bar.bar = (unsigned*)(ctl + CW_BAR); bar.x = 0; bar.st = nullptr;
    if (N_LAUNCHES != PER_PHASE) bar = xcd_barrier_post((unsigned*)(ctl + CW_BAR), MISC + 8);
#define GRID_BAR() do { if (N_LAUNCHES != PER_PHASE) xcd_barrier(bar); } while (0)
    const int lo = args.ph_lo, hi = args.ph_hi;
#define IN(k) (lo <= (k) && (k) < hi)
#define BOTH(k) (IN(k) && IN((k) + 1))
    const float* mod = (const float*)(A.ws + WS_CTL) + CW_MOD;
    bf16* Hb = (bf16*)(A.ws + WS_H); bf16* Pb = (bf16*)(A.ws + WS_P); bf16* Ob = (bf16*)(A.ws + WS_O);
    const int gw = vcu * NWAVES + wave, NGW = G * NWAVES;

    if (IN(0)) { p0_prologue<0>(A, lds, vcu, G, wave, lane, gw, NGW); if (BOTH(0)) GRID_BAR(); }
    if (IN(1)) {
        for (int m = gw; m < M; m += NGW) { const float* md = mod + (m >> 13) * 6144; modnorm_row(A.x + (size_t)m * D, A.n1g, md, md + 1024, Hb + (size_t)m * D, lane); }
        if (BOTH(1)) GRID_BAR();
    }
    if (IN(2)) {
        pg8::Gemm g{Hb, (const bf16*)(A.ws + WS_WIN), M, NIN, D}; pg8::StaticOrder S; S.init(M, NIN, G, bx);
        { const float* tab = (const float*)(A.ws + WS_TAB); LAS float* tl = (LAS float*)(lds + 131072);
          for (int i = tid; i < 2 * 128 * 16; i += NWAVES * 64) tl[i] = tab[i];
          __syncthreads(); }
        pg8::EpiInProj E{Pb, A.ws + WS_Q8, A.ws + WS_K8, A.ws + WS_V8T, A.qng, A.kng, (const LAS float*)(lds + 131072), (const LAS float*)(lds + 131072) + 128 * 16, C2};
        pg8::gemm_phase<pg8::EpiInProj, pg8::StaticOrder, true, true>(lds, g, S, E);
        {
            const int nunits = (M / 256) * (NIN / 256), rounds = (nunits + G - 1) / G, busy = nunits - (rounds - 1) * G, nidle = G - busy;
            __syncthreads();
            if (nidle == 0) p0_prologue<1>(A, lds, vcu, G, wave, lane, bx * NWAVES + wave, G * NWAVES);
            else if (bx >= busy) p0_prologue<1>(A, lds, vcu, G, wave, lane, (bx - busy) * NWAVES + wave, nidle * NWAVES);
        }
        if (BOTH(2)) GRID_BAR();
    }
    if (IN(3)) {
        float cb; { const float gq = fabsf(A.qng[lane]), gk = fabsf(A.kng[lane]); float mq = gq, mk = gk;
#pragma unroll
            for (int o = 1; o < 64; o <<= 1) { mq = fmaxf(mq, __shfl_xor(mq, o)); mk = fmaxf(mk, __shfl_xor(mk, o)); }
            cb = 8.0f * 1.4426950408889634f * mq * mk; }
        const attn8::Tensors AT{A.ws + WS_Q8, A.ws + WS_K8, A.ws + WS_V8T, Ob, (float*)(A.ws + WS_SSA)};
        attn8::phase((char*)lds_raw, AT, G, bx, cb - 8.0f);
        __syncthreads();
        natten::natten_phase(lds, Pb + 768, Pb + 1280, Pb + 1792, A.rpb, Ob, (float*)(A.ws + WS_SSB), vcu, G);
        if (BOTH(3)) GRID_BAR();
    }
    if (IN(5)) {
        pg8::Gemm g{Ob, (const bf16*)(A.ws + WS_WOUT), M, D, D}; pg8::StaticOrder S; S.init(M, D, G, bx);
        pg8::EpiX1N E{A.x, (bf16*)(A.ws + WS_X1), Hb, mod, A.n2g, (const float*)(A.ws + WS_SSA), (const float*)(A.ws + WS_SSB), (LAS float*)(lds + 131072), (unsigned*)(A.ws + WS_XS), (unsigned*)(ctl + CW_PCNT)};
        E.prep(S);
        pg8::gemm_phase<pg8::EpiX1N, pg8::StaticOrder, true, true>(lds, g, S, E);
        if (BOTH(5)) GRID_BAR();
    }
    if (IN(7)) {
        pg8::Gemm g{Hb, (const bf16*)(A.ws + WS_WQ), M, NPQ, D}; pg8::StaticOrder S; S.init(M, NPQ, G, bx);
        pg8::EpiBf16 E{Pb, NPQ};
        pg8::gemm_phase<pg8::EpiBf16, pg8::StaticOrder, true, true>(lds, g, S, E);
        if (BOTH(7)) GRID_BAR();
    }
    if (IN(8) || IN(9)) {
        peer::PeerArgs PA{Pb, (const bf16*)(A.ws + WS_SK), Hb, A.ws + WS_U, A.ws + WS_V, (const float*)(A.ws + WS_US), (const float*)(A.ws + WS_VS), (int*)(A.ws + WS_EI), (float*)(A.ws + WS_EG), (float*)(A.ws + WS_EW), (const bf16*)(A.ws + WS_X1), A.out, mod, A.fng};
        if (IN(8)) peer::peer_phase(lds, PA, vcu, G, wave);
    }
#undef IN
#undef BOTH
#undef GRID_BAR
}

extern "C" void kernel_launch(void* const* d_in, const int* in_sizes, int n_in, void* d_out, int out_size, void* d_ws, size_t ws_size, hipStream_t stream) {
    static int grid = 0;
    if (grid == 0) {
        if (n_in != 19 || in_sizes[0] != M * D || out_size != M * D || ws_size < WS_END) { fprintf(stderr, "kernel_launch: unexpected problem shape (n_in %d, in0 %d, out %d, ws %zu); nothing launched\n", n_in, n_in > 0 ? in_sizes[0] : -1, out_size, ws_size); grid = -1; return; }
        int dev = 0, cus = 0, per_cu = 0;
        if (hipGetDevice(&dev) != hipSuccess || hipDeviceGetAttribute(&cus, hipDeviceAttributeMultiprocessorCount, dev) != hipSuccess) { grid = -1; return; }
        if (hipFuncSetAttribute((const void*)hymba_fwd, hipFuncAttributeMaxDynamicSharedMemorySize, LDS_BYTES) != hipSuccess) { fprintf(stderr, "kernel_launch: hipFuncSetAttribute failed\n"); grid = -1; return; }
        if (hipOccupancyMaxActiveBlocksPerMultiprocessor(&per_cu, (const void*)hymba_fwd, NWAVES * 64, LDS_BYTES) != hipSuccess || per_cu < 1) { fprintf(stderr, "kernel_launch: occupancy query reports %d workgroups per CU; nothing launched\n", per_cu); (void)hipGetLastError(); grid = -1; return; }
        grid = cus;
    }
    if (grid < 0) return;
    if (hipMemsetAsync((char*)d_ws + WS_CTL, 0, CTL_ZERO_BYTES, stream) != hipSuccess) { fprintf(stderr, "kernel_launch: hipMemsetAsync failed\n"); return; }
    Args a{};
    a.p.x = (const float*)d_in[0]; a.p.c = (const float*)d_in[1]; a.p.w_ada = (const float*)d_in[2]; a.p.b_ada = (const float*)d_in[3]; a.p.n1g = (const float*)d_in[4];
    a.p.w_in = (const float*)d_in[5]; a.p.qng = (const float*)d_in[6]; a.p.kng = (const float*)d_in[7]; a.p.rpb = (const float*)d_in[8]; a.p.gag = (const float*)d_in[9];
    a.p.gbg = (const float*)d_in[10]; a.p.w_out = (const float*)d_in[11]; a.p.n2g = (const float*)d_in[12]; a.p.wq = (const float*)d_in[13]; a.p.sk1 = (const float*)d_in[14];
    a.p.sk2 = (const float*)d_in[15]; a.p.pu = (const float*)d_in[16]; a.p.pv = (const float*)d_in[17]; a.p.fng = (const float*)d_in[18];
    a.p.out = (float*)d_out; a.p.ws = (unsigned char*)d_ws;
    for (int li = 0; li < N_LAUNCHES; ++li) {
        a.ph_lo = (N_LAUNCHES == PER_PHASE) ? li : 0; a.ph_hi = (N_LAUNCHES == PER_PHASE) ? li + 1 : PER_PHASE;
        hipLaunchKernelGGL(hymba_fwd, dim3(grid), dim3(NWAVES * 64), LDS_BYTES, stream, a);
        const hipError_t le = hipPeekAtLastError();
        if (le != hipSuccess) { fprintf(stderr, "kernel_launch: launch %d failed: %s\n", li, hipGetErrorName(le)); break; }
    }
}
```

```cpp
#include <hip/hip_runtime.h>
#include <hip/hip_bf16.h>
#include <cstdio>
#include <cstdint>
#include <cmath>
namespace pg8 {
#define PG8_LAS __attribute__((address_space(3)))
typedef unsigned short bf16_t;
typedef short bf16x8 __attribute__((ext_vector_type(8)));
typedef float f32x4 __attribute__((ext_vector_type(4)));
typedef unsigned u32x4 __attribute__((ext_vector_type(4)));
typedef unsigned u32x2 __attribute__((ext_vector_type(2)));
constexpr int BM = 256, BK = 64, HALF = 128, HTB = HALF * BK * 2  , STAGE_BYTES = 8 * HTB, NXCD = 8, WGM = 8;

__host__ __device__ __forceinline__ int lds_byte(int r, int c) { const int st = (r >> 4) * 2 + (c >> 5), rr = r & 15, cc = c & 31, ob = rr * 64 + cc * 2; return st * 1024 + (ob ^ (((ob >> 9) & 1) << 5)); }
__host__ __device__ __forceinline__ void stage_rc(int b, int& R, int& C) { const int st = b / 1024, sb = b % 1024, swz = sb ^ (((sb >> 9) & 1) << 5); R = (st >> 1) * 16 + swz / 64; C = (st & 1) * 32 + (swz % 64) / 2; }
__host__ __device__ __forceinline__ int perm32(int rho) { const int n = rho >> 4, i = rho & 15; return 8 * (i >> 2) + 4 * n + (i & 3); }

struct Unit { int pm, pn; };
struct Gemm { const bf16_t* A; const bf16_t* Bt; int M, N, K; };

struct StaticOrder {
    int nM, nN, nwg, G, c;
    __host__ __device__ void init(int M, int N, int G_, int c_) { nM = M / BM; nN = N / BM; nwg = nM * nN; G = G_; c = c_; }
    __host__ __device__ bool next(int i, Unit& u) const {
        const long L = (long)i * G + c; if (L >= nwg) return false;
        int wgid = (int)L; { const int q = nwg / NXCD, r = nwg % NXCD, xcd = wgid % NXCD, off = wgid / NXCD; wgid = (xcd < r ? xcd * (q + 1) : r * (q + 1) + (xcd - r) * q) + off; }
        const int nig = WGM * nN, gid = wgid / nig, fm = gid * WGM, gsz = (nM - fm) < WGM ? (nM - fm) : WGM;
        u.pm = fm + ((wgid % nig) % gsz); u.pn = (wgid % nig) / gsz; return true;
    }
    __device__ __forceinline__ void a_ready(const Unit&) const {}
    __device__ __forceinline__ void done(const Unit&) const {}
};

__device__ __forceinline__ unsigned cvt_pk_bf16(float lo, float hi) { unsigned r; asm volatile("v_cvt_pk_bf16_f32 %0, %1, %2" : "=v"(r) : "v"(lo), "v"(hi)); return r; }

struct EpiBf16 {
    static constexpr bool PERM = true, AFTER_DRAIN = false, MIDSCALE = false, EXCH = false;
    bf16_t* O; int ldc;
    __device__ __forceinline__ void operator()(const f32x4 (&acc)[2][2][4][2], const Unit& u, int wr, int wc, int fr, int fq) const {
        const int row0 = u.pm * BM + wr * 64 + fr; const int col0 = u.pn * BM + wc * 32 + 8 * fq;
#pragma unroll
        for (int ai = 0; ai < 2; ++ai)
#pragma unroll
            for (int m = 0; m < 4; ++m) { bf16_t* rowp = O + (size_t)(row0 + ai * HALF + m * 16) * ldc + col0;
#pragma unroll
                for (int bj = 0; bj < 2; ++bj) { const f32x4 v0 = acc[ai][bj][m][0], v1 = acc[ai][bj][m][1];
                    u32x4 w; w.x = cvt_pk_bf16(v0[0], v0[1]); w.y = cvt_pk_bf16(v0[2], v0[3]); w.z = cvt_pk_bf16(v1[0], v1[1]); w.w = cvt_pk_bf16(v1[2], v1[3]);
                    *(u32x4*)(rowp + bj * HALF) = w; } }
    }
};

typedef unsigned u32x2v __attribute__((__vector_size__(2 * sizeof(unsigned))));
struct EpiInProj {
    static constexpr bool PERM = false, AFTER_DRAIN = false, MIDSCALE = false, EXCH = false;
    bf16_t* P; unsigned char* Q8; unsigned char* K8; unsigned char* V8T;
    const float* qg; const float* kg; const PG8_LAS float* rc; const PG8_LAS float* rs; float c2;
    __device__ __forceinline__ void operator()(const f32x4 (&acc)[2][2][4][2], const Unit& u, int wr, int wc, int fr, int fq) const {
        const int pn = u.pn;
        const bool nq = pn < 2, nk = (pn == 2 && wc < 2), normed = nq || nk;
        const float sc = (nq || pn == 3 || pn == 4) ? c2 : 1.0f;
        const float* g = nq ? qg : kg;
        f32x4 gv[2][2];
#pragma unroll
        for (int bj = 0; bj < 2; ++bj)
#pragma unroll
            for (int n = 0; n < 2; ++n) gv[bj][n] = normed ? *(const f32x4*)(g + 32 * bj + 16 * n + 4 * fq) : (f32x4){1.f, 1.f, 1.f, 1.f};
        const int colb = pn * BM + 64 * wc + 4 * fq;
#pragma unroll
        for (int ai = 0; ai < 2; ++ai)
#pragma unroll
            for (int m = 0; m < 4; ++m) {
                const int row = u.pm * BM + ai * HALF + wr * 64 + m * 16 + fr;
                f32x4 v[2][2];
#pragma unroll
                for (int bj = 0; bj < 2; ++bj)
#pragma unroll
                    for (int n = 0; n < 2; ++n) v[bj][n] = acc[ai][bj][m][n];
                if (normed) {
                    float ss = 0.f;
#pragma unroll
                    for (int bj = 0; bj < 2; ++bj)
#pragma unroll
                        for (int n = 0; n < 2; ++n) { const f32x4 x = v[bj][n]; ss += (x[0] * x[0] + x[1] * x[1]) + (x[2] * x[2] + x[3] * x[3]); }
                    ss += __shfl_xor(ss, 16); ss += __shfl_xor(ss, 32);
                    const float rinv = 1.0f / sqrtf(ss * (1.0f / 64.0f) + 1e-6f);
                    const int t = row & 8191, prow = t >> 6, pcol = t & 63;
#pragma unroll
                    for (int bj = 0; bj < 2; ++bj) {
                        const int pos = bj ? pcol : prow;
                        const f32x4 c4 = *(const PG8_LAS f32x4*)(rc + pos * 16 + 4 * fq), s4 = *(const PG8_LAS f32x4*)(rs + pos * 16 + 4 * fq);
                        const f32x4 x1 = v[bj][0] * rinv * gv[bj][0], x2 = v[bj][1] * rinv * gv[bj][1];
                        v[bj][0] = x1 * c4 - x2 * s4; v[bj][1] = x1 * s4 + x2 * c4;
                    }
                }
                const int coff = (fq & 1) ? 12 + 4 * fq : 4 * fq;
                if (pn > 2) {
                    bf16_t* rowp = P + (size_t)row * 2304 + pn * BM + 64 * wc + coff;
#pragma unroll
                    for (int bj = 0; bj < 2; ++bj) { const f32x4 x = v[bj][0] * sc, y = v[bj][1] * sc;
                        const u32x2v s0 = __builtin_amdgcn_permlane16_swap(cvt_pk_bf16(x[0], x[1]), cvt_pk_bf16(y[0], y[1]), false, false), s1 = __builtin_amdgcn_permlane16_swap(cvt_pk_bf16(x[2], x[3]), cvt_pk_bf16(y[2], y[3]), false, false);
                        u32x4 w; w.x = s0[0]; w.y = s1[0]; w.z = s0[1]; w.w = s1[1]; *(u32x4*)(rowp + 32 * bj) = w; }
                } else {
                    const float fs = nq ? sc * 4.0f : (nk ? 0.25f : 8.0f);
                    if (nq || nk) {
#pragma unroll
                        for (int bj = 0; bj < 2; ++bj) { const f32x4 x = v[bj][0] * fs, y = v[bj][1] * fs;
                            unsigned w0 = (unsigned)__builtin_amdgcn_cvt_pk_fp8_f32(x[0], x[1], 0, false); w0 = (unsigned)__builtin_amdgcn_cvt_pk_fp8_f32(x[2], x[3], (int)w0, true);
                            unsigned w1 = (unsigned)__builtin_amdgcn_cvt_pk_fp8_f32(y[0], y[1], 0, false); w1 = (unsigned)__builtin_amdgcn_cvt_pk_fp8_f32(y[2], y[3], (int)w1, true);
                            const u32x2v s0 = __builtin_amdgcn_permlane16_swap(w0, w1, false, false); u32x2 w; w.x = s0[0]; w.y = s0[1];
                            if (nq) *(u32x2*)(Q8 + (size_t)row * 512 + pn * 256 + 64 * wc + 32 * bj + coff) = w;
                            else    *(u32x2*)(K8 + (size_t)row * 128 + 64 * wc + 32 * bj + coff) = w; }
                    } else
#pragma unroll
                    for (int bj = 0; bj < 2; ++bj)
#pragma unroll
                        for (int n = 0; n < 2; ++n) { const f32x4 x = v[bj][n] * fs;
                            unsigned w = (unsigned)__builtin_amdgcn_cvt_pk_fp8_f32(x[0], x[1], 0, false); w = (unsigned)__builtin_amdgcn_cvt_pk_fp8_f32(x[2], x[3], (int)w, true);
                            const int d = 32 * bj + 16 * n + 4 * fq;
                            { const int t = row & 8191, kap = t & 63; const int kp = 32 * ((kap >> 2) & 1) + 16 * (kap >> 5) + (kap & 3) + 4 * ((kap & 31) >> 3);
                                unsigned char* vp = V8T + ((size_t)(((row >> 13) * 2 + (wc - 2)) * 64 + d)) * 8192 + (t & ~63) + kp;
                                vp[0] = (unsigned char)(w & 0xffu); vp[8192] = (unsigned char)((w >> 8) & 0xffu); vp[2 * 8192] = (unsigned char)((w >> 16) & 0xffu); vp[3 * 8192] = (unsigned char)(w >> 24); } }
                }
            }
    }
};

struct EpiX1 {
    static constexpr bool PERM = true, AFTER_DRAIN = false, MIDSCALE = true, EXCH = false;
    const float* x; bf16_t* out; const float* mod;
    const float* ssa; const float* ssb;
    PG8_LAS float* rsl;
    template <class Sched> __device__ __forceinline__ void prep(const Sched& S) const {
        Unit u;
        for (int i = 0; S.next(i, u); ++i) {
            if (threadIdx.x < 256) { const size_t r = (size_t)(u.pm * BM + threadIdx.x) * 8;
                const f32x4 a0 = *(const f32x4*)(ssa + r), a1 = *(const f32x4*)(ssa + r + 4), b0 = *(const f32x4*)(ssb + r), b1 = *(const f32x4*)(ssb + r + 4);
                const float sa = ((a0[0] + a0[1]) + (a0[2] + a0[3])) + ((a1[0] + a1[1]) + (a1[2] + a1[3])), sb = ((b0[0] + b0[1]) + (b0[2] + b0[3])) + ((b1[0] + b1[1]) + (b1[2] + b1[3]));
                const float ra = 1.0f / sqrtf(sa * (1.0f / 512.0f) + 1e-6f), rb = 1.0f / sqrtf(sb * (1.0f / 512.0f) + 1e-6f);
                rsl[(i * 256 + threadIdx.x) * 2] = ra / rb; rsl[(i * 256 + threadIdx.x) * 2 + 1] = rb; }
        }
        __syncthreads();
    }
    __device__ __forceinline__ void mid_scale(f32x4 (&acc)[2][2][4][2], int ui, int wr, int fr) const {
#pragma unroll
        for (int ai = 0; ai < 2; ++ai)
#pragma unroll
            for (int m = 0; m < 4; ++m) { const float sc = rsl[(ui * 256 + ai * HALF + wr * 64 + m * 16 + fr) * 2];
#pragma unroll
                for (int bj = 0; bj < 2; ++bj)
#pragma unroll
                    for (int n = 0; n < 2; ++n) acc[ai][bj][m][n] = acc[ai][bj][m][n] * sc; }
    }
    __device__ __forceinline__ void operator()(const f32x4 (&acc)[2][2][4][2], const Unit& u, int wr, int wc, int fr, int fq, int ui) const {
        const int col0 = u.pn * BM + wc * 32 + 8 * fq;
        const int b = (u.pm * BM) >> 13;
        f32x4 gt[2][2];
#pragma unroll
        for (int bj = 0; bj < 2; ++bj)
#pragma unroll
            for (int n = 0; n < 2; ++n) gt[bj][n] = *(const f32x4*)(mod + b * 6144 + 2048 + col0 + bj * HALF + 4 * n);
#pragma unroll
        for (int ai = 0; ai < 2; ++ai) {
            f32x4 xv[4][2][2];
#pragma unroll
            for (int m = 0; m < 4; ++m) { const size_t off = (size_t)(u.pm * BM + ai * HALF + wr * 64 + m * 16 + fr) * 1024 + col0;
#pragma unroll
                for (int bj = 0; bj < 2; ++bj)
#pragma unroll
                    for (int n = 0; n < 2; ++n) xv[m][bj][n] = *(const f32x4*)(x + off + bj * HALF + 4 * n); }
#pragma unroll
            for (int m = 0; m < 4; ++m) { const size_t off = (size_t)(u.pm * BM + ai * HALF + wr * 64 + m * 16 + fr) * 1024 + col0;
                const float fin = rsl[(ui * 256 + ai * HALF + wr * 64 + m * 16 + fr) * 2 + 1];
#pragma unroll
                for (int bj = 0; bj < 2; ++bj) { const f32x4 y0 = xv[m][bj][0] + gt[bj][0] * (acc[ai][bj][m][0] * fin), y1 = xv[m][bj][1] + gt[bj][1] * (acc[ai][bj][m][1] * fin);
                    u32x4 w; w.x = cvt_pk_bf16(y0[0], y0[1]); w.y = cvt_pk_bf16(y0[2], y0[3]); w.z = cvt_pk_bf16(y1[0], y1[1]); w.w = cvt_pk_bf16(y1[2], y1[3]);
                    *(u32x4*)(out + off + bj * HALF) = w; } }
        }
    }
};

struct EpiX1N {
    static constexpr bool PERM = true, AFTER_DRAIN = false, MIDSCALE = true, EXCH = true;
    const float* x; bf16_t* out; bf16_t* h2; const float* mod; const float* n2g;
    const float* ssa; const float* ssb;
    PG8_LAS float* rsl;
    unsigned* xs; unsigned* cnt;
    template <class Sched> __device__ __forceinline__ void prep(const Sched& S) const {
        Unit u;
        for (int i = 0; S.next(i, u); ++i) {
            if (threadIdx.x < 256) { const size_t r = (size_t)(u.pm * BM + threadIdx.x) * 8;
                const f32x4 a0 = *(const f32x4*)(ssa + r), a1 = *(const f32x4*)(ssa + r + 4), b0 = *(const f32x4*)(ssb + r), b1 = *(const f32x4*)(ssb + r + 4);
                const float sa = ((a0[0] + a0[1]) + (a0[2] + a0[3])) + ((a1[0] + a1[1]) + (a1[2] + a1[3])), sb = ((b0[0] + b0[1]) + (b0[2] + b0[3])) + ((b1[0] + b1[1]) + (b1[2] + b1[3]));
                const float ra = 1.0f / sqrtf(sa * (1.0f / 512.0f) + 1e-6f), rb = 1.0f / sqrtf(sb * (1.0f / 512.0f) + 1e-6f);
                rsl[(i * 256 + threadIdx.x) * 2] = ra / rb; rsl[(i * 256 + threadIdx.x) * 2 + 1] = rb; }
        }
        __syncthreads();
    }
    __device__ __forceinline__ void mid_scale(f32x4 (&acc)[2][2][4][2], int ui, int wr, int fr) const {
#pragma unroll
        for (int ai = 0; ai < 2; ++ai)
#pragma unroll
            for (int m = 0; m < 4; ++m) { const float sc = rsl[(ui * 256 + ai * HALF + wr * 64 + m * 16 + fr) * 2];
#pragma unroll
                for (int bj = 0; bj < 2; ++bj)
#pragma unroll
                    for (int n = 0; n < 2; ++n) acc[ai][bj][m][n] = acc[ai][bj][m][n] * sc; }
    }
    __device__ __forceinline__ void operator()(f32x4 (&acc)[2][2][4][2], const Unit& u, int wr, int wc, int fr, int fq, int ui, int wid, int lane) const {
        unsigned lb = (unsigned)(size_t)rsl; asm volatile("" : "+s"(lb));
        PG8_LAS float* R = (PG8_LAS float*)lb; PG8_LAS float* P = R + 1024; PG8_LAS float* S = R + 2048;
        int r0 = wr * 64 + fr; asm volatile("" : "+v"(r0));
        const int col0 = u.pn * BM + wc * 32 + 8 * fq;
        const int b = (u.pm * BM) >> 13;
        {
            f32x4 gt[2][2];
#pragma unroll
            for (int bj = 0; bj < 2; ++bj)
#pragma unroll
                for (int n = 0; n < 2; ++n) gt[bj][n] = *(const f32x4*)(mod + b * 6144 + 2048 + col0 + bj * HALF + 4 * n);
#pragma unroll
            for (int ai = 0; ai < 2; ++ai) {
                f32x4 xv[4][2][2];
#pragma unroll
                for (int m = 0; m < 4; ++m) { const size_t off = (size_t)(u.pm * BM + ai * HALF + m * 16 + r0) * 1024 + col0;
#pragma unroll
                    for (int bj = 0; bj < 2; ++bj)
#pragma unroll
                        for (int n = 0; n < 2; ++n) xv[m][bj][n] = *(const f32x4*)(x + off + bj * HALF + 4 * n); }
#pragma unroll
                for (int m = 0; m < 4; ++m) { const int r = ai * HALF + m * 16 + r0;
                    const float fin = R[(ui * 256 + r) * 2 + 1]; float s = 0.f;
#pragma unroll
                    for (int bj = 0; bj < 2; ++bj)
#pragma unroll
                        for (int n = 0; n < 2; ++n) { const f32x4 y = xv[m][bj][n] + gt[bj][n] * (acc[ai][bj][m][n] * fin); acc[ai][bj][m][n] = y; s += (y[0] * y[0] + y[1] * y[1]) + (y[2] * y[2] + y[3] * y[3]); }
                    s += __shfl_xor(s, 16); s += __shfl_xor(s, 32);
                    if (fq == 0) P[r * 4 + wc] = s; }
            }
        }
        asm volatile("s_waitcnt lgkmcnt(0)" ::: "memory"); __builtin_amdgcn_s_barrier(); asm volatile("" ::: "memory");
        int row = wid * 32 + (lane & 31); asm volatile("" : "+v"(row));
        if (lane < 32) { const f32x4 p = *(const PG8_LAS f32x4*)(P + row * 4);
            __hip_atomic_store(xs + (size_t)(u.pm * BM + row) * 4 + u.pn, __builtin_bit_cast(unsigned, (p[0] + p[1]) + (p[2] + p[3])), __ATOMIC_RELAXED, __HIP_MEMORY_SCOPE_AGENT); }
        asm volatile("s_waitcnt vmcnt(0)" ::: "memory");
        if (lane == 0) __hip_atomic_fetch_add(cnt + 64 * u.pm, 1u, __ATOMIC_RELAXED, __HIP_MEMORY_SCOPE_AGENT);
        if (wid == 0) {
            unsigned sp = 0u;
            while ((unsigned)__builtin_amdgcn_readfirstlane(__hip_atomic_load(cnt + 64 * u.pm, __ATOMIC_RELAXED, __HIP_MEMORY_SCOPE_AGENT)) < 32u) { __builtin_amdgcn_s_sleep(1); if (++sp > (1u << 22)) break; }
            __builtin_amdgcn_fence(__ATOMIC_ACQUIRE, "agent");
        }
        asm volatile("s_waitcnt vmcnt(0) lgkmcnt(0)" ::: "memory"); __builtin_amdgcn_s_barrier(); asm volatile("" ::: "memory");
        if (lane < 32) { const unsigned* sl = xs + (size_t)(u.pm * BM + row) * 4; float t = 0.f;
#pragma unroll
            for (int k = 0; k < 4; ++k) t += __builtin_bit_cast(float, __hip_atomic_load(sl + k, __ATOMIC_RELAXED, __HIP_MEMORY_SCOPE_AGENT));
            S[row] = 1.0f / sqrtf(t * (1.0f / 1024.0f) + 1e-6f); }
        asm volatile("s_waitcnt lgkmcnt(0)" ::: "memory"); __builtin_amdgcn_s_barrier(); asm volatile("" ::: "memory");
        f32x4 wv[2][2], sv[2][2];
#pragma unroll
        for (int bj = 0; bj < 2; ++bj)
#pragma unroll
            for (int n = 0; n < 2; ++n) { const int c = col0 + bj * HALF + 4 * n;
                wv[bj][n] = *(const f32x4*)(n2g + c) * (*(const f32x4*)(mod + b * 6144 + 4096 + c) + 1.0f); sv[bj][n] = *(const f32x4*)(mod + b * 6144 + 3072 + c); }
#pragma unroll
        for (int ai = 0; ai < 2; ++ai)
#pragma unroll
            for (int m = 0; m < 4; ++m) { const int r = ai * HALF + m * 16 + r0; const size_t off = (size_t)(u.pm * BM + r) * 1024 + col0; const float ri = S[r];
#pragma unroll
                for (int bj = 0; bj < 2; ++bj) { const f32x4 y0 = acc[ai][bj][m][0], y1 = acc[ai][bj][m][1];
                    u32x4 w; w.x = cvt_pk_bf16(y0[0], y0[1]); w.y = cvt_pk_bf16(y0[2], y0[3]); w.z = cvt_pk_bf16(y1[0], y1[1]); w.w = cvt_pk_bf16(y1[2], y1[3]);
                    *(u32x4*)(out + off + bj * HALF) = w;
                    const f32x4 h0 = (y0 * ri) * wv[bj][0] + sv[bj][0], h1 = (y1 * ri) * wv[bj][1] + sv[bj][1];
                    u32x4 g; g.x = cvt_pk_bf16(h0[0], h0[1]); g.y = cvt_pk_bf16(h0[2], h0[3]); g.z = cvt_pk_bf16(h1[0], h1[1]); g.w = cvt_pk_bf16(h1[2], h1[3]);
                    *(u32x4*)(h2 + off + bj * HALF) = g; } }
    }
};


template <class Epi, class Sched, bool ALIGN_EPI = false, bool SP2 = false>
__device__ __forceinline__ void gemm_phase(PG8_LAS unsigned char* lds, const Gemm g, const Sched& S, const Epi& E) {
    const int tid = threadIdx.x, wid = __builtin_amdgcn_readfirstlane(tid >> 6), lane = tid & 63, wr = wid >> 2, wc = wid & 3, fr = lane & 15, fq = lane >> 4;
    const int K = g.K, nt = K / BK;
    unsigned voffA[2], voffB[2];
#pragma unroll
    for (int i = 0; i < 2; ++i) { int R, C; stage_rc(tid * 16 + i * 8192, R, C); const int Rb = Epi::PERM ? ((R & ~31) + perm32(R & 31)) : R;
        voffA[i] = (unsigned)(R * K + C) * 2u; voffB[i] = (unsigned)(Rb * K + C) * 2u; }
    const size_t kstep = (size_t)(BK * 2);
    const size_t hstep = (size_t)HALF * K * 2;
    const size_t tstep = 2 * hstep;
    const unsigned ldsw = (unsigned)wid * 1024u;
    const int aoff = lds_byte(wr * 64 + fr, fq * 8), boff = lds_byte(wc * 32 + fr, fq * 8);
#define PG8_SA(b, h) (((b) * 2 + (h)) * HTB)
#define PG8_SB(b, h) ((4 + (b) * 2 + (h)) * HTB)
#define PG8_STAGE(bufoff, gbase, voff) do { _Pragma("unroll") for (int _i = 0; _i < 2; ++_i) \
        __builtin_amdgcn_global_load_lds((const unsigned*)((const char*)(gbase) + (voff)[_i]), (PG8_LAS unsigned*)(lds + (bufoff) + ldsw + _i * 8192), 16, 0, 0); } while (0)
#define PG8_LDA(dst, b, h) do { _Pragma("unroll") for (int m = 0; m < 4; ++m) _Pragma("unroll") for (int k = 0; k < 2; ++k) dst[m][k] = *(const PG8_LAS bf16x8*)(lds + PG8_SA(b, h) + aoff + m * 2048 + k * 1024); } while (0)
#define PG8_LDB(dst, b, h) do { _Pragma("unroll") for (int n = 0; n < 2; ++n) _Pragma("unroll") for (int k = 0; k < 2; ++k) dst[n][k] = *(const PG8_LAS bf16x8*)(lds + PG8_SB(b, h) + boff + n * 2048 + k * 1024); } while (0)
#define PG8_MMA(ai, bj, At, Bt) do { __builtin_amdgcn_s_setprio(1); _Pragma("unroll") for (int m = 0; m < 4; ++m) _Pragma("unroll") for (int n = 0; n < 2; ++n) _Pragma("unroll") for (int k = 0; k < 2; ++k) \
        acc[ai][bj][m][n] = __builtin_amdgcn_mfma_f32_16x16x32_bf16(Bt[n][k], At[m][k], acc[ai][bj][m][n], 0, 0, 0); __builtin_amdgcn_s_setprio(0); } while (0)
#define PG8_WAIT_V(n) asm volatile("s_waitcnt vmcnt(" #n ")" ::: "memory")
#define PG8_WAIT_L(n) asm volatile("s_waitcnt lgkmcnt(" #n ")" ::: "memory")
#define PG8_BAR __builtin_amdgcn_s_barrier()
#define PG8_SCHED __builtin_amdgcn_sched_barrier(0)
    Unit cur, nxt; int ui = 0;
    if (!S.next(0, cur)) return;
    f32x4 acc[2][2][4][2];
#pragma unroll
    for (int a = 0; a < 2; ++a)
#pragma unroll
        for (int b = 0; b < 2; ++b)
#pragma unroll
            for (int m = 0; m < 4; ++m)
#pragma unroll
                for (int n = 0; n < 2; ++n) acc[a][b][m][n] = (f32x4){0.f, 0.f, 0.f, 0.f};
    bf16x8 At[4][2], B0[2][2], B1[2][2];
    const char* cA = (const char*)g.A + (size_t)cur.pm * tstep; const char* cB = (const char*)g.Bt + (size_t)cur.pn * tstep;
    S.a_ready(cur);
    if constexpr (SP2) {
        PG8_STAGE(PG8_SB(0, 0), cB, voffB); PG8_STAGE(PG8_SB(0, 1), cB + hstep, voffB); PG8_STAGE(PG8_SA(0, 0), cA, voffA); PG8_STAGE(PG8_SA(0, 1), cA + hstep, voffA);
        if (wr == 1) PG8_BAR;
        PG8_WAIT_V(2); PG8_BAR;
        PG8_STAGE(PG8_SB(1, 0), cB + kstep, voffB); PG8_STAGE(PG8_SA(1, 0), cA + kstep, voffA); PG8_STAGE(PG8_SB(1, 1), cB + hstep + kstep, voffB);
        PG8_WAIT_V(6); PG8_BAR;
    } else {
        PG8_STAGE(PG8_SB(0, 0), cB, voffB); PG8_STAGE(PG8_SA(0, 0), cA, voffA); PG8_STAGE(PG8_SB(0, 1), cB + hstep, voffB); PG8_STAGE(PG8_SA(0, 1), cA + hstep, voffA);
        if (wr == 1) PG8_BAR;
        PG8_WAIT_V(4); PG8_BAR;
        PG8_STAGE(PG8_SB(1, 0), cB + kstep, voffB); PG8_STAGE(PG8_SA(1, 0), cA + kstep, voffA); PG8_STAGE(PG8_SB(1, 1), cB + hstep + kstep, voffB);
        PG8_WAIT_V(6); PG8_BAR;
    }
    for (;;) {
        const bool has_next = S.next(ui + 1, nxt);
        const char* nA = has_next ? (const char*)g.A + (size_t)nxt.pm * tstep : cA; const char* nB = has_next ? (const char*)g.Bt + (size_t)nxt.pn * tstep : cB;
        for (int t = 0; t < nt; t += 2) {
            if constexpr (Epi::MIDSCALE) { if (t == nt / 2) E.mid_scale(acc, ui, wr, fr); }
            const bool last = (t == nt - 2);
            const char* a1 = cA + (size_t)(t + 1) * kstep;
            const char* a2 = last ? nA : cA + (size_t)(t + 2) * kstep; const char* b2 = last ? nB : cB + (size_t)(t + 2) * kstep;
            const char* a3 = a2 + kstep; const char* b3 = b2 + kstep;
            if (last && has_next) S.a_ready(nxt);
            if constexpr (SP2) {
            PG8_LDB(B0, 0, 0); PG8_LDB(B1, 0, 1); PG8_SCHED; PG8_LDA(At, 0, 0); PG8_STAGE(PG8_SA(1, 1), a1 + hstep, voffA);
            PG8_WAIT_V(8); PG8_WAIT_L(0); PG8_BAR; PG8_MMA(0, 0, At, B0); PG8_MMA(0, 1, At, B1); PG8_BAR; PG8_SCHED;
            PG8_LDA(At, 0, 1); PG8_STAGE(PG8_SB(0, 0), b2, voffB); PG8_STAGE(PG8_SB(0, 1), b2 + hstep, voffB); PG8_STAGE(PG8_SA(0, 0), a2, voffA);
            PG8_WAIT_V(8); PG8_WAIT_L(0); PG8_BAR; PG8_MMA(1, 0, At, B0); PG8_MMA(1, 1, At, B1); PG8_BAR; PG8_SCHED;
            PG8_LDB(B0, 1, 0); PG8_LDB(B1, 1, 1); PG8_SCHED; PG8_LDA(At, 1, 0); PG8_STAGE(PG8_SA(0, 1), a2 + hstep, voffA);
            PG8_WAIT_V(8); PG8_WAIT_L(0); PG8_BAR; PG8_MMA(0, 0, At, B0); PG8_MMA(0, 1, At, B1); PG8_BAR; PG8_SCHED;
            PG8_LDA(At, 1, 1); PG8_STAGE(PG8_SB(1, 0), b3, voffB); PG8_STAGE(PG8_SB(1, 1), b3 + hstep, voffB); PG8_STAGE(PG8_SA(1, 0), a3, voffA);
            PG8_WAIT_V(8); PG8_WAIT_L(0); PG8_BAR; PG8_MMA(1, 0, At, B0); PG8_MMA(1, 1, At, B1); PG8_BAR; PG8_SCHED;
            } else {
            PG8_LDB(B0, 0, 0); PG8_SCHED; PG8_LDA(At, 0, 0); PG8_STAGE(PG8_SA(1, 1), a1 + hstep, voffA);
            PG8_WAIT_L(8); PG8_BAR; PG8_WAIT_L(0); PG8_MMA(0, 0, At, B0); PG8_BAR; PG8_SCHED;
            PG8_LDB(B1, 0, 1); PG8_STAGE(PG8_SB(0, 0), b2, voffB);
            PG8_BAR; PG8_WAIT_L(0); PG8_MMA(0, 1, At, B1); PG8_BAR;
            PG8_LDA(At, 0, 1); PG8_STAGE(PG8_SA(0, 0), a2, voffA);
            PG8_BAR; PG8_WAIT_L(0); PG8_MMA(1, 0, At, B0); PG8_BAR; PG8_SCHED;
            PG8_STAGE(PG8_SB(0, 1), b2 + hstep, voffB);
            PG8_WAIT_V(6); PG8_BAR; PG8_MMA(1, 1, At, B1); PG8_BAR;
            PG8_LDB(B0, 1, 0); PG8_SCHED; PG8_LDA(At, 1, 0); PG8_STAGE(PG8_SA(0, 1), a2 + hstep, voffA);
            PG8_WAIT_L(8); PG8_BAR; PG8_WAIT_L(0); PG8_MMA(0, 0, At, B0); PG8_BAR; PG8_SCHED;
            PG8_LDB(B1, 1, 1); PG8_STAGE(PG8_SB(1, 0), b3, voffB);
            PG8_BAR; PG8_WAIT_L(0); PG8_MMA(0, 1, At, B1); PG8_BAR;
            PG8_LDA(At, 1, 1); PG8_STAGE(PG8_SA(1, 0), a3, voffA);
            PG8_BAR; PG8_WAIT_L(0); PG8_MMA(1, 0, At, B0); PG8_BAR; PG8_SCHED;
            PG8_STAGE(PG8_SB(1, 1), b3 + hstep, voffB);
            PG8_WAIT_V(6); PG8_BAR; PG8_MMA(1, 1, At, B1); PG8_BAR;
            }
        }
        if constexpr (ALIGN_EPI) { if (wr == 0) PG8_BAR; }
        if constexpr (!Epi::AFTER_DRAIN) { if constexpr (Epi::EXCH) E(acc, cur, wr, wc, fr, fq, ui, wid, lane); else if constexpr (Epi::MIDSCALE) E(acc, cur, wr, wc, fr, fq, ui); else E(acc, cur, wr, wc, fr, fq); S.done(cur); }
        if (!has_next) break;
#pragma unroll
        for (int a = 0; a < 2; ++a)
#pragma unroll
            for (int b = 0; b < 2; ++b)
#pragma unroll
                for (int m = 0; m < 4; ++m)
#pragma unroll
                    for (int n = 0; n < 2; ++n) acc[a][b][m][n] = (f32x4){0.f, 0.f, 0.f, 0.f};
        cur = nxt; cA = nA; cB = nB; ++ui;
        if constexpr (ALIGN_EPI) { if (wr == 1) PG8_BAR; }
    }
    PG8_WAIT_V(0);
    if constexpr (!ALIGN_EPI) { if (wr == 0) PG8_BAR; }
    PG8_BAR;
    if constexpr (Epi::AFTER_DRAIN) { E.fused(acc, cur, wr, wc, fr, fq, lds, wid, lane); S.done(cur); }
#undef PG8_SA
#undef PG8_SB
#undef PG8_STAGE
#undef PG8_LDA
#undef PG8_LDB
#undef PG8_MMA
#undef PG8_WAIT_V
#undef PG8_WAIT_L
#undef PG8_BAR
#undef PG8_SCHED
}
}

namespace attn_body {
using bf16=__hip_bfloat16;
using bf16x8=__attribute__((ext_vector_type(8)))short;
using s16x4=__attribute__((ext_vector_type(4)))short;
using f32x16=__attribute__((ext_vector_type(16)))float;
using u32x4=__attribute__((ext_vector_type(4)))unsigned;
constexpr int BATCH=4,NHEAD=8,NKV=2,SEQ=8192,D=64,PP=2304,OP=1024;
constexpr int NW=8,QBLK=32,QB=QBLK*NW,KVBLK=64,NQB=SEQ/QB;
constexpr int ATTN_UNIT_ROWS=QB;
__device__ __forceinline__ int crow(int r,int hi){return (r&3)+8*(r>>2)+4*hi;}
#define SBAR() __builtin_amdgcn_sched_barrier(0)
__device__ __forceinline__ void cmask(f32x16&p0,f32x16&p1,int jb,int qrel,int hi){
  const float NEG=-INFINITY; int kb=64*jb+4*hi;
  #pragma unroll
  for(int r=0;r<16;++r){int kv=kb+(r&3)+8*(r>>2); if(kv>qrel)p0[r]=NEG; if(kv+32>qrel)p1[r]=NEG;}
}

constexpr int NSLOT=3, SLOTB=8192;
constexpr int LDS_K=0, LDS_V=NSLOT*SLOTB, LDS_WS=2*NSLOT*SLOTB, LDS_OST=LDS_WS+NW*64*4, LDS_BYTES=LDS_OST+NW*4096;
constexpr float C2=0.125f*1.4426950408889634f;
__device__ __forceinline__ void glds16(const void*gsrc,unsigned lds_dst){unsigned keep;
  asm volatile("s_mov_b32 %0, m0\n\ts_mov_b32 m0, %2\n\ts_nop 0\n\tglobal_load_lds_dwordx4 %1, off\n\ts_mov_b32 m0, %0":"=&s"(keep):"v"(gsrc),"s"(lds_dst):"memory");}
__device__ __forceinline__ float max3f(float a,float b,float c){float r;asm("v_max3_f32 %0, %1, %2, %3":"=v"(r):"v"(a),"v"(b),"v"(c));return r;}
__device__ __forceinline__ float max2f(float a,float b){float r;asm("v_max_f32_e32 %0, %1, %2":"=v"(r):"v"(a),"v"(b));return r;}
__device__ __forceinline__ float fadd_s(float a,float b){float r;asm("v_add_f32_e32 %0, %1, %2":"=v"(r):"v"(a),"v"(b));return r;}
__device__ __forceinline__ float fsub_s(float a,float b){float r;asm("v_sub_f32_e32 %0, %1, %2":"=v"(r):"v"(a),"v"(b));return r;}
typedef float f32x2_t __attribute__((ext_vector_type(2))); typedef __bf16 bf16x2_t __attribute__((ext_vector_type(2)));
__device__ __forceinline__ unsigned cvtpk_s(float lo,float hi){f32x2_t v={lo,hi};bf16x2_t b=__builtin_convertvector(v,bf16x2_t);return __builtin_bit_cast(unsigned,b);}
#define WAIT_BAR(N) asm volatile("s_waitcnt vmcnt(" #N ") lgkmcnt(0)\n\ts_barrier":::"memory")

__device__ __forceinline__ void qkt(f32x16&p0,f32x16&p1,const char*Kslot,const bf16x8*qr,const f32x16&negm,int r32,int hi){
  const char*kb=Kslot+hi*1024+r32*16;
  #pragma unroll
  for(int d0=0;d0<4;++d0){
    const bf16x8 b0=*reinterpret_cast<const bf16x8*>(kb+d0*2048);
    const bf16x8 b1=*reinterpret_cast<const bf16x8*>(kb+d0*2048+512);
    if(d0==0){p0=__builtin_amdgcn_mfma_f32_32x32x16_bf16(b0,qr[0],negm,0,0,0);p1=__builtin_amdgcn_mfma_f32_32x32x16_bf16(b1,qr[0],negm,0,0,0);}
    else{p0=__builtin_amdgcn_mfma_f32_32x32x16_bf16(b0,qr[d0],p0,0,0,0);p1=__builtin_amdgcn_mfma_f32_32x32x16_bf16(b1,qr[d0],p1,0,0,0);}}
}
typedef __attribute__((address_space(3))) const char* lds_cptr;
typedef short v4i16_t __attribute__((ext_vector_type(4)));
__device__ __forceinline__ void kload8(bf16x8*kf,lds_cptr kp){
  kf[0]=*(const __attribute__((address_space(3))) bf16x8*)(kp);      kf[1]=*(const __attribute__((address_space(3))) bf16x8*)(kp+512);
  kf[2]=*(const __attribute__((address_space(3))) bf16x8*)(kp+2048); kf[3]=*(const __attribute__((address_space(3))) bf16x8*)(kp+2560);
  kf[4]=*(const __attribute__((address_space(3))) bf16x8*)(kp+4096); kf[5]=*(const __attribute__((address_space(3))) bf16x8*)(kp+4608);
  kf[6]=*(const __attribute__((address_space(3))) bf16x8*)(kp+6144); kf[7]=*(const __attribute__((address_space(3))) bf16x8*)(kp+6656);
}
__device__ __forceinline__ void kload2(bf16x8*kf,lds_cptr kp,int j){ kf[2*j]=*(const __attribute__((address_space(3))) bf16x8*)(kp+j*2048); kf[2*j+1]=*(const __attribute__((address_space(3))) bf16x8*)(kp+j*2048+512); }
__device__ __forceinline__ s16x4 vtr(lds_cptr p){ return __builtin_bit_cast(s16x4,__builtin_amdgcn_ds_read_tr16_b64_v4i16((__attribute__((address_space(3))) v4i16_t*)p)); }
__device__ __forceinline__ float rowmax(const f32x16&p0,const f32x16&p1){
  float a=max3f(p0[0],p0[1],p1[0]),b=max3f(p0[2],p0[3],p1[1]);a=max3f(a,p1[2],p1[3]);
  #pragma unroll
  for(int r=4;r<16;r+=4){a=max3f(a,p0[r],p0[r+1]);b=max3f(b,p0[r+2],p0[r+3]);a=max3f(a,p1[r],p1[r+1]);b=max3f(b,p1[r+2],p1[r+3]);}
  const float m=max2f(a,b);
  auto rr=__builtin_amdgcn_permlane32_swap(__float_as_uint(m),__float_as_uint(m),false,false);
  return max2f(__uint_as_float(rr[0]),__uint_as_float(rr[1]));
}
__device__ __forceinline__ void pv(f32x16*o,int vb,bf16x8 pa0,bf16x8 pa1,bf16x8 pa2,bf16x8 pa3){
  #pragma unroll
  for(int d0=0;d0<2;++d0){s16x4 lo[4],hi[4];
    #pragma unroll
    for(int ks=0;ks<4;++ks){
      asm volatile("ds_read_b64_tr_b16 %0,%1 offset:%c2":"=&v"(lo[ks]):"v"(vb),"i"(d0*4096+ks*1024):"memory");
      asm volatile("ds_read_b64_tr_b16 %0,%1 offset:%c2":"=&v"(hi[ks]):"v"(vb),"i"(d0*4096+ks*1024+512):"memory");}
    asm volatile("s_waitcnt lgkmcnt(0)":::"memory");SBAR();
    #define PK(k) (bf16x8){lo[k][0],lo[k][1],lo[k][2],lo[k][3],hi[k][0],hi[k][1],hi[k][2],hi[k][3]}
    o[d0]=__builtin_amdgcn_mfma_f32_32x32x16_bf16(pa0,PK(0),o[d0],0,0,0);
    o[d0]=__builtin_amdgcn_mfma_f32_32x32x16_bf16(pa1,PK(1),o[d0],0,0,0);
    o[d0]=__builtin_amdgcn_mfma_f32_32x32x16_bf16(pa2,PK(2),o[d0],0,0,0);
    o[d0]=__builtin_amdgcn_mfma_f32_32x32x16_bf16(pa3,PK(3),o[d0],0,0,0);
    #undef PK
  }
}

#ifndef ATTN_STORE16
#define ATTN_STORE16(p,v) (*(u32x4*)(p)=(v))
#endif
template<int THRL> __device__ __forceinline__ void attn_unit(float cb,int b,int h,int kvh,int qb,const bf16*Q,const bf16*__restrict__ K,const bf16*__restrict__ V,bf16*O,float*SS,char*shm){
  const int tid=threadIdx.x,lane=tid&63,r32=lane&31,hi=lane>>5; const int wid=__builtin_amdgcn_readfirstlane(tid>>6);
  const long rowbase=(long)b*SEQ; const int q0=qb*QB;
  const bf16*Qw=Q+(rowbase+q0+wid*QBLK)*PP+h*D;
  const bf16*Kh=K+rowbase*PP+kvh*D,*Vh=V+rowbase*PP+kvh*D;
  const unsigned lds0=(unsigned)(uintptr_t)shm;
  float*wsf=(float*)(shm+LDS_WS)+wid*64;
  const bf16*ksrc=Kh+(long)lane*PP+wid*8;
  const bf16*vsrc=Vh+(long)(16*(wid&3)+(lane>>2))*PP+(wid>>2)*32+(lane&3)*8;
  const unsigned kdst=lds0+LDS_K+wid*1024, vdst=lds0+LDS_V+wid*1024;
  #define DMA_K(t,slot) glds16(ksrc+(long)(t)*KVBLK*PP,(unsigned)__builtin_amdgcn_readfirstlane(kdst+(slot)))
  #define DMA_V(t,slot) glds16(vsrc+(long)(t)*KVBLK*PP,(unsigned)__builtin_amdgcn_readfirstlane(vdst+(slot)))
  const int vb0=(int)(lds0+LDS_V)+((lane>>4)&1)*32+(lane&3)*8+(4*hi+((lane&15)>>2))*64;
  const char*Kbase=shm+LDS_K; bf16x8 kf[8];
  const lds_cptr shm3=(lds_cptr)shm; const lds_cptr kp0=shm3+LDS_K+hi*1024+r32*16; const lds_cptr vp0=shm3+LDS_V+((lane>>4)&1)*32+(lane&3)*8+(4*hi+((lane&15)>>2))*64;
  const int NT=SEQ/KVBLK;
  DMA_K(0,0);DMA_V(0,0);DMA_K(1,SLOTB);
  bf16x8 qr[4];
  #pragma unroll
  for(int d0=0;d0<4;++d0)qr[d0]=*reinterpret_cast<const bf16x8*>(&Qw[(long)r32*PP+d0*16+hi*8]);
  float l_reg=0.f;f32x16 o[2];o[0]=f32x16{};o[1]=f32x16{};f32x16 negm;
  #pragma unroll
  for(int r=0;r<16;++r)negm[r]=-cb;
  asm volatile("":"+v"(negm));
  const int qrel=wid*QBLK+r32;
  #define CMASK(P0,P1,t) do{}while(0)
  #define START(P0,P1) do{ _Pragma("unroll") for(int r=0;r<16;++r)P0[r]=__builtin_amdgcn_exp2f(P0[r]); }while(0)
  #define RESC() do{}while(0)
  f32x16 pA0,pA1,pB0,pB1;
  int sl_prev=0,sl_cur=0,sl_next=SLOTB;
  #define ROT() do{sl_prev=sl_cur;sl_cur=sl_next;sl_next=(sl_next==(NSLOT-1)*SLOTB)?0:sl_next+SLOTB;}while(0)
  DMA_K(2,2*SLOTB);
  WAIT_BAR(3);
  qkt(pA0,pA1,Kbase,qr,negm,r32,hi);asm volatile("s_nop 15\n\ts_nop 7":"+v"(pA0),"+v"(pA1));CMASK(pA0,pA1,0);
  START(pA0,pA1);
  _Pragma("unroll") for(int r=0;r<16;++r)pA1[r]=__builtin_amdgcn_exp2f(pA1[r]);
  WAIT_BAR(0);
  DMA_K(3,0);DMA_V(1,SLOTB);
  ROT();
  kload8(kf,kp0+sl_cur);
  WAIT_BAR(2);
  s16x4 vlo[8],vhi[8]; u32x4 pw0,pw1,pw2,pw3;
  #define PKW(P,B) cvtpk_s(P[B],P[B+1])
  #define PAF(k) __builtin_bit_cast(bf16x8,pw##k)
  #define VFR(i) (bf16x8){vlo[i][0],vlo[i][1],vlo[i][2],vlo[i][3],vhi[i][0],vhi[i][1],vhi[i][2],vhi[i][3]}
  #define PIN(x) asm volatile("":"+v"(x))
  #define MX3(a,b,c) __builtin_fmaxf(__builtin_fmaxf((a),(b)),(c))
  #define GAPA(MF,A0,A1,A2,A3,W0,W1,PW) do{ MF; sacc+=A0; sacc+=A1; sacc+=A2; sacc+=A3; PIN(sacc); W0; W1; PIN(PW); SBAR(); }while(0)
  #define EX(v) __builtin_amdgcn_exp2f(v)
  #define GAPB(MF,X,B) do{ MF; X[B]=EX(X[B]); X[B+1]=EX(X[B+1]); X[B+2]=EX(X[B+2]); X[B+3]=EX(X[B+3]); PIN(X); SBAR(); }while(0)
  #define VRD(i) do{ vlo[i]=vtr(vp_+(((i)>>2)*4096+((i)&3)*1024)); vhi[i]=vtr(vp_+(((i)>>2)*4096+((i)&3)*1024+512)); }while(0)
  #define KRD(G,j) do{ if(G){ kload2(kf,kp0+sl_next,j); SBAR(); } }while(0)
  #define STEP(C0,C1,P0,P1,t,GK,GV,GL) do{ SBAR(); \
    const lds_cptr vp_=vp0+sl_prev; \
    VRD(0); SBAR(); float sacc=(P0[0]+P0[1]); \
    GAPA(C0=__builtin_amdgcn_mfma_f32_32x32x16_bf16(kf[0],qr[0],negm,0,0,0), P0[2],P0[3],P0[4],P0[5],     pw0[0]=PKW(P0,0), pw0[1]=PKW(P0,2), pw0); \
    VRD(4); SBAR(); GAPA(C1=__builtin_amdgcn_mfma_f32_32x32x16_bf16(kf[1],qr[0],negm,0,0,0), P0[6],P0[7],P0[8],P0[9],     pw0[2]=PKW(P0,4), pw0[3]=PKW(P0,6), pw0); \
    VRD(1); SBAR(); GAPA(C0=__builtin_amdgcn_mfma_f32_32x32x16_bf16(kf[2],qr[1],C0,0,0,0),   P0[10],P0[11],P0[12],P0[13], pw1[0]=PKW(P0,8), pw1[1]=PKW(P0,10), pw1); \
    VRD(5); SBAR(); GAPA(C1=__builtin_amdgcn_mfma_f32_32x32x16_bf16(kf[3],qr[1],C1,0,0,0),   P0[14],P0[15],P1[0],P1[1],   pw1[2]=PKW(P0,12),pw1[3]=PKW(P0,14), pw1); \
    VRD(2); SBAR(); GAPA(C0=__builtin_amdgcn_mfma_f32_32x32x16_bf16(kf[4],qr[2],C0,0,0,0),   P1[2],P1[3],P1[4],P1[5],     pw2[0]=PKW(P1,0), pw2[1]=PKW(P1,2), pw2); \
    VRD(6); SBAR(); GAPA(C1=__builtin_amdgcn_mfma_f32_32x32x16_bf16(kf[5],qr[2],C1,0,0,0),   P1[6],P1[7],P1[8],P1[9],     pw2[2]=PKW(P1,4), pw2[3]=PKW(P1,6), pw2); \
    VRD(3); SBAR(); GAPA(C0=__builtin_amdgcn_mfma_f32_32x32x16_bf16(kf[6],qr[3],C0,0,0,0),   P1[10],P1[11],P1[12],P1[13], pw3[0]=PKW(P1,8), pw3[1]=PKW(P1,10), pw3); \
    VRD(7); SBAR(); GAPA(C1=__builtin_amdgcn_mfma_f32_32x32x16_bf16(kf[7],qr[3],C1,0,0,0),   P1[14],P1[15],0.f,0.f,       pw3[2]=PKW(P1,12),pw3[3]=PKW(P1,14), pw3); \
    l_reg+=sacc; \
    if(GK){DMA_K((t)+3,sl_cur);} if(GV){DMA_V((t)+1,sl_next);} \
    CMASK(C0,C1,t); \
    SBAR(); \
    GAPB(o[0]=__builtin_amdgcn_mfma_f32_32x32x16_bf16(PAF(0),VFR(0),o[0],0,0,0), C0,0); \
    GAPB(o[1]=__builtin_amdgcn_mfma_f32_32x32x16_bf16(PAF(0),VFR(4),o[1],0,0,0), C0,4); \
    KRD(GL,0); GAPB(o[0]=__builtin_amdgcn_mfma_f32_32x32x16_bf16(PAF(1),VFR(1),o[0],0,0,0), C0,8); \
    KRD(GL,1); GAPB(o[1]=__builtin_amdgcn_mfma_f32_32x32x16_bf16(PAF(1),VFR(5),o[1],0,0,0), C0,12); \
    KRD(GL,2); GAPB(o[0]=__builtin_amdgcn_mfma_f32_32x32x16_bf16(PAF(2),VFR(2),o[0],0,0,0), C1,0); \
    KRD(GL,3); GAPB(o[1]=__builtin_amdgcn_mfma_f32_32x32x16_bf16(PAF(2),VFR(6),o[1],0,0,0), C1,4); \
    GAPB(o[0]=__builtin_amdgcn_mfma_f32_32x32x16_bf16(PAF(3),VFR(3),o[0],0,0,0), C1,8); \
    GAPB(o[1]=__builtin_amdgcn_mfma_f32_32x32x16_bf16(PAF(3),VFR(7),o[1],0,0,0), C1,12); \
    }while(0)
  int t=1;
  #undef CMASK
  #define CMASK(P0,P1,t) do{}while(0)
  for(;t+5<NT;t+=2){
    STEP(pB0,pB1,pA0,pA1,t,true,true,true);     WAIT_BAR(2); RESC(); ROT();
    STEP(pA0,pA1,pB0,pB1,t+1,true,true,true);   WAIT_BAR(2); RESC(); ROT();
  }
  #undef CMASK
  #define CMASK(P0,P1,t) do{}while(0)
  #define ENDW(tt) do{ if((tt)+3<NT){WAIT_BAR(2);} else if((tt)+2<NT){WAIT_BAR(1);} else {WAIT_BAR(0);} }while(0)
  for(;t+1<NT;t+=2){
    STEP(pB0,pB1,pA0,pA1,t,(t+3<NT),(t+1<NT),(t+1<NT));       ENDW(t);   RESC(); ROT();
    STEP(pA0,pA1,pB0,pB1,t+1,(t+4<NT),(t+2<NT),(t+2<NT));     ENDW(t+1); RESC(); ROT();
  }
  STEP(pB0,pB1,pA0,pA1,NT-1,false,false,false); RESC();
  { float sacc=pB0[0]+pB0[1]; _Pragma("unroll") for(int r=2;r<16;++r)sacc+=pB0[r]; _Pragma("unroll") for(int r=0;r<16;++r)sacc+=pB1[r]; l_reg+=sacc;
    pw0=(u32x4){PKW(pB0,0),PKW(pB0,2),PKW(pB0,4),PKW(pB0,6)};pw1=(u32x4){PKW(pB0,8),PKW(pB0,10),PKW(pB0,12),PKW(pB0,14)};pw2=(u32x4){PKW(pB1,0),PKW(pB1,2),PKW(pB1,4),PKW(pB1,6)};pw3=(u32x4){PKW(pB1,8),PKW(pB1,10),PKW(pB1,12),PKW(pB1,14)};
    SBAR(); pv(o,vb0+sl_cur,PAF(0),PAF(1),PAF(2),PAF(3)); }
  #undef PKW
  #undef PAF
  #undef VFR
  #undef PIN
  #undef MX3
  #undef GAPA
  #undef GAPB
  #undef EX
  #undef VRD
  #undef KRD
  #undef STEP
  #undef ENDW
  {auto rr=__builtin_amdgcn_permlane32_swap(__float_as_uint(l_reg),__float_as_uint(l_reg),false,false);l_reg=__uint_as_float(rr[0])+__uint_as_float(rr[1]);}
  if(hi==0)wsf[32+r32]=l_reg;asm volatile("s_waitcnt lgkmcnt(0)":::"memory");
  float rli[16];
  #pragma unroll
  for(int r=0;r<16;++r)rli[r]=__builtin_amdgcn_rcpf(wsf[32+crow(r,hi)]);
  bf16*Ow=O+(rowbase+q0+wid*QBLK)*OP+h*D;
  { bf16*stg=(bf16*)(shm+LDS_OST)+wid*2048;
    #pragma unroll
    for(int r=0;r<16;++r){const int orow=crow(r,hi);
      #pragma unroll
      for(int d0=0;d0<2;++d0)stg[orow*64+d0*32+r32]=__float2bfloat16(o[d0][r]*rli[r]);}
    asm volatile("s_waitcnt lgkmcnt(0)":::"memory");
    #pragma unroll
    for(int i=0;i<4;++i){const int row=i*8+(lane>>3),ch=lane&7; const u32x4 v=*(const u32x4*)(stg+row*64+ch*8); ATTN_STORE16(Ow+(long)row*OP+ch*8,v);
      float q=0.f; { const unsigned w4[4]={v.x,v.y,v.z,v.w};
        #pragma unroll
        for(int k=0;k<4;++k){const float a=__uint_as_float(w4[k]<<16),b2=__uint_as_float(w4[k]&0xffff0000u); q+=a*a+b2*b2;} }
      q+=__builtin_bit_cast(float,__builtin_amdgcn_update_dpp(0,__builtin_bit_cast(int,q),0xB1,0xF,0xF,true));
      q+=__builtin_bit_cast(float,__builtin_amdgcn_update_dpp(0,__builtin_bit_cast(int,q),0x4E,0xF,0xF,true));
      q+=__builtin_bit_cast(float,__builtin_amdgcn_update_dpp(0,__builtin_bit_cast(int,q),0x141,0xF,0xF,true));
      if(ch==0)SS[(rowbase+q0+wid*QBLK+row)*8+h]=q; } }
  asm volatile("s_waitcnt lgkmcnt(0)\n\ts_barrier":::"memory");
  #undef DMA_K
  #undef DMA_V
  #undef CMASK
  #undef START
  #undef RESC
  #undef ROT
}
constexpr int ATTN_LDS_BYTES=LDS_BYTES;
struct AttnTensors { const bf16* Q; const bf16* K; const bf16* V; bf16* O; float* SS; };
struct AttnUnit { int b, h, kvh, qb; };
struct StaticOrder {
  int vcu, G;
  __device__ __forceinline__ explicit StaticOrder(int grid,int block):vcu((grid%8==0)?(block%8)*(grid/8)+block/8:block),G(grid){}
  __device__ __forceinline__ bool next(int i,AttnUnit&u)const{ const int id=vcu+i*G; const int per=NQB*BATCH*NKV; if(id>=4*per)return false;
    const int hq=id/per, rem=id%per, bk=rem/NQB; u.qb=rem%NQB; u.b=bk/NKV; u.kvh=bk%NKV; u.h=u.kvh*4+hq; return true; }
  __device__ __forceinline__ void a_ready(const AttnUnit&)const{}
  __device__ __forceinline__ void done(const AttnUnit&)const{}
};
template<class Sched,int THRL=8> __device__ __forceinline__ void attn_phase(char*lds,const AttnTensors&T,const Sched&S,float cb){
  AttnUnit u;
  for(int i=0;S.next(i,u);++i){ S.a_ready(u); attn_unit<THRL>(cb,u.b,u.h,u.kvh,u.qb,T.Q,T.K,T.V,T.O,T.SS,lds); S.done(u); }
}
#undef SBAR
#undef WAIT_BAR
}

namespace attn8 {
typedef int v8i __attribute__((ext_vector_type(8)));
using f32x16 = __attribute__((ext_vector_type(16))) float;
using u32x4 = __attribute__((ext_vector_type(4))) unsigned;
typedef __attribute__((address_space(3))) const unsigned char* lds_cptr;
constexpr int SEQ = 8192, QB = 256, NQB = SEQ / QB, KVT = 64, NT = SEQ / KVT, OP = 1024;
constexpr int NSLOT = 8, SLOTB = 8192, LDS_OST = NSLOT * SLOTB, LDS_BYTES = LDS_OST + 8 * 4096;
__device__ __forceinline__ int crow(int r, int hi) { return (r & 3) + 8 * (r >> 2) + 4 * hi; }
__device__ __forceinline__ unsigned f2bf_rne(float f) { const unsigned u = __float_as_uint(f); return (u + 0x7fffu + ((u >> 16) & 1u)) >> 16; }
__host__ __device__ __forceinline__ int kpos(int kappa) { return 32 * ((kappa >> 2) & 1) + 16 * (kappa >> 5) + (kappa & 3) + 4 * ((kappa & 31) >> 3); }
__device__ __forceinline__ void glds16(const void* gsrc, unsigned lds_dst) { unsigned keep;
    asm volatile("s_mov_b32 %0, m0\n\ts_mov_b32 m0, %2\n\ts_nop 0\n\tglobal_load_lds_dwordx4 %1, off\n\ts_mov_b32 m0, %0" : "=&s"(keep) : "v"(gsrc), "s"(lds_dst) : "memory"); }
#define A8_MFMA(a, b, c) __builtin_amdgcn_mfma_scale_f32_32x32x64_f8f6f4(a, b, c, 0, 0, 0, 0x7F7F7F7F, 0, 0x7F7F7F7F)
struct Tensors { const unsigned char* Q8; const unsigned char* K8; const unsigned char* V8T; unsigned short* O; float* SS; };

__device__ __forceinline__ void unit(float cb8, int b, int h, int kvh, int qb, const Tensors& T, char* shm) {
    const int tid = threadIdx.x, lane = tid & 63, r32 = lane & 31, hi = lane >> 5; const int wid = __builtin_amdgcn_readfirstlane(tid >> 6);
    const long rowbase = (long)b * SEQ; const int q0 = qb * QB;
    const unsigned lds0 = (unsigned)(uintptr_t)shm;
    const int prow = 16 * (wid & 3) + (lane >> 2), pch = (lane & 3) ^ ((prow >> 2) & 3);
    const unsigned char* src = (wid < 4) ? T.K8 + (size_t)(rowbase + prow) * 128 + kvh * 64 + pch * 16
                                         : T.V8T + ((size_t)((b * 2 + kvh) * 64 + prow)) * SEQ + pch * 16;
    const long tstep = (wid < 4) ? (long)KVT * 128 : (long)KVT;
    const unsigned dst0 = lds0 + (wid < 4 ? 0 : 4096) + (wid & 3) * 1024;
#define A8_DMA(t, slot) glds16(src + (long)(t) * tstep, (unsigned)__builtin_amdgcn_readfirstlane(dst0 + (slot) * SLOTB))
    A8_DMA(0, 0); A8_DMA(1, 1); A8_DMA(2, 2);
    v8i qv; { const unsigned char* qp = T.Q8 + (size_t)(rowbase + q0 + wid * 32 + r32) * 512 + h * 64 + 32 * hi;
              const u32x4 a = *(const u32x4*)qp, c = *(const u32x4*)(qp + 16); qv = (v8i){(int)a.x, (int)a.y, (int)a.z, (int)a.w, (int)c.x, (int)c.y, (int)c.z, (int)c.w}; }
    const int f = (r32 >> 2) & 3;
    const int o0 = r32 * 64 + 16 * ((2 * hi) ^ f), o1 = r32 * 64 + 16 * ((2 * hi + 1) ^ f);
    const lds_cptr sh3 = (lds_cptr)shm;
    f32x16 negc, O0 = f32x16{}, O1 = f32x16{};
#pragma unroll
    for (int r = 0; r < 16; ++r) negc[r] = -cb8;
    f32x16 L = f32x16{}; v8i ones = {0x38383838, 0x38383838, 0x38383838, 0x38383838, 0x38383838, 0x38383838, 0x38383838, 0x38383838};
    asm volatile("" : "+v"(ones));
#define A8_FRAG(p, blk) ({ const u32x4 x_ = *(const __attribute__((address_space(3))) u32x4*)((p) + (blk) * 2048 + o0), y_ = *(const __attribute__((address_space(3))) u32x4*)((p) + (blk) * 2048 + o1); \
                           (v8i){(int)x_.x, (int)x_.y, (int)x_.z, (int)x_.w, (int)y_.x, (int)y_.y, (int)y_.z, (int)y_.w}; })
#define A8_SB __builtin_amdgcn_sched_barrier(0)
#define A8_E(S, r) S[r] = __builtin_amdgcn_exp2f(S[r])
#define A8_C(PW, w, S, d) { PW[w] = __builtin_amdgcn_cvt_pk_fp8_f32(S[4 * (d)], S[4 * (d) + 1], PW[w], false); PW[w] = __builtin_amdgcn_cvt_pk_fp8_f32(S[4 * (d) + 2], S[4 * (d) + 3], PW[w], true); }
#define A8_ITER(t, SA0, SA1, SB0, SB1, PW, PR, PV) { \
        asm volatile("s_waitcnt vmcnt(1) lgkmcnt(0)\n\ts_barrier" ::: "memory");        \
        { const int tn = (t) + 3 < NT ? (t) + 3 : NT - 1; A8_DMA(tn, ((t) + 3) & (NSLOT - 1)); }     \
        const lds_cptr kn = sh3 + (((t) + 1) & (NSLOT - 1)) * SLOTB, vb = sh3 + (((t) + NSLOT - 1) & (NSLOT - 1)) * SLOTB + 4096; \
        const v8i k0 = A8_FRAG(kn, 0), k1 = A8_FRAG(kn, 1); v8i v0 = k0, v1 = k1; if (PV) { v0 = A8_FRAG(vb, 0); v1 = A8_FRAG(vb, 1); } \
        A8_SB; A8_E(SA0, 0); A8_E(SA0, 1); A8_E(SA0, 2); A8_E(SA0, 3); A8_E(SA0, 4); A8_E(SA0, 5); A8_SB; \
        SB0 = A8_MFMA(k0, qv, negc); A8_SB; \
        A8_E(SA0, 6); A8_E(SA0, 7); A8_E(SA0, 8); A8_E(SA0, 9); A8_E(SA0, 10); A8_E(SA0, 11); A8_E(SA0, 12); A8_SB; \
        SB1 = A8_MFMA(k1, qv, negc); A8_SB; \
        A8_E(SA0, 13); A8_E(SA0, 14); A8_E(SA0, 15); A8_E(SA1, 0); A8_E(SA1, 1); A8_E(SA1, 2); A8_E(SA1, 3); A8_SB; \
        if (PV) O0 = A8_MFMA(v0, PR, O0); A8_SB; \
        A8_E(SA1, 4); A8_E(SA1, 5); A8_E(SA1, 6); A8_E(SA1, 7); A8_E(SA1, 8); A8_E(SA1, 9); A8_SB; \
        if (PV) O1 = A8_MFMA(v1, PR, O1); A8_SB; \
        A8_E(SA1, 10); A8_E(SA1, 11); A8_E(SA1, 12); A8_E(SA1, 13); A8_E(SA1, 14); A8_E(SA1, 15); A8_C(PW, 0, SA0, 0); A8_C(PW, 1, SA0, 1); A8_SB; \
        if (PV) L = A8_MFMA(ones, PR, L); A8_SB; \
        A8_C(PW, 2, SA0, 2); A8_C(PW, 3, SA0, 3); A8_C(PW, 4, SA1, 0); A8_C(PW, 5, SA1, 1); A8_C(PW, 6, SA1, 2); A8_C(PW, 7, SA1, 3); A8_SB; }
    asm volatile("s_waitcnt vmcnt(2) lgkmcnt(0)\n\ts_barrier" ::: "memory");
    f32x16 Sa0, Sa1, Sb0, Sb1; v8i pA = {0, 0, 0, 0, 0, 0, 0, 0}, pB = {0, 0, 0, 0, 0, 0, 0, 0};
    { const v8i k0 = A8_FRAG(sh3, 0), k1 = A8_FRAG(sh3, 1); Sa0 = A8_MFMA(k0, qv, negc); Sa1 = A8_MFMA(k1, qv, negc); }
    A8_ITER(0, Sa0, Sa1, Sb0, Sb1, pA, pB, false);
    A8_ITER(1, Sb0, Sb1, Sa0, Sa1, pB, pA, true);
    for (int t = 2; t < NT; t += 2) {
        A8_ITER(t, Sa0, Sa1, Sb0, Sb1, pA, pB, true);
        A8_ITER(t + 1, Sb0, Sb1, Sa0, Sa1, pB, pA, true);
    }
    { const lds_cptr vb = sh3 + ((NT - 1) & (NSLOT - 1)) * SLOTB + 4096; const v8i v0 = A8_FRAG(vb, 0), v1 = A8_FRAG(vb, 1);
      O0 = A8_MFMA(v0, pB, O0); O1 = A8_MFMA(v1, pB, O1); L = A8_MFMA(ones, pB, L); }
#undef A8_ITER
#undef A8_C
#undef A8_E
#undef A8_SB
    const float rl = 1.0f / (8.0f * L[0]);
    unsigned short* stg = (unsigned short*)(shm + LDS_OST) + wid * 2048;
#pragma unroll
    for (int r = 0; r < 16; ++r) { const int d = crow(r, hi);
        stg[r32 * 64 + d] = (unsigned short)(f2bf_rne(O0[r] * rl)); stg[r32 * 64 + 32 + d] = (unsigned short)(f2bf_rne(O1[r] * rl)); }
    asm volatile("s_waitcnt lgkmcnt(0)" ::: "memory");
    unsigned short* Ow = T.O + (rowbase + q0 + wid * 32) * OP + h * 64;
#pragma unroll
    for (int i = 0; i < 4; ++i) { const int row = i * 8 + (lane >> 3), ch = lane & 7; const u32x4 v = *(const u32x4*)(stg + row * 64 + ch * 8); *(u32x4*)(Ow + (long)row * OP + ch * 8) = v;
        float q = 0.f; { const unsigned w4[4] = {v.x, v.y, v.z, v.w};
#pragma unroll
            for (int k = 0; k < 4; ++k) { const float a = __uint_as_float(w4[k] << 16), b2 = __uint_as_float(w4[k] & 0xffff0000u); q += a * a + b2 * b2; } }
        q += __builtin_bit_cast(float, __builtin_amdgcn_update_dpp(0, __builtin_bit_cast(int, q), 0xB1, 0xF, 0xF, true));
        q += __builtin_bit_cast(float, __builtin_amdgcn_update_dpp(0, __builtin_bit_cast(int, q), 0x4E, 0xF, 0xF, true));
        q += __builtin_bit_cast(float, __builtin_amdgcn_update_dpp(0, __builtin_bit_cast(int, q), 0x141, 0xF, 0xF, true));
        if (ch == 0) T.SS[(rowbase + q0 + wid * 32 + row) * 8 + h] = q; }
    asm volatile("s_waitcnt vmcnt(0) lgkmcnt(0)\n\ts_barrier" ::: "memory");
#undef A8_DMA
#undef A8_FRAG
}
__device__ __forceinline__ void phase(char* lds, const Tensors& T, int grid, int block, float cb8) {
    const int vcu = (grid % 8 == 0) ? (block % 8) * (grid / 8) + block / 8 : block;
    for (int id = vcu; id < 4 * NQB * 8; id += grid) {
        const int per = NQB * 8, hq = id / per, rem = id % per, bk = rem / NQB, qb = rem % NQB, b = bk / 2, kvh = bk % 2;
        unit(cb8, b, kvh * 4 + hq, kvh, qb, T, lds);
    }
}
#undef A8_MFMA
}

namespace natten {
using bf16x8 = __attribute__((ext_vector_type(8))) short;
using s16x4 = __attribute__((ext_vector_type(4))) short;
using f32x4 = __attribute__((ext_vector_type(4))) float;
using u32x4 = __attribute__((ext_vector_type(4))) unsigned;
using u32x2 = __attribute__((ext_vector_type(2))) unsigned;
typedef unsigned short bf16_t;
typedef __attribute__((address_space(3))) unsigned char* lds_ptr;
typedef short v4i16_t __attribute__((ext_vector_type(4)));
constexpr int SEQ = 8192, GW = 64, ROWS = 128, PP = 2304, OP = 1024, KH = 8, KW = 16;
constexpr int LDS_K = 0, LDS_V = 9 * 64 * 128, LDS_BIAS = 2 * LDS_V, LDS_BYTES = LDS_BIAS + 15 * 64 * 4;
__device__ __forceinline__ int clampi(int v, int lo, int hi) { return v < lo ? lo : (v > hi ? hi : v); }
__device__ __forceinline__ unsigned cvtpk(float lo, float hi) { unsigned r; asm volatile("v_cvt_pk_bf16_f32 %0, %1, %2" : "=v"(r) : "v"(lo), "v"(hi)); return r; }
__device__ __forceinline__ s16x4 vtr(const __attribute__((address_space(3))) unsigned char* p) { return __builtin_bit_cast(s16x4, __builtin_amdgcn_ds_read_tr16_b64_v4i16((__attribute__((address_space(3))) v4i16_t*)p)); }

__device__ __forceinline__ int win_lo(int rp) { return clampi(2 * rp - 4, 0, ROWS - KH); }
__device__ __forceinline__ int win_hi(int rp) { const int lo = win_lo(rp); return lo + ((ROWS - lo) < 9 ? (ROWS - lo) : 9) - 1; }
__device__ __forceinline__ void stage_chunk(lds_ptr lds, int row, int col, int c, bool isv, u32x4 v) {
    const int s = row % 9;
    if (!isv) *(__attribute__((address_space(3))) u32x4*)(lds + LDS_K + s * 8192 + col * 128 + 16 * (c ^ ((col >> 1) & 7))) = v;
    else      *(__attribute__((address_space(3))) u32x4*)(lds + LDS_V + s * 8192 + col * 128 + 32 * ((c >> 1) ^ ((col >> 1) & 3)) + 16 * (c & 1)) = v;
}
__device__ __forceinline__ void natten_block(int b, int h, int rp0, int nun, const bf16_t* Qb, const bf16_t* Kb, const bf16_t* Vb, const float* rpb, bf16_t* O, float* SS, lds_ptr lds) {
    const int tid = threadIdx.x, lane = tid & 63, wid = __builtin_amdgcn_readfirstlane(tid >> 6);
    for (int n = tid; n < 15 * 64; n += 512) {
        const int dr = n >> 6, x = (n & 63) - 16;
        const float v = (x >= 0 && x < 31) ? rpb[(h * 15 + dr) * 31 + x] * 1.4426950408889634f : 0.f;
        *(__attribute__((address_space(3))) float*)(lds + LDS_BIAS + n * 4) = v;
    }
    int have_hi = win_hi(rp0);
    { const int lo = win_lo(rp0), nr = have_hi - lo + 1;
      for (int n = tid; n < nr * 1024; n += 512) {
          const int r = n >> 10, m = n & 1023, isv = m >> 9, col = (m & 511) >> 3, c = m & 7;
          const size_t tokk = (size_t)b * SEQ + (size_t)(lo + r) * GW + col;
          stage_chunk(lds, lo + r, col, c, isv, *(const u32x4*)((isv ? Vb : Kb) + tokk * PP + h * 64 + c * 8));
      } }
    __syncthreads();
    const int g = lane >> 4, i16 = lane & 15, q4 = i16 >> 2, p4 = lane & 3;
    for (int u = 0; u < nun; ++u) {
        const int rp = rp0 + u;
        u32x4 pf[4]; int nnew = 0;
        if (u + 1 < nun) { nnew = win_hi(rp + 1) - have_hi;
#pragma unroll
            for (int i = 0; i < 4; ++i) { const int n = tid + 512 * i; const int r = n >> 10, m = n & 1023, isv = m >> 9, col = (m & 511) >> 3, c = m & 7;
                if (r < nnew) { const size_t tokk = (size_t)b * SEQ + (size_t)(have_hi + 1 + r) * GW + col; pf[i] = *(const u32x4*)((isv ? Vb : Kb) + tokk * PP + h * 64 + c * 8); } } }
        const int rq = 2 * rp + (wid >> 2), c0 = 16 * (wid & 3), cw = clampi(c0 - 8, 0, 32), rs = clampi(rq - 4, 0, ROWS - KH);
        const int cq = c0 + i16, csq = clampi(cq - 8, 0, GW - KW);
        const size_t tok = (size_t)b * SEQ + (size_t)rq * GW + cq;
        bf16x8 qf[2];
#pragma unroll
        for (int ks = 0; ks < 2; ++ks) qf[ks] = *(const bf16x8*)(Qb + tok * PP + h * 64 + 32 * ks + 8 * g);
        const int swk = ((cw + i16) >> 1) & 7;
        const lds_ptr kp0 = lds + LDS_K + (cw + i16) * 128 + 16 * ((0 + g) ^ swk);
        const lds_ptr kp1 = lds + LDS_K + (cw + i16) * 128 + 16 * ((4 + g) ^ swk);
        int sl[8];
#pragma unroll
        for (int j = 0; j < 8; ++j) sl[j] = ((rs + j) % 9) * 8192;
        f32x4 s[16];
#pragma unroll
        for (int kb = 0; kb < 16; ++kb) {
            const int off = sl[kb >> 1] + (16 * (kb & 1)) * 128;
            const bf16x8 a0 = *(const __attribute__((address_space(3))) bf16x8*)(kp0 + off);
            const bf16x8 a1 = *(const __attribute__((address_space(3))) bf16x8*)(kp1 + off);
            f32x4 z = {0.f, 0.f, 0.f, 0.f};
            z = __builtin_amdgcn_mfma_f32_16x16x32_bf16(a0, qf[0], z, 0, 0, 0);
            s[kb] = __builtin_amdgcn_mfma_f32_16x16x32_bf16(a1, qf[1], z, 0, 0, 0);
        }
        const lds_ptr bp = lds + LDS_BIAS + ((rs - rq + 7) * 64 + (cw + 4 * g - cq + 31)) * 4;
        bool ok[2][4];
#pragma unroll
        for (int hh = 0; hh < 2; ++hh)
#pragma unroll
            for (int r = 0; r < 4; ++r) ok[hh][r] = (unsigned)(cw + 16 * hh + 4 * g + r - csq) < 16u;
        float mx = -3.0e38f;
#pragma unroll
        for (int kb = 0; kb < 16; ++kb)
#pragma unroll
            for (int r = 0; r < 4; ++r) {
                const float bias = *(const __attribute__((address_space(3))) float*)(bp + ((kb >> 1) * 64 + 16 * (kb & 1) + r) * 4);
                const float v = ok[kb & 1][r] ? s[kb][r] + bias : -3.0e38f;
                s[kb][r] = v; mx = fmaxf(mx, v);
            }
        mx = fmaxf(mx, __shfl_xor(mx, 16)); mx = fmaxf(mx, __shfl_xor(mx, 32));
        float l = 0.f;
#pragma unroll
        for (int kb = 0; kb < 16; ++kb)
#pragma unroll
            for (int r = 0; r < 4; ++r) { const float p = __builtin_amdgcn_exp2f(s[kb][r] - mx); s[kb][r] = p; l += p; }
        l += __shfl_xor(l, 16); l += __shfl_xor(l, 32);
        const int swv = (2 * g + (q4 >> 1)) & 3;
        lds_ptr vp[4];
#pragma unroll
        for (int db = 0; db < 4; ++db) vp[db] = lds + LDS_V + (cw + 4 * g + q4) * 128 + 32 * (db ^ swv) + 8 * p4;
        f32x4 o[4];
#pragma unroll
        for (int db = 0; db < 4; ++db) o[db] = (f32x4){0.f, 0.f, 0.f, 0.f};
#pragma unroll
        for (int kk = 0; kk < 8; ++kk) {
            u32x4 pw; pw.x = cvtpk(s[2 * kk][0], s[2 * kk][1]); pw.y = cvtpk(s[2 * kk][2], s[2 * kk][3]); pw.z = cvtpk(s[2 * kk + 1][0], s[2 * kk + 1][1]); pw.w = cvtpk(s[2 * kk + 1][2], s[2 * kk + 1][3]);
            const bf16x8 pb = __builtin_bit_cast(bf16x8, pw);
#pragma unroll
            for (int db = 0; db < 4; ++db) {
                const s16x4 lo = vtr(vp[db] + sl[kk]), hi = vtr(vp[db] + sl[kk] + 16 * 128);
                const bf16x8 a = (bf16x8){lo[0], lo[1], lo[2], lo[3], hi[0], hi[1], hi[2], hi[3]};
                o[db] = __builtin_amdgcn_mfma_f32_16x16x32_bf16(a, pb, o[db], 0, 0, 0);
            }
        }
        const float rl = 1.0f / l;
        bf16_t* op = O + tok * OP + 512 + h * 64 + 4 * g;
        float qs = 0.f;
#pragma unroll
        for (int db = 0; db < 4; ++db) { u32x2 w; w.x = cvtpk(o[db][0] * rl, o[db][1] * rl); w.y = cvtpk(o[db][2] * rl, o[db][3] * rl); *(u32x2*)(op + 16 * db) = w;
            const float a0 = __uint_as_float(w.x << 16), a1 = __uint_as_float(w.x & 0xffff0000u), a2 = __uint_as_float(w.y << 16), a3 = __uint_as_float(w.y & 0xffff0000u); qs += (a0 * a0 + a1 * a1) + (a2 * a2 + a3 * a3); }
        qs += __shfl_xor(qs, 16); qs += __shfl_xor(qs, 32);
        if (g == 0) SS[tok * 8 + h] = qs;
        __syncthreads();
        if (u + 1 < nun) {
#pragma unroll
            for (int i = 0; i < 4; ++i) { const int n = tid + 512 * i; const int r = n >> 10, m = n & 1023, isv = m >> 9, col = (m & 511) >> 3, c = m & 7;
                if (r < nnew) stage_chunk(lds, have_hi + 1 + r, col, c, isv, pf[i]); }
            have_hi += nnew;
            __syncthreads();
        }
    }
}
__device__ __forceinline__ void natten_phase(lds_ptr lds, const bf16_t* Qb, const bf16_t* Kb, const bf16_t* Vb, const float* rpb, bf16_t* O, float* SS, int vcu, int G) {
    for (int it = vcu; it < 256; it += G) { natten_block(it >> 6, (it >> 3) & 7, (it & 7) * 8, 8, Qb, Kb, Vb, rpb, O, SS, lds); __syncthreads(); }
}
}

namespace peer {
using bf16x8 = __attribute__((ext_vector_type(8))) short;
using f32x4 = __attribute__((ext_vector_type(4))) float;
using u32x4 = __attribute__((ext_vector_type(4))) unsigned;
typedef unsigned short bf16_t;
typedef __bf16 bf16x2_t __attribute__((ext_vector_type(2)));
typedef __attribute__((address_space(3))) unsigned char* lds_ptr;
constexpr int LDS_SK = 0, LDS_TAB = 65536, LDS_WV = LDS_TAB + 256, LDS_BYTES = LDS_WV + 8 * 4096;
constexpr float LOG2E = 1.4426950408889634f;

#define PEER_CE(a, b) do { const float hi_ = fmaxf(a, b), lo_ = fminf(a, b); a = hi_; b = lo_; } while (0)
template <int N, bool DESC> __device__ __forceinline__ void bitonic_sort(float (&v)[N]) {
#pragma unroll
    for (int k = 2; k <= N; k <<= 1)
#pragma unroll
        for (int j = k >> 1; j > 0; j >>= 1)
#pragma unroll
            for (int i = 0; i < N; ++i) { const int l = i ^ j; if (l > i) { const bool d = (((i & k) == 0) == DESC); if (d) PEER_CE(v[i], v[l]); else PEER_CE(v[l], v[i]); } }
}
template <bool DESC> __device__ __forceinline__ void oem_sort16(float (&v)[16]) {
#pragma unroll
    for (int p = 1; p < 16; p <<= 1)
#pragma unroll
        for (int k = p; k >= 1; k >>= 1)
#pragma unroll
            for (int j = k % p; j <= 15 - k; j += 2 * k)
#pragma unroll
                for (int i = 0; i < k; ++i) { if (i <= 15 - j - k && ((i + j) / (2 * p) == (i + j + k) / (2 * p))) { if (DESC) PEER_CE(v[i + j], v[i + j + k]); else PEER_CE(v[i + j + k], v[i + j]); } }
}
__device__ __forceinline__ void bitonic_merge16_desc(float (&v)[16]) {
#pragma unroll
    for (int j = 8; j > 0; j >>= 1)
#pragma unroll
        for (int i = 0; i < 16; ++i) { const int l = i ^ j; if (l > i) PEER_CE(v[i], v[l]); }
}
__device__ __forceinline__ void xlane_merge16(float (&v)[16], int mask) {
    float t[16];
#pragma unroll
    for (int i = 0; i < 16; ++i) t[i] = fmaxf(v[i], __shfl_xor(v[15 - i], mask));
#pragma unroll
    for (int i = 0; i < 16; ++i) v[i] = t[i];
    bitonic_merge16_desc(v);
}
__device__ __forceinline__ float gelu_erf(float v) {
    const float av = fabsf(v), t = 1.0f / (1.0f + 0.2316418882f * av);
    float q = t * 0.5307027145f + (-0.7265760135f); q = q * t + 0.7107068705f; q = q * t + (-0.142248368f); q = q * t + 0.127414796f; q = q * t;
    const float e = __builtin_amdgcn_exp2f((v * v) * (-0.72134752044f));
    const float m = v * (q * e);
    return v < 0.f ? m : v - m;
}
__device__ __forceinline__ float dot8(u32x4 a, u32x4 b, float acc) {
    typedef __bf16 bf16x8_t __attribute__((ext_vector_type(8)));
    const bf16x8_t va = __builtin_bit_cast(bf16x8_t, a), vb = __builtin_bit_cast(bf16x8_t, b);
    acc = __builtin_amdgcn_fdot2_f32_bf16((bf16x2_t){va[0], va[1]}, (bf16x2_t){vb[0], vb[1]}, acc, false);
    acc = __builtin_amdgcn_fdot2_f32_bf16((bf16x2_t){va[2], va[3]}, (bf16x2_t){vb[2], vb[3]}, acc, false);
    acc = __builtin_amdgcn_fdot2_f32_bf16((bf16x2_t){va[4], va[5]}, (bf16x2_t){vb[4], vb[5]}, acc, false);
    acc = __builtin_amdgcn_fdot2_f32_bf16((bf16x2_t){va[6], va[7]}, (bf16x2_t){vb[6], vb[7]}, acc, false);
    return acc;
}
__device__ __forceinline__ float blo(unsigned w) { return __uint_as_float(w << 16); }
__device__ __forceinline__ float bhi(unsigned w) { return __uint_as_float(w & 0xffff0000u); }

struct PeerArgs {
    const bf16_t* PQ;
    const bf16_t* SK;
    const bf16_t* H2;
    const unsigned char* U; const unsigned char* V;
    const float* US; const float* VS;
    int* eidx; float* egate2; float* wts;
    const bf16_t* xin; float* xout;
    const float* mod;
    const float* fg;
};

__device__ __forceinline__ void route16(const PeerArgs& A, lds_ptr lds, int tok0, int wid, int lane) {
    const int g = lane >> 4, i16 = lane & 15;
    const lds_ptr wv = lds + LDS_WV + wid * 4096;
    const bf16_t* qrow = A.PQ + (size_t)(tok0 + i16) * 2048;
    bf16x8 qn[4];
#pragma unroll
    for (int ks = 0; ks < 4; ++ks) qn[ks] = *(const bf16x8*)(qrow + 32 * ks + 8 * g);
    for (int h = 0; h < 8; ++h) {
        if (((h ^ (wid >> 2)) & 1) != 0) __builtin_amdgcn_s_setprio(1); else __builtin_amdgcn_s_setprio(0);
        float top[2][16];
#pragma unroll
        for (int half = 0; half < 2; ++half) {
            bf16x8 qf[4];
#pragma unroll
            for (int ks = 0; ks < 4; ++ks) qf[ks] = qn[ks];
            { const int nx = (2 * h + half + 1) & 15;
#pragma unroll
              for (int ks = 0; ks < 4; ++ks) qn[ks] = *(const bf16x8*)(qrow + nx * 128 + 32 * ks + 8 * g); }
            float v[32];
#pragma unroll
            for (int kb = 0; kb < 8; ++kb) {
                f32x4 s = {0.f, 0.f, 0.f, 0.f};
#pragma unroll
                for (int ks = 0; ks < 4; ++ks) {
                    const int row = 16 * kb + i16, c = 4 * ks + g;
                    const bf16x8 a = *(const __attribute__((address_space(3))) bf16x8*)(lds + LDS_SK + half * 32768 + row * 256 + 16 * (c ^ i16));
                    s = __builtin_amdgcn_mfma_f32_16x16x32_bf16(a, qf[ks], s, 0, 0, 0);
                }
#pragma unroll
                for (int r = 0; r < 4; ++r) v[4 * kb + r] = __uint_as_float((__float_as_uint(s[r]) & ~127u) | (unsigned)(16 * kb + 4 * g + r));
            }
            float a16[16], b16[16];
#pragma unroll
            for (int i = 0; i < 16; ++i) { a16[i] = v[i]; b16[i] = v[16 + i]; }
            oem_sort16<true>(a16); oem_sort16<false>(b16);
#pragma unroll
            for (int i = 0; i < 16; ++i) a16[i] = fmaxf(a16[i], b16[i]);
            bitonic_merge16_desc(a16);
            xlane_merge16(a16, 16); xlane_merge16(a16, 32);
#pragma unroll
            for (int i = 0; i < 16; ++i) top[half][i] = a16[i];
        }
        if (g == 0) {
#pragma unroll
            for (int i = 0; i < 16; ++i) { *(__attribute__((address_space(3))) float*)(wv + (i16 * 32 + i) * 4) = top[0][i]; *(__attribute__((address_space(3))) float*)(wv + (i16 * 32 + 16 + i) * 4) = top[1][i]; }
        }
        float cs[16];
#pragma unroll
        for (int j = 0; j < 16; ++j) {
            constexpr int A1[16] = {1, 1, 1, 1, 1, 1, 1, 1, 4, 4, 4, 5, 5, 8, 9, 10}, B1[16] = {0, 1, 2, 3, 4, 5, 6, 7, 0, 1, 2, 0, 1, 0, 0, 0};
            constexpr int A2[16] = {2, 2, 2, 2, 2, 3, 3, 3, 3, 6, 6, 7, 7, 11, 12, 13}, B2[16] = {0, 1, 2, 3, 4, 0, 1, 2, 3, 0, 1, 0, 1, 0, 0, 0};
            constexpr int A3[16] = {14, 15, 0, 0, 0, 0, 0, 0, 0, 0, 0, 0, 0, 0, 0, 0};
            const float x1 = g == 0 ? top[0][0] : (g == 1 ? top[0][A1[j]] : (g == 2 ? top[0][A2[j]] : top[0][A3[j]]));
            const float x2 = g == 0 ? top[1][j] : (g == 1 ? top[1][B1[j]] : (g == 2 ? top[1][B2[j]] : top[1][0]));
            float sm = __uint_as_float(__float_as_uint(x1) & ~127u) + __uint_as_float(__float_as_uint(x2) & ~127u);
            if (g == 3 && j >= 2) sm = -3.0e38f;
            cs[j] = __uint_as_float((__float_as_uint(sm) & ~63u) | (unsigned)(g * 16 + j));
        }
        oem_sort16<true>(cs);
        xlane_merge16(cs, 16); xlane_merge16(cs, 32);
        float mxs = __uint_as_float(__float_as_uint(cs[0]) & ~63u);
        float val[4]; int ex[4]; float es = 0.f;
#pragma unroll
        for (int k = 0; k < 4; ++k) {
            const float e = g == 0 ? cs[k] : (g == 1 ? cs[4 + k] : (g == 2 ? cs[8 + k] : cs[12 + k]));
            const unsigned slot = __float_as_uint(e) & 63u;
            const unsigned ab = *(const __attribute__((address_space(3))) unsigned char*)(lds + LDS_TAB + slot);
            const unsigned p1 = __float_as_uint(*(const __attribute__((address_space(3))) float*)(wv + (i16 * 32 + (ab >> 4)) * 4));
            const unsigned p2 = __float_as_uint(*(const __attribute__((address_space(3))) float*)(wv + (i16 * 32 + 16 + (ab & 15)) * 4));
            ex[k] = (int)((p1 & 127u) * 128u + (p2 & 127u));
            val[k] = __builtin_amdgcn_exp2f((__uint_as_float(p1 & ~127u) + __uint_as_float(p2 & ~127u) - mxs) * LOG2E);
            es += val[k];
        }
        es += __shfl_xor(es, 16); es += __shfl_xor(es, 32);
        const float ri = 1.0f / es;
        int* ep = A.eidx + (size_t)(tok0 + i16) * 128 + h * 16 + 4 * g;
        float* gp = A.egate2 + ((size_t)(tok0 + i16) * 128 + h * 16 + 4 * g) * 2;
        *(int4*)ep = make_int4(ex[0], ex[1], ex[2], ex[3]);
        *(float4*)gp = make_float4(A.US[ex[0]], val[0] * ri * A.VS[ex[0]], A.US[ex[1]], val[1] * ri * A.VS[ex[1]]);
        *(float4*)(gp + 4) = make_float4(A.US[ex[2]], val[2] * ri * A.VS[ex[2]], A.US[ex[3]], val[3] * ri * A.VS[ex[3]]);
    }
    __builtin_amdgcn_s_setprio(0);
}

typedef float f32x2 __attribute__((ext_vector_type(2)));
__device__ __forceinline__ float row16_sum(float x) {
    x += __builtin_bit_cast(float, __builtin_amdgcn_update_dpp(0, __builtin_bit_cast(int, x), 0xB1, 0xF, 0xF, true));
    x += __builtin_bit_cast(float, __builtin_amdgcn_update_dpp(0, __builtin_bit_cast(int, x), 0x4E, 0xF, 0xF, true));
    x += __builtin_bit_cast(float, __builtin_amdgcn_update_dpp(0, __builtin_bit_cast(int, x), 0x141, 0xF, 0xF, true));
    x += __builtin_bit_cast(float, __builtin_amdgcn_update_dpp(0, __builtin_bit_cast(int, x), 0x140, 0xF, 0xF, true));
    return x;
}
__device__ __forceinline__ f32x2 dot16_fp8(u32x4 w, const f32x2 (&h)[8], f32x2 acc) {
    acc += __builtin_amdgcn_cvt_pk_f32_fp8(w.x, false) * h[0]; acc += __builtin_amdgcn_cvt_pk_f32_fp8(w.x, true) * h[1];
    acc += __builtin_amdgcn_cvt_pk_f32_fp8(w.y, false) * h[2]; acc += __builtin_amdgcn_cvt_pk_f32_fp8(w.y, true) * h[3];
    acc += __builtin_amdgcn_cvt_pk_f32_fp8(w.z, false) * h[4]; acc += __builtin_amdgcn_cvt_pk_f32_fp8(w.z, true) * h[5];
    acc += __builtin_amdgcn_cvt_pk_f32_fp8(w.w, false) * h[6]; acc += __builtin_amdgcn_cvt_pk_f32_fp8(w.w, true) * h[7];
    return acc;
}
__device__ __forceinline__ void axpy16_fp8(u32x4 v, float wt, f32x2 (&acc)[8]) {
    const f32x2 w2 = {wt, wt};
    acc[0] += w2 * __builtin_amdgcn_cvt_pk_f32_fp8(v.x, false); acc[1] += w2 * __builtin_amdgcn_cvt_pk_f32_fp8(v.x, true);
    acc[2] += w2 * __builtin_amdgcn_cvt_pk_f32_fp8(v.y, false); acc[3] += w2 * __builtin_amdgcn_cvt_pk_f32_fp8(v.y, true);
    acc[4] += w2 * __builtin_amdgcn_cvt_pk_f32_fp8(v.z, false); acc[5] += w2 * __builtin_amdgcn_cvt_pk_f32_fp8(v.z, true);
    acc[6] += w2 * __builtin_amdgcn_cvt_pk_f32_fp8(v.w, false); acc[7] += w2 * __builtin_amdgcn_cvt_pk_f32_fp8(v.w, true);
}
typedef unsigned v6u __attribute__((ext_vector_type(6)));
typedef float v32f __attribute__((ext_vector_type(32)));
typedef __bf16 v32bf __attribute__((ext_vector_type(32)));
typedef unsigned u32x2 __attribute__((ext_vector_type(2)));
__device__ __forceinline__ float dot32_bf16(v32bf c, u32x4 h0, u32x4 h1, u32x4 h2, u32x4 h3, float acc) {
    typedef __bf16 bf16x8_t __attribute__((ext_vector_type(8)));
    const bf16x8_t a0 = __builtin_bit_cast(bf16x8_t, h0), a1 = __builtin_bit_cast(bf16x8_t, h1), a2 = __builtin_bit_cast(bf16x8_t, h2), a3 = __builtin_bit_cast(bf16x8_t, h3);
#pragma unroll
    for (int i = 0; i < 4; ++i) {
        acc = __builtin_amdgcn_fdot2_f32_bf16((bf16x2_t){c[2 * i], c[2 * i + 1]}, (bf16x2_t){a0[2 * i], a0[2 * i + 1]}, acc, false);
        acc = __builtin_amdgcn_fdot2_f32_bf16((bf16x2_t){c[8 + 2 * i], c[8 + 2 * i + 1]}, (bf16x2_t){a1[2 * i], a1[2 * i + 1]}, acc, false);
        acc = __builtin_amdgcn_fdot2_f32_bf16((bf16x2_t){c[16 + 2 * i], c[16 + 2 * i + 1]}, (bf16x2_t){a2[2 * i], a2[2 * i + 1]}, acc, false);
        acc = __builtin_amdgcn_fdot2_f32_bf16((bf16x2_t){c[24 + 2 * i], c[24 + 2 * i + 1]}, (bf16x2_t){a3[2 * i], a3[2 * i + 1]}, acc, false);
    }
    return acc;
}
__device__ __forceinline__ float udot64(u32x4 p0, u32x4 p1, u32x4 p2, const u32x4 (&hp)[8]) {
    const v6u ga = {p0.x, p0.y, p0.z, p0.w, p1.x, p1.y}, gb = {p1.z, p1.w, p2.x, p2.y, p2.z, p2.w};
    const v32bf ca = __builtin_amdgcn_cvt_scalef32_pk32_bf16_fp6(ga, 1.0f), cb = __builtin_amdgcn_cvt_scalef32_pk32_bf16_fp6(gb, 1.0f);
    float d = dot32_bf16(ca, hp[0], hp[1], hp[2], hp[3], 0.f);
    return dot32_bf16(cb, hp[4], hp[5], hp[6], hp[7], d);
}
__device__ __forceinline__ void upass_token(const PeerArgs& A, int tok, int lane) {
    const int e4 = lane >> 4, l16 = lane & 15;
    u32x4 hp[8];
#pragma unroll
    for (int k = 0; k < 8; ++k) hp[k] = *(const u32x4*)(A.H2 + (size_t)tok * 1024 + 64 * l16 + 8 * k);
    const int2* ei = (const int2*)(A.eidx + (size_t)tok * 128 + e4 * 32); const f32x4* eg = (const f32x4*)(A.egate2 + ((size_t)tok * 128 + e4 * 32) * 2); float* wo = A.wts + (size_t)tok * 128 + e4 * 32;
    const unsigned char* ub = A.U + l16 * 16;
    int2 id[5]; u32x4 buf[3][6]; f32x4 gs[3];
#define U_IDS(st) do { id[(st) % 5] = ei[(st)]; } while (0)
#define U_GATHER(st) do { const unsigned char* pa = ub + (size_t)id[(st) % 5].x * 768; const unsigned char* pb = ub + (size_t)id[(st) % 5].y * 768; \
        buf[(st) % 3][0] = *(const u32x4*)pa; buf[(st) % 3][1] = *(const u32x4*)(pa + 256); buf[(st) % 3][2] = *(const u32x4*)(pa + 512); \
        buf[(st) % 3][3] = *(const u32x4*)pb; buf[(st) % 3][4] = *(const u32x4*)(pb + 256); buf[(st) % 3][5] = *(const u32x4*)(pb + 512); gs[(st) % 3] = eg[(st)]; } while (0)
    U_IDS(0); U_IDS(1); U_IDS(2); U_IDS(3);
    U_GATHER(0); U_GATHER(1);
#pragma unroll
    for (int st = 0; st < 16; ++st) {
        if (st + 4 < 16) U_IDS(st + 4);
        if (st + 2 < 16) U_GATHER(st + 2);
        const f32x4 g = gs[st % 3];
        const float ta = row16_sum(udot64(buf[st % 3][0], buf[st % 3][1], buf[st % 3][2], hp)) * g[0];
        const float tb = row16_sum(udot64(buf[st % 3][3], buf[st % 3][4], buf[st % 3][5], hp)) * g[2];
        if (l16 == 0) *(f32x2*)(wo + 2 * st) = (f32x2){gelu_erf(ta) * g[1], gelu_erf(tb) * g[3]};
    }
#undef U_IDS
#undef U_GATHER
}
__device__ __forceinline__ int grab(lds_ptr cnt, int lane) {
    int t = 0;
    if (lane == 0) t = __hip_atomic_fetch_add((__attribute__((address_space(3))) int*)cnt, 1, __ATOMIC_RELAXED, __HIP_MEMORY_SCOPE_WORKGROUP);
    return __builtin_amdgcn_readfirstlane(t);
}
template <bool DYN> __device__ __forceinline__ void vpass_wave(const PeerArgs& A, int tok0, int tstride, int ntok, int lane, lds_ptr cnt = nullptr) {
    const int hw = lane >> 5, l32 = lane & 31;
    const unsigned char* vb = A.V + l32 * 16; const unsigned char* vc = A.V + 512 + l32 * 8;
    int4 id[4]; f32x4 wg[4]; u32x4 p0[4][4]; u32x2 p1[4][4];
#define V_EI(t) ((const int4*)(A.eidx + (size_t)(t) * 128 + hw * 64))
#define V_WI(t) ((const f32x4*)(A.wts + (size_t)(t) * 128 + hw * 64))
#define V_IDS(t, gr) do { id[(gr) % 4] = V_EI(t)[(gr) % 16]; wg[(gr) % 4] = V_WI(t)[(gr) % 16]; } while (0)
#define V_GATHER(gr) do { const int4 t_ = id[(gr) % 4]; \
        p0[(gr) % 4][0] = *(const u32x4*)(vb + (size_t)t_.x * 768); p1[(gr) % 4][0] = *(const u32x2*)(vc + (size_t)t_.x * 768); \
        p0[(gr) % 4][1] = *(const u32x4*)(vb + (size_t)t_.y * 768); p1[(gr) % 4][1] = *(const u32x2*)(vc + (size_t)t_.y * 768); \
        p0[(gr) % 4][2] = *(const u32x4*)(vb + (size_t)t_.z * 768); p1[(gr) % 4][2] = *(const u32x2*)(vc + (size_t)t_.z * 768); \
        p0[(gr) % 4][3] = *(const u32x4*)(vb + (size_t)t_.w * 768); p1[(gr) % 4][3] = *(const u32x2*)(vc + (size_t)t_.w * 768); } while (0)
    int cur = 0, nxt = 1;
    if (DYN) { cur = grab(cnt, lane); if (cur >= ntok) return; nxt = grab(cnt, lane); tok0 += cur; }
    V_IDS(tok0, 0); V_IDS(tok0, 1); V_IDS(tok0, 2);
    V_GATHER(0); V_GATHER(1);
    int tokd = tok0;
    for (int t = 0; DYN || t < ntok; ++t) {
        const int tok = DYN ? tokd : tok0 + t * tstride, tokn = DYN ? (nxt < ntok ? tok - cur + nxt : tok) : ((t + 1 < ntok) ? tok + tstride : tok);
        v32f acc;
#pragma unroll
        for (int i = 0; i < 32; ++i) acc[i] = 0.f;
#pragma unroll
        for (int gr = 0; gr < 16; ++gr) {
            V_GATHER(gr + 2);
            const f32x4 w = wg[gr % 4];
            if (gr + 3 < 16) V_IDS(tok, gr + 3); else V_IDS(tokn, gr + 3);
#pragma unroll
            for (int k = 0; k < 4; ++k) {
                const v6u g = {p0[gr % 4][k].x, p0[gr % 4][k].y, p0[gr % 4][k].z, p0[gr % 4][k].w, p1[gr % 4][k].x, p1[gr % 4][k].y};
                const v32f c = __builtin_amdgcn_cvt_scalef32_pk32_f32_fp6(g, 1.0f);
                acc += c * w[k];
            }
        }
#pragma unroll
        for (int i = 0; i < 32; ++i) acc[i] += __shfl_xor(acc[i], 32);
        float f[16];
#pragma unroll
        for (int i = 0; i < 16; ++i) f[i] = hw ? acc[16 + i] : acc[i];
        const int b = tok >> 13, col = 32 * l32 + 16 * hw;
        const bf16_t* xr = A.xin + (size_t)tok * 1024 + col; float* xo = A.xout + (size_t)tok * 1024 + col; const float* g2 = A.mod + b * 6144 + 5120 + col; const float* fgp = A.fg + col;
        float y[16]; float ss = 0.f;
        { const u32x4 xa = *(const u32x4*)xr, xb = *(const u32x4*)(xr + 8);
          y[0] = blo(xa.x); y[1] = bhi(xa.x); y[2] = blo(xa.y); y[3] = bhi(xa.y); y[4] = blo(xa.z); y[5] = bhi(xa.z); y[6] = blo(xa.w); y[7] = bhi(xa.w);
          y[8] = blo(xb.x); y[9] = bhi(xb.x); y[10] = blo(xb.y); y[11] = bhi(xb.y); y[12] = blo(xb.z); y[13] = bhi(xb.z); y[14] = blo(xb.w); y[15] = bhi(xb.w); }
#pragma unroll
        for (int q = 0; q < 4; ++q) {
            const f32x4 gv = *(const f32x4*)(g2 + 4 * q);
#pragma unroll
            for (int i = 0; i < 4; ++i) { y[4 * q + i] = y[4 * q + i] + gv[i] * f[4 * q + i]; ss += y[4 * q + i] * y[4 * q + i]; }
        }
#pragma unroll
        for (int o = 1; o < 64; o <<= 1) ss += __shfl_xor(ss, o);
        const float rinv = 1.0f / sqrtf(ss * (1.0f / 1024.0f) + 1e-6f);
#pragma unroll
        for (int q = 0; q < 4; ++q) {
            const f32x4 fv = *(const f32x4*)(fgp + 4 * q); f32x4 o;
#pragma unroll
            for (int i = 0; i < 4; ++i) o[i] = y[4 * q + i] * rinv * fv[i];
            *(f32x4*)(xo + 4 * q) = o;
        }
        if (DYN) { if (nxt >= ntok) break; tokd = tokn; cur = nxt; nxt = grab(cnt, lane); }
    }
#undef V_EI
#undef V_WI
#undef V_IDS
#undef V_GATHER
}

__device__ __forceinline__ void peer_phase(lds_ptr lds, const PeerArgs& A, int vcu, int G, int wid) {
    const int lane = (int)__builtin_amdgcn_mbcnt_hi(~0u, __builtin_amdgcn_mbcnt_lo(~0u, 0u)), tid = wid * 64 + lane;
    for (int n = tid; n < 2 * 128 * 16; n += 512) {
        const int tb = n >> 11, row = (n >> 4) & 127, c = n & 15;
        *(__attribute__((address_space(3))) u32x4*)(lds + LDS_SK + tb * 32768 + row * 256 + 16 * (c ^ (row & 15))) = *(const u32x4*)(A.SK + (size_t)tb * 16384 + row * 128 + c * 8);
    }
    if (tid < 64) {
        const unsigned long long A1 = 0xA985544411111111ull, B1 = 0x0001021076543210ull, A2 = 0xDCB7766333322222ull, B2 = 0x0001010321043210ull;
        const int gq = tid >> 4, j = tid & 15; int a = 0, b = 0;
        if (gq == 0) { a = 0; b = j; } else if (gq == 1) { a = (int)((A1 >> (4 * j)) & 15); b = (int)((B1 >> (4 * j)) & 15); } else if (gq == 2) { a = (int)((A2 >> (4 * j)) & 15); b = (int)((B2 >> (4 * j)) & 15); } else { a = j == 0 ? 14 : 15; b = 0; }
        *(__attribute__((address_space(3))) unsigned char*)(lds + LDS_TAB + tid) = (unsigned char)((a << 4) | b);
    }
    __syncthreads();
    const lds_ptr cU = lds + 160 * 1024 - 256 + 24 * 4, cV = cU + 4;
    for (int task_ = vcu; task_ < 256; task_ += G) {
        const int task = __builtin_amdgcn_readfirstlane(task_);
        if (tid == 0) { *(__attribute__((address_space(3))) int*)cU = 0; *(__attribute__((address_space(3))) int*)cV = 0; }
        const int tok0 = task * 128 + wid * 16;
        { int ln_ = lane; asm volatile("" : "+v"(ln_)); route16(A, lds, tok0, wid, ln_); }
        int lane2 = lane;
        asm volatile("s_waitcnt vmcnt(0) lgkmcnt(0)" : "+v"(lane2) :: "memory");
        __syncthreads();
        for (int t = grab(cU, lane2); t < 128; t = grab(cU, lane2)) upass_token(A, task * 128 + t, lane2);
        asm volatile("s_waitcnt vmcnt(0)" ::: "memory");
        __syncthreads();
        vpass_wave<true>(A, task * 128, 1, 128, lane2, cV);
        __syncthreads();
    }
}
__device__ __forceinline__ void peer_vphase_local(const PeerArgs& A, int vcu, int G) {
    const int lane = threadIdx.x & 63, wid = __builtin_amdgcn_readfirstlane(threadIdx.x >> 6);
    asm volatile("s_waitcnt vmcnt(0)" ::: "memory");
    for (int task = vcu; task < 256; task += G) vpass_wave<false>(A, task * 128 + wid * 16, 1, 16, lane);
}
__device__ __forceinline__ void peer_vphase(const PeerArgs& A, int vcu, int G) {
    const int lane = threadIdx.x & 63, wid = __builtin_amdgcn_readfirstlane(threadIdx.x >> 6);
    { const int w0 = vcu * 8 + wid, nw = G * 8; if (w0 < 32768) vpass_wave<false>(A, w0, nw, (32768 - w0 + nw - 1) / nw, lane); }
}
#undef PEER_CE
}

constexpr int NWAVES = 8;
#ifndef MK_N_LAUNCHES
#define MK_N_LAUNCHES 1
#endif
constexpr int PER_PHASE = 10;
constexpr int N_LAUNCHES = MK_N_LAUNCHES;

constexpr int BATCH = 4, T = 8192, D = 1024, M = BATCH * T, NIN = 2304, NPQ = 2048, NEXP = 16384;
constexpr float EPS = 1e-6f;
constexpr float C2 = 0.125f * 1.4426950408889634f;

constexpr size_t MiB = 1u << 20;
constexpr size_t WS_CTL = 0, CTL_ZERO_BYTES = 1 * MiB;
constexpr size_t WS_TAB = 1 * MiB;
constexpr size_t WS_WIN = 2 * MiB, WS_WOUT = 8 * MiB, WS_WQ = 10 * MiB, WS_SK = 14 * MiB;
constexpr size_t WS_U = 16 * MiB, WS_V = 32 * MiB;
constexpr size_t WS_US = 48 * MiB, WS_VS = 49 * MiB, WS_XS = 50 * MiB  ;
constexpr size_t WS_H = 80 * MiB;
constexpr size_t WS_P = 144 * MiB;
constexpr size_t WS_O = 288 * MiB;
constexpr size_t WS_EI = 352 * MiB, WS_EG = 368 * MiB  , WS_EW = 400 * MiB, WS_SSA = 416 * MiB, WS_SSB = 417 * MiB, WS_X1 = 420 * MiB, WS_END = 484 * MiB;
constexpr size_t WS_Q8 = 420 * MiB, WS_K8 = 436 * MiB, WS_V8T = 440 * MiB;
constexpr int CW_BAR = 4096;
constexpr int CW_PCNT = 8192;
constexpr int CW_MOD = 131072;

constexpr int LDS_BYTES = 160 * 1024;
constexpr int MISC_OFF = LDS_BYTES - 256;

#define GAS __attribute__((address_space(1)))
#define LAS __attribute__((address_space(3)))
typedef unsigned short bf16;
typedef unsigned v4u __attribute__((ext_vector_type(4)));
typedef float f32x4 __attribute__((ext_vector_type(4)));
typedef GAS unsigned gu32;
#define RLX_AGENT __ATOMIC_RELAXED, __HIP_MEMORY_SCOPE_AGENT
#define LDS_WAIT() asm volatile("s_waitcnt lgkmcnt(0)" ::: "memory")
__device__ __forceinline__ unsigned f2bf(float f) { unsigned u = __builtin_bit_cast(unsigned, f); return (u + 0x7fffu + ((u >> 16) & 1u)) >> 16; }
__device__ __forceinline__ unsigned pk2(float lo, float hi) { return f2bf(lo) | (f2bf(hi) << 16); }

#define XB_TMO      128
#define XB_XCNT(j)  (256  + 64 * (j))
#define XB_XSUB(j)  (1280 + 64 * (j))
#define XB_XGEN(j)  (2304 + 64 * (j))
#define XB_TOP      3328
#define XB_TOPGEN   3392
#define XCD_BAR_WORDS 3456
#define XB_SPIN_CAP (1u << 20)

__device__ __forceinline__ unsigned xb_ld(unsigned* p)              { return __hip_atomic_load(p, __ATOMIC_RELAXED, __HIP_MEMORY_SCOPE_AGENT); }
__device__ __forceinline__ unsigned xb_add(unsigned* p, unsigned v) { return __hip_atomic_fetch_add(p, v, __ATOMIC_RELAXED, __HIP_MEMORY_SCOPE_AGENT); }
__device__ __forceinline__ unsigned xb_xcc_id() { return (unsigned)__builtin_amdgcn_s_getreg((3 << 11) | 20) & 0xFu; }
#define XB_SPIN(cond, bar) do { unsigned _sp = 0; while (cond) { __builtin_amdgcn_s_sleep(1); \
    if ((++_sp & 255u) == 0u) { if (xb_ld(&(bar)[XB_TMO])) break; if (_sp > XB_SPIN_CAP) { atomicAdd(&(bar)[XB_TMO], 1u); break; } } } } while (0)

struct XcdBarrier { unsigned* bar; unsigned x; volatile LAS unsigned* st; };

__device__ __forceinline__ XcdBarrier xcd_barrier_post(unsigned* bar, volatile LAS unsigned* st) {
    XcdBarrier b; b.bar = bar; b.x = xb_xcc_id(); b.st = st;
    if (threadIdx.x == 0) (void)xb_add(&bar[XB_XCNT(b.x)], 1u);
    return b;
}
__device__ __forceinline__ void xcd_barrier_complete(unsigned* bar, unsigned x, unsigned& nloc, unsigned& nx) {
    const unsigned G = gridDim.x * gridDim.y * gridDim.z;
    unsigned sum, cnt, mine, sp = 0u;
    for (;;) {
        sum = 0u; cnt = 0u; mine = 0u;
#pragma unroll
        for (unsigned j = 0; j < 16; ++j) { const unsigned c = xb_ld(&bar[XB_XCNT(j)]); sum += c; cnt += (c > 0u) ? 1u : 0u; mine = (j == x) ? c : mine; }
        if (sum == G) break;
        __builtin_amdgcn_s_sleep(1);
        if ((++sp & 255u) == 0u) { if (xb_ld(&bar[XB_TMO])) break; if (sp > XB_SPIN_CAP) { atomicAdd(&bar[XB_TMO], 1u); break; } }
    }
    nloc = mine > 0u ? mine : 1u; nx = cnt > 0u ? cnt : 1u;
}
__device__ __forceinline__ void xcd_barrier(const XcdBarrier& b) {
    asm volatile("s_waitcnt vmcnt(0)" ::: "memory");
    __syncthreads();
    if (threadIdx.x == 0) {
        unsigned* bar = b.bar;
        __builtin_amdgcn_s_waitcnt(0);
        unsigned nloc = b.st[0], nx = b.st[1];
        if (nloc == 0u) { xcd_barrier_complete(bar, b.x, nloc, nx); b.st[0] = nloc; b.st[1] = nx; }
        const unsigned old = xb_add(&bar[XB_XSUB(b.x)], 1u);
        const unsigned gen = old / nloc;
        if (old + 1u == (gen + 1u) * nloc) {
            __builtin_amdgcn_fence(__ATOMIC_RELEASE, "agent");
            asm volatile("s_waitcnt vmcnt(0)" ::: "memory");
            const unsigned og = xb_add(&bar[XB_TOP], 1u);
            const unsigned tg = og / nx;
            if (og + 1u == (tg + 1u) * nx) xb_add(&bar[XB_TOPGEN], 1u);
            else XB_SPIN(xb_ld(&bar[XB_TOPGEN]) == tg, bar);
            __builtin_amdgcn_fence(__ATOMIC_ACQUIRE, "agent");
            xb_add(&bar[XB_XGEN(b.x)], 1u);
            asm volatile("s_waitcnt vmcnt(0)" ::: "memory");
        } else {
            XB_SPIN(xb_ld(&bar[XB_XGEN(b.x)]) == gen, bar);
            __builtin_amdgcn_fence(__ATOMIC_ACQUIRE, "agent");
            asm volatile("s_waitcnt vmcnt(0)" ::: "memory");
        }
    }
    __syncthreads();
}

__device__ __forceinline__ float wave_sum(float v) {
#pragma unroll
    for (int o = 1; o < 64; o <<= 1) v += __shfl_xor(v, o);
    return v;
}
template <bool PERMUTE> __device__ __forceinline__ void p0_transpose_item(const float* W, int K, int N, bf16* WT, LAS float* scr, int item, int lane, const float* ks0 = nullptr, const float* ks1 = nullptr) {
    const int nblk = N / 32, kb = item / nblk, nb = item % nblk, k0 = 64 * kb, n0 = 32 * nb;
    int r0 = n0;
    if (PERMUTE) { const int tile = nb >> 3, ob = nb & 7, wc = ob >> 1, bj = ob & 1; r0 = tile * 256 + 32 * (4 * bj + wc); }
#pragma unroll 8
    for (int i = 0; i < 32; ++i) { const int kk = 2 * i + (lane >> 5); const int kg = k0 + kk; const float sc = ks0 ? (kg < 512 ? ks0[kg] : ks1[kg - 512]) : 1.0f; scr[kk * 33 + (lane & 31)] = W[(size_t)kg * N + n0 + (lane & 31)] * sc; }
    LDS_WAIT(); asm volatile("" ::: "memory");
    const int c = lane & 7;
#pragma unroll
    for (int j = 0; j < 4; ++j) { const int n = (lane >> 3) + 8 * j; const LAS float* s = scr + (8 * c) * 33 + n;
        v4u o; o.x = pk2(s[0 * 33], s[1 * 33]); o.y = pk2(s[2 * 33], s[3 * 33]); o.z = pk2(s[4 * 33], s[5 * 33]); o.w = pk2(s[6 * 33], s[7 * 33]);
        *(GAS v4u*)(WT + (size_t)(r0 + n) * K + k0 + 8 * c) = o; }
    LDS_WAIT(); asm volatile("" ::: "memory");
}
__device__ __forceinline__ void sincos_d(double a, double& s, double& c) {
    const double TWO_PI = 6.283185307179586476925286766559, INV = 0.15915494309189533576888376337251;
    const double k = __builtin_rint(a * INV); const double x = a - k * TWO_PI; const double x2 = x * x;
    double ts = x, tc = 1.0, ss = x, cc = 1.0;
#pragma unroll
    for (int n = 1; n <= 16; ++n) { tc = -tc * x2 / (double)((2 * n - 1) * (2 * n)); ts = -ts * x2 / (double)((2 * n) * (2 * n + 1)); cc += tc; ss += ts; }
    s = ss; c = cc;
}
__device__ __forceinline__ float silu_f(float v) { return v / (1.0f + __expf(-v)); }

struct Ptrs {
    const float *x, *c, *w_ada, *b_ada, *n1g, *w_in, *qng, *kng, *rpb, *gag, *gbg, *w_out, *n2g, *wq, *sk1, *sk2, *pu, *pv, *fng;
    float* out; unsigned char* ws;
};

template <int PART> __device__ __forceinline__ void p0_prologue(const Ptrs& A, LAS unsigned char* lds, int vcu, int G, int wave, int lane, int gw, int NGW) {
    LAS float* scr = (LAS float*)(lds + wave * 16384);
    bf16* Win_t = (bf16*)(A.ws + WS_WIN); bf16* Wout_t = (bf16*)(A.ws + WS_WOUT); bf16* Wq_t = (bf16*)(A.ws + WS_WQ);
    constexpr int I_IN = (D / 64) * (NIN / 32), I_OUT = (D / 64) * (D / 32), I_Q = (D / 64) * (NPQ / 32);
    if (PART == 0) { for (int it = gw; it < I_IN; it += NGW) p0_transpose_item<true>(A.w_in, D, NIN, Win_t, scr, it, lane); }
    else if (PART == 1) { for (int it = gw; it < I_Q; it += NGW) p0_transpose_item<false>(A.wq, D, NPQ, Wq_t, scr, it, lane); }
    else { for (int it = gw; it < I_OUT; it += NGW) p0_transpose_item<false>(A.w_out, D, D, Wout_t, scr, it, lane, A.gag, A.gbg); return; }
    if (PART == 1) {
        typedef float v16f __attribute__((ext_vector_type(16))); typedef unsigned v6u __attribute__((ext_vector_type(6)));
        unsigned char* U6 = A.ws + WS_U; unsigned char* V6 = A.ws + WS_V; float* USc = (float*)(A.ws + WS_US); float* VSc = (float*)(A.ws + WS_VS);
        const int hw = lane >> 5, l32 = lane & 31;
        for (int it = gw; it < NEXP; it += NGW) {
            const int r = 2 * it + hw; const bool isv = r >= NEXP; const int row = isv ? r - NEXP : r;
            const float* src = (isv ? A.pv : A.pu) + (size_t)row * D + l32 * 32;
            f32x4 v[8]; float mx = 0.f;
#pragma unroll
            for (int j = 0; j < 8; ++j) { v[j] = *(const GAS f32x4*)(src + 4 * j); mx = fmaxf(mx, fmaxf(fmaxf(fabsf(v[j][0]), fabsf(v[j][1])), fmaxf(fabsf(v[j][2]), fabsf(v[j][3])))); }
#pragma unroll
            for (int o = 1; o < 32; o <<= 1) mx = fmaxf(mx, __shfl_xor(mx, o));
            const float sc = mx > 0.f ? __uint_as_float(__float_as_uint(7.5f / mx) & 0x7f800000u) : 1.0f;
            v16f a, b;
#pragma unroll
            for (int j = 0; j < 4; ++j)
#pragma unroll
                for (int i = 0; i < 4; ++i) { a[4 * j + i] = v[2 * j + (i >> 1)][2 * (i & 1)] * sc; b[4 * j + i] = v[2 * j + (i >> 1)][2 * (i & 1) + 1] * sc; }
            const v6u q = __builtin_amdgcn_cvt_scalef32_2xpk16_fp6_f32(a, b, 1.0f);
            if (isv) {
                unsigned char* dst = V6 + (size_t)row * 768;
                *(GAS v4u*)(dst + 16 * l32) = (v4u){q[0], q[1], q[2], q[3]};
                *(GAS unsigned long long*)(dst + 512 + 8 * l32) = (unsigned long long)q[4] | ((unsigned long long)q[5] << 32);
            } else {
                unsigned char* dst = U6 + (size_t)row * 768 + 16 * (l32 >> 1);
                if ((l32 & 1) == 0) { *(GAS v4u*)dst = (v4u){q[0], q[1], q[2], q[3]}; *(GAS unsigned long long*)(dst + 256) = (unsigned long long)q[4] | ((unsigned long long)q[5] << 32); }
                else { *(GAS unsigned long long*)(dst + 256 + 8) = (unsigned long long)q[0] | ((unsigned long long)q[1] << 32); *(GAS v4u*)(dst + 512) = (v4u){q[2], q[3], q[4], q[5]}; }
            }
            if (l32 == 0) (isv ? VSc : USc)[row] = 1.0f / sc;
        }
        bf16* SKb = (bf16*)(A.ws + WS_SK);
        for (int it = gw; it < 64; it += NGW) {
            const float* src = it < 32 ? A.sk1 : A.sk2; const int r = it & 31;
            const size_t e = (size_t)r * 512 + lane * 8;
            const f32x4 a = *(const GAS f32x4*)(src + e), b = *(const GAS f32x4*)(src + e + 4);
            v4u o; o.x = pk2(a[0], a[1]); o.y = pk2(a[2], a[3]); o.z = pk2(b[0], b[1]); o.w = pk2(b[2], b[3]);
            *(GAS v4u*)(SKb + (it < 32 ? 0 : 16384) + e) = o;
        }
    }
    if (PART == 0) {
        float* rc = (float*)(A.ws + WS_TAB); float* rs = rc + 128 * 16;
        const int gt = gw * 64 + lane;
        if (gt < 128 * 16) {
            const int pos = gt >> 4, i = gt & 15;
            const double f4[4] = {1.0, 0.56234132519034908039495103977648, 0.31622776601683793319988935444327, 0.17782794100389228012254211951927};
            double fr = (i & 3) == 0 ? f4[0] : ((i & 3) == 1 ? f4[1] : ((i & 3) == 2 ? f4[2] : f4[3]));
            fr *= (i >> 2) == 0 ? 1.0 : ((i >> 2) == 1 ? 0.1 : ((i >> 2) == 2 ? 0.01 : 0.001));
            double s, c; sincos_d((double)pos * fr, s, c);
            rc[gt] = (float)c; rs[gt] = (float)s;
        }
    }
    if (PART == 0) {
        float* mod = (float*)(A.ws + WS_CTL) + CW_MOD;
        LAS float* part = (LAS float*)(lds + 131072);
        LAS float* sc_l = (LAS float*)(lds + 131072 + 8192);
        if (vcu < 96) { for (int i = threadIdx.x; i < 4096; i += 512) sc_l[i] = silu_f(A.c[i]); __syncthreads(); }
        for (int it = vcu; it < 96; it += G) {
            const int col = it * 64 + lane;
            float acc[4] = {0.f, 0.f, 0.f, 0.f};
#pragma unroll 16
            for (int k = 0; k < 128; ++k) {
                const int kk = wave * 128 + k;
                const float w = A.w_ada[(size_t)kk * 6144 + col];
#pragma unroll
                for (int b = 0; b < 4; ++b) acc[b] += w * sc_l[b * 1024 + kk];
            }
#pragma unroll
            for (int b = 0; b < 4; ++b) part[(wave * 4 + b) * 64 + lane] = acc[b];
            __syncthreads();
            if (wave < 4) {
                float s = A.b_ada[col];
#pragma unroll
                for (int w8 = 0; w8 < 8; ++w8) s += part[(w8 * 4 + wave) * 64 + lane];
                mod[wave * 6144 + col] = s;
            }
            __syncthreads();
        }
    }
}
__device__ __forceinline__ void modnorm_row(const float* xrow, const float* g, const float* shift, const float* scale, bf16* orow, int lane) {
    const GAS f32x4* xr = (const GAS f32x4*)xrow + lane;
    f32x4 v[4]; float s = 0.f;
#pragma unroll
    for (int j = 0; j < 4; ++j) { v[j] = xr[64 * j]; s += (v[j].x * v[j].x + v[j].y * v[j].y) + (v[j].z * v[j].z + v[j].w * v[j].w); }
    const float rinv = 1.0f / sqrtf(wave_sum(s) * (1.0f / D) + EPS);
    GAS unsigned long long* o8 = (GAS unsigned long long*)orow + lane;
#pragma unroll
    for (int j = 0; j < 4; ++j) {
        const f32x4 gv = *((const f32x4*)g + lane + 64 * j), sh = *((const f32x4*)shift + lane + 64 * j), sc = *((const f32x4*)scale + lane + 64 * j);
        const f32x4 y = v[j] * rinv * gv * (sc + 1.0f) + sh;
        o8[64 * j] = (unsigned long long)pk2(y.x, y.y) | ((unsigned long long)pk2(y.z, y.w) << 32);
    }
}
__device__ __forceinline__ void modnorm_row_b(const bf16* xrow, const float* g, const float* shift, const float* scale, bf16* orow, int lane) {
    float f[2][8]; float s = 0.f;
#pragma unroll
    for (int j = 0; j < 2; ++j) { const v4u w = *(const GAS v4u*)(xrow + 512 * j + lane * 8);
        f[j][0] = __uint_as_float(w.x << 16); f[j][1] = __uint_as_float(w.x & 0xffff0000u); f[j][2] = __uint_as_float(w.y << 16); f[j][3] = __uint_as_float(w.y & 0xffff0000u);
        f[j][4] = __uint_as_float(w.z << 16); f[j][5] = __uint_as_float(w.z & 0xffff0000u); f[j][6] = __uint_as_float(w.w << 16); f[j][7] = __uint_as_float(w.w & 0xffff0000u);
#pragma unroll
        for (int i = 0; i < 8; ++i) s += f[j][i] * f[j][i]; }
    const float rinv = 1.0f / sqrtf(wave_sum(s) * (1.0f / D) + EPS);
#pragma unroll
    for (int j = 0; j < 2; ++j) { const int c = 512 * j + lane * 8; float y[8];
#pragma unroll
        for (int q = 0; q < 2; ++q) { const f32x4 gv = *(const f32x4*)(g + c + 4 * q), sh = *(const f32x4*)(shift + c + 4 * q), sc = *(const f32x4*)(scale + c + 4 * q);
#pragma unroll
            for (int i = 0; i < 4; ++i) y[4 * q + i] = f[j][4 * q + i] * rinv * gv[i] * (sc[i] + 1.0f) + sh[i]; }
        v4u o; o.x = pk2(y[0], y[1]); o.y = pk2(y[2], y[3]); o.z = pk2(y[4], y[5]); o.w = pk2(y[6], y[7]);
        *(GAS v4u*)(orow + c) = o; }
}
__device__ __forceinline__ void groupnorm_row(const bf16* orow, const float* ga, const float* gb, bf16* mrow, int lane) {
#pragma unroll
    for (int j = 0; j < 2; ++j) {
        const v4u w = *(const GAS v4u*)(orow + 512 * j + lane * 8);
        float f[8]; f[0] = __uint_as_float(w.x << 16); f[1] = __uint_as_float(w.x & 0xffff0000u); f[2] = __uint_as_float(w.y << 16); f[3] = __uint_as_float(w.y & 0xffff0000u);
        f[4] = __uint_as_float(w.z << 16); f[5] = __uint_as_float(w.z & 0xffff0000u); f[6] = __uint_as_float(w.w << 16); f[7] = __uint_as_float(w.w & 0xffff0000u);
        float s = 0.f;
#pragma unroll
        for (int i = 0; i < 8; ++i) s += f[i] * f[i];
        const float rinv = 1.0f / sqrtf(wave_sum(s) * (1.0f / 512.0f) + EPS);
        const float* gp = (j ? gb : ga) + lane * 8;
        const f32x4 g0 = *(const f32x4*)gp, g1 = *(const f32x4*)(gp + 4);
        v4u o; o.x = pk2(f[0] * rinv * g0[0], f[1] * rinv * g0[1]); o.y = pk2(f[2] * rinv * g0[2], f[3] * rinv * g0[3]); o.z = pk2(f[4] * rinv * g1[0], f[5] * rinv * g1[1]); o.w = pk2(f[6] * rinv * g1[2], f[7] * rinv * g1[3]);
        *(GAS v4u*)(mrow + 512 * j + lane * 8) = o;
    }
}

struct Args { Ptrs p; int ph_lo, ph_hi; };
__global__ void __launch_bounds__(NWAVES * 64, 2) hymba_fwd(Args args) {
    extern __shared__ __attribute__((aligned(16))) unsigned char lds_raw[];
    LAS unsigned char* lds = (LAS unsigned char*)lds_raw;
    volatile LAS unsigned* MISC = (volatile LAS unsigned*)(lds + MISC_OFF);
    const Ptrs& A = args.p;
    const int tid = threadIdx.x, lane = tid & 63, wave = __builtin_amdgcn_readfirstlane(tid >> 6);
    const int G = gridDim.x; const int bx = blockIdx.x; const int vcu = (G % 8 == 0) ? (bx % 8) * (G / 8) + bx / 8 : bx;
    gu32* ctl = (gu32*)(A.ws + WS_CTL);
    if (tid < 64) MISC[tid] = 0u;
    __syncthreads();
    XcdBarrier bar; bar.bar = (unsigned*)(ctl + CW_BAR); bar.x = 0; bar.st = nullptr;
    if (N_LAUNCHES != PER_PHASE) bar = xcd_barrier_post((unsigned*)(ctl + CW_BAR), MISC + 8);
#define GRID_BAR() do { if (N_LAUNCHES != PER_PHASE) xcd_barrier(bar); } while (0)
    const int lo = args.ph_lo, hi = args.ph_hi;
#define IN(k) (lo <= (k) && (k) < hi)
#define BOTH(k) (IN(k) && IN((k) + 1))
    const float* mod = (const float*)(A.ws + WS_CTL) + CW_MOD;
    bf16* Hb = (bf16*)(A.ws + WS_H); bf16* Pb = (bf16*)(A.ws + WS_P); bf16* Ob = (bf16*)(A.ws + WS_O);
    const int gw = vcu * NWAVES + wave, NGW = G * NWAVES;

    if (IN(0)) { p0_prologue<0>(A, lds, vcu, G, wave, lane, gw, NGW); if (BOTH(0)) GRID_BAR(); }
    if (IN(1)) {
        for (int m = gw; m < M; m += NGW) { const float* md = mod + (m >> 13) * 6144; modnorm_row(A.x + (size_t)m * D, A.n1g, md, md + 1024, Hb + (size_t)m * D, lane); }
        if (BOTH(1)) GRID_BAR();
    }
    if (IN(2)) {
        pg8::Gemm g{Hb, (const bf16*)(A.ws + WS_WIN), M, NIN, D}; pg8::StaticOrder S; S.init(M, NIN, G, bx);
        { const float* tab = (const float*)(A.ws + WS_TAB); LAS float* tl = (LAS float*)(lds + 131072);
          for (int i = tid; i < 2 * 128 * 16; i += NWAVES * 64) tl[i] = tab[i];
          __syncthreads(); }
        pg8::EpiInProj E{Pb, A.ws + WS_Q8, A.ws + WS_K8, A.ws + WS_V8T, A.qng, A.kng, (const LAS float*)(lds + 131072), (const LAS float*)(lds + 131072) + 128 * 16, C2};
        pg8::gemm_phase<pg8::EpiInProj, pg8::StaticOrder, true, true>(lds, g, S, E);
        {
            const int nunits = (M / 256) * (NIN / 256), rounds = (nunits + G - 1) / G, busy = nunits - (rounds - 1) * G, nidle = G - busy;
            __syncthreads();
            if (nidle == 0) { p0_prologue<1>(A, lds, vcu, G, wave, lane, bx * NWAVES + wave, G * NWAVES); p0_prologue<2>(A, lds, vcu, G, wave, lane, bx * NWAVES + wave, G * NWAVES); }
            else if (bx >= busy) p0_prologue<1>(A, lds, vcu, G, wave, lane, (bx - busy) * NWAVES + wave, nidle * NWAVES);
            else if (wave < 4) p0_prologue<2>(A, lds, vcu, G, wave, lane, bx * 4 + wave, busy * 4);
        }
        if (BOTH(2)) GRID_BAR();
    }
    if (IN(3)) {
        float cb; { const float gq = fabsf(A.qng[lane]), gk = fabsf(A.kng[lane]); float mq = gq, mk = gk;
#pragma unroll
            for (int o = 1; o < 64; o <<= 1) { mq = fmaxf(mq, __shfl_xor(mq, o)); mk = fmaxf(mk, __shfl_xor(mk, o)); }
            cb = 8.0f * 1.4426950408889634f * mq * mk; }
        const attn8::Tensors AT{A.ws + WS_Q8, A.ws + WS_K8, A.ws + WS_V8T, Ob, (float*)(A.ws + WS_SSA)};
        attn8::phase((char*)lds_raw, AT, G, bx, cb - 8.0f);
        __syncthreads();
        natten::natten_phase(lds, Pb + 768, Pb + 1280, Pb + 1792, A.rpb, Ob, (float*)(A.ws + WS_SSB), vcu, G);
        if (BOTH(3)) GRID_BAR();
    }
    if (IN(5)) {
        pg8::Gemm g{Ob, (const bf16*)(A.ws + WS_WOUT), M, D, D}; pg8::StaticOrder S; S.init(M, D, G, bx);
        pg8::EpiX1N E{A.x, (bf16*)(A.ws + WS_X1), Hb, mod, A.n2g, (const float*)(A.ws + WS_SSA), (const float*)(A.ws + WS_SSB), (LAS float*)(lds + 131072), (unsigned*)(A.ws + WS_XS), (unsigned*)(ctl + CW_PCNT)};
        E.prep(S);
        pg8::gemm_phase<pg8::EpiX1N, pg8::StaticOrder, true, true>(lds, g, S, E);
        if (BOTH(5)) GRID_BAR();
    }
    if (IN(7)) {
        pg8::Gemm g{Hb, (const bf16*)(A.ws + WS_WQ), M, NPQ, D}; pg8::StaticOrder S; S.init(M, NPQ, G, bx);
        pg8::EpiBf16 E{Pb, NPQ};
        pg8::gemm_phase<pg8::EpiBf16, pg8::StaticOrder, true, true>(lds, g, S, E);
        if (BOTH(7)) GRID_BAR();
    }
    if (IN(8) || IN(9)) {
        peer::PeerArgs PA{Pb, (const bf16*)(A.ws + WS_SK), Hb, A.ws + WS_U, A.ws + WS_V, (const float*)(A.ws + WS_US), (const float*)(A.ws + WS_VS), (int*)(A.ws + WS_EI), (float*)(A.ws + WS_EG), (float*)(A.ws + WS_EW), (const bf16*)(A.ws + WS_X1), A.out, mod, A.fng};
        if (IN(8)) peer::peer_phase(lds, PA, vcu, G, wave);
    }
#undef IN
#undef BOTH
#undef GRID_BAR
}

extern "C" void kernel_launch(void* const* d_in, const int* in_sizes, int n_in, void* d_out, int out_size, void* d_ws, size_t ws_size, hipStream_t stream) {
    static int grid = 0;
    if (grid == 0) {
        if (n_in != 19 || in_sizes[0] != M * D || out_size != M * D || ws_size < WS_END) { fprintf(stderr, "kernel_launch: unexpected problem shape (n_in %d, in0 %d, out %d, ws %zu); nothing launched\n", n_in, n_in > 0 ? in_sizes[0] : -1, out_size, ws_size); grid = -1; return; }
        int dev = 0, cus = 0, per_cu = 0;
        if (hipGetDevice(&dev) != hipSuccess || hipDeviceGetAttribute(&cus, hipDeviceAttributeMultiprocessorCount, dev) != hipSuccess) { grid = -1; return; }
        if (hipFuncSetAttribute((const void*)hymba_fwd, hipFuncAttributeMaxDynamicSharedMemorySize, LDS_BYTES) != hipSuccess) { fprintf(stderr, "kernel_launch: hipFuncSetAttribute failed\n"); grid = -1; return; }
        if (hipOccupancyMaxActiveBlocksPerMultiprocessor(&per_cu, (const void*)hymba_fwd, NWAVES * 64, LDS_BYTES) != hipSuccess || per_cu < 1) { fprintf(stderr, "kernel_launch: occupancy query reports %d workgroups per CU; nothing launched\n", per_cu); (void)hipGetLastError(); grid = -1; return; }
        grid = cus;
    }
    if (grid < 0) return;
    if (hipMemsetAsync((char*)d_ws + WS_CTL, 0, CTL_ZERO_BYTES, stream) != hipSuccess) { fprintf(stderr, "kernel_launch: hipMemsetAsync failed\n"); return; }
    Args a{};
    a.p.x = (const float*)d_in[0]; a.p.c = (const float*)d_in[1]; a.p.w_ada = (const float*)d_in[2]; a.p.b_ada = (const float*)d_in[3]; a.p.n1g = (const float*)d_in[4];
    a.p.w_in = (const float*)d_in[5]; a.p.qng = (const float*)d_in[6]; a.p.kng = (const float*)d_in[7]; a.p.rpb = (const float*)d_in[8]; a.p.gag = (const float*)d_in[9];
    a.p.gbg = (const float*)d_in[10]; a.p.w_out = (const float*)d_in[11]; a.p.n2g = (const float*)d_in[12]; a.p.wq = (const float*)d_in[13]; a.p.sk1 = (const float*)d_in[14];
    a.p.sk2 = (const float*)d_in[15]; a.p.pu = (const float*)d_in[16]; a.p.pv = (const float*)d_in[17]; a.p.fng = (const float*)d_in[18];
    a.p.out = (float*)d_out; a.p.ws = (unsigned char*)d_ws;
    for (int li = 0; li < N_LAUNCHES; ++li) {
        a.ph_lo = (N_LAUNCHES == PER_PHASE) ? li : 0; a.ph_hi = (N_LAUNCHES == PER_PHASE) ? li + 1 : PER_PHASE;
        hipLaunchKernelGGL(hymba_fwd, dim3(grid), dim3(NWAVES * 64), LDS_BYTES, stream, a);
        const hipError_t le = hipPeekAtLastError();
        if (le != hipSuccess) { fprintf(stderr, "kernel_launch: launch %d failed: %s\n", li, hipGetErrorName(le)); break; }
    }
}
```

```cpp
#include <hip/hip_runtime.h>
#include <hip/hip_bf16.h>
#include <cstdio>
#include <cstdint>
#include <cmath>
namespace pg8 {
#define PG8_LAS __attribute__((address_space(3)))
typedef unsigned short bf16_t;
typedef short bf16x8 __attribute__((ext_vector_type(8)));
typedef float f32x4 __attribute__((ext_vector_type(4)));
typedef unsigned u32x4 __attribute__((ext_vector_type(4)));
typedef unsigned u32x2 __attribute__((ext_vector_type(2)));
constexpr int BM = 256, BK = 64, HALF = 128, HTB = HALF * BK * 2  , STAGE_BYTES = 8 * HTB, NXCD = 8, WGM = 8;

__host__ __device__ __forceinline__ int lds_byte(int r, int c) { const int st = (r >> 4) * 2 + (c >> 5), rr = r & 15, cc = c & 31, ob = rr * 64 + cc * 2; return st * 1024 + (ob ^ (((ob >> 9) & 1) << 5)); }
__host__ __device__ __forceinline__ void stage_rc(int b, int& R, int& C) { const int st = b / 1024, sb = b % 1024, swz = sb ^ (((sb >> 9) & 1) << 5); R = (st >> 1) * 16 + swz / 64; C = (st & 1) * 32 + (swz % 64) / 2; }
__host__ __device__ __forceinline__ int perm32(int rho) { const int n = rho >> 4, i = rho & 15; return 8 * (i >> 2) + 4 * n + (i & 3); }

struct Unit { int pm, pn; };
struct Gemm { const bf16_t* A; const bf16_t* Bt; int M, N, K; };

struct StaticOrder {
    int nM, nN, nwg, G, c;
    __host__ __device__ void init(int M, int N, int G_, int c_) { nM = M / BM; nN = N / BM; nwg = nM * nN; G = G_; c = c_; }
    __host__ __device__ bool next(int i, Unit& u) const {
        const long L = (long)i * G + c; if (L >= nwg) return false;
        int wgid = (int)L; { const int q = nwg / NXCD, r = nwg % NXCD, xcd = wgid % NXCD, off = wgid / NXCD; wgid = (xcd < r ? xcd * (q + 1) : r * (q + 1) + (xcd - r) * q) + off; }
        const int nig = WGM * nN, gid = wgid / nig, fm = gid * WGM, gsz = (nM - fm) < WGM ? (nM - fm) : WGM;
        u.pm = fm + ((wgid % nig) % gsz); u.pn = (wgid % nig) / gsz; return true;
    }
    __device__ __forceinline__ void a_ready(const Unit&) const {}
    __device__ __forceinline__ void done(const Unit&) const {}
};

__device__ __forceinline__ unsigned cvt_pk_bf16(float lo, float hi) { unsigned r; asm volatile("v_cvt_pk_bf16_f32 %0, %1, %2" : "=v"(r) : "v"(lo), "v"(hi)); return r; }

struct EpiBf16 {
    static constexpr bool PERM = true, AFTER_DRAIN = false, MIDSCALE = false, EXCH = false;
    bf16_t* O; int ldc;
    __device__ __forceinline__ void operator()(const f32x4 (&acc)[2][2][4][2], const Unit& u, int wr, int wc, int fr, int fq) const {
        const int row0 = u.pm * BM + wr * 64 + fr; const int col0 = u.pn * BM + wc * 32 + 8 * fq;
#pragma unroll
        for (int ai = 0; ai < 2; ++ai)
#pragma unroll
            for (int m = 0; m < 4; ++m) { bf16_t* rowp = O + (size_t)(row0 + ai * HALF + m * 16) * ldc + col0;
#pragma unroll
                for (int bj = 0; bj < 2; ++bj) { const f32x4 v0 = acc[ai][bj][m][0], v1 = acc[ai][bj][m][1];
                    u32x4 w; w.x = cvt_pk_bf16(v0[0], v0[1]); w.y = cvt_pk_bf16(v0[2], v0[3]); w.z = cvt_pk_bf16(v1[0], v1[1]); w.w = cvt_pk_bf16(v1[2], v1[3]);
                    *(u32x4*)(rowp + bj * HALF) = w; } }
    }
};

typedef unsigned u32x2v __attribute__((__vector_size__(2 * sizeof(unsigned))));
struct EpiInProj {
    static constexpr bool PERM = false, AFTER_DRAIN = false, MIDSCALE = false, EXCH = false;
    bf16_t* P; unsigned char* Q8; unsigned char* K8; unsigned char* V8T;
    const float* qg; const float* kg; const PG8_LAS float* rc; const PG8_LAS float* rs; float c2;
    __device__ __forceinline__ void operator()(const f32x4 (&acc)[2][2][4][2], const Unit& u, int wr, int wc, int fr, int fq) const {
        const int pn = u.pn;
        const bool nq = pn < 2, nk = (pn == 2 && wc < 2), normed = nq || nk;
        const float sc = (nq || pn == 3 || pn == 4) ? c2 : 1.0f;
        const float* g = nq ? qg : kg;
        f32x4 gv[2][2];
#pragma unroll
        for (int bj = 0; bj < 2; ++bj)
#pragma unroll
            for (int n = 0; n < 2; ++n) gv[bj][n] = normed ? *(const f32x4*)(g + 32 * bj + 16 * n + 4 * fq) : (f32x4){1.f, 1.f, 1.f, 1.f};
        const int colb = pn * BM + 64 * wc + 4 * fq;
#pragma unroll
        for (int ai = 0; ai < 2; ++ai)
#pragma unroll
            for (int m = 0; m < 4; ++m) {
                const int row = u.pm * BM + ai * HALF + wr * 64 + m * 16 + fr;
                f32x4 v[2][2];
#pragma unroll
                for (int bj = 0; bj < 2; ++bj)
#pragma unroll
                    for (int n = 0; n < 2; ++n) v[bj][n] = acc[ai][bj][m][n];
                if (normed) {
                    float ss = 0.f;
#pragma unroll
                    for (int bj = 0; bj < 2; ++bj)
#pragma unroll
                        for (int n = 0; n < 2; ++n) { const f32x4 x = v[bj][n]; ss += (x[0] * x[0] + x[1] * x[1]) + (x[2] * x[2] + x[3] * x[3]); }
                    ss += __shfl_xor(ss, 16); ss += __shfl_xor(ss, 32);
                    const float rinv = 1.0f / sqrtf(ss * (1.0f / 64.0f) + 1e-6f);
                    const int t = row & 8191, prow = t >> 6, pcol = t & 63;
#pragma unroll
                    for (int bj = 0; bj < 2; ++bj) {
                        const int pos = bj ? pcol : prow;
                        const f32x4 c4 = *(const PG8_LAS f32x4*)(rc + pos * 16 + 4 * fq), s4 = *(const PG8_LAS f32x4*)(rs + pos * 16 + 4 * fq);
                        const f32x4 x1 = v[bj][0] * rinv * gv[bj][0], x2 = v[bj][1] * rinv * gv[bj][1];
                        v[bj][0] = x1 * c4 - x2 * s4; v[bj][1] = x1 * s4 + x2 * c4;
                    }
                }
                const int coff = (fq & 1) ? 12 + 4 * fq : 4 * fq;
                if (pn > 2) {
                    bf16_t* rowp = P + (size_t)row * 2304 + pn * BM + 64 * wc + coff;
#pragma unroll
                    for (int bj = 0; bj < 2; ++bj) { const f32x4 x = v[bj][0] * sc, y = v[bj][1] * sc;
                        const u32x2v s0 = __builtin_amdgcn_permlane16_swap(cvt_pk_bf16(x[0], x[1]), cvt_pk_bf16(y[0], y[1]), false, false), s1 = __builtin_amdgcn_permlane16_swap(cvt_pk_bf16(x[2], x[3]), cvt_pk_bf16(y[2], y[3]), false, false);
                        u32x4 w; w.x = s0[0]; w.y = s1[0]; w.z = s0[1]; w.w = s1[1]; *(u32x4*)(rowp + 32 * bj) = w; }
                } else {
                    const float fs = nq ? sc * 4.0f : (nk ? 0.25f : 8.0f);
                    if (nq || nk) {
#pragma unroll
                        for (int bj = 0; bj < 2; ++bj) { const f32x4 x = v[bj][0] * fs, y = v[bj][1] * fs;
                            unsigned w0 = (unsigned)__builtin_amdgcn_cvt_pk_fp8_f32(x[0], x[1], 0, false); w0 = (unsigned)__builtin_amdgcn_cvt_pk_fp8_f32(x[2], x[3], (int)w0, true);
                            unsigned w1 = (unsigned)__builtin_amdgcn_cvt_pk_fp8_f32(y[0], y[1], 0, false); w1 = (unsigned)__builtin_amdgcn_cvt_pk_fp8_f32(y[2], y[3], (int)w1, true);
                            const u32x2v s0 = __builtin_amdgcn_permlane16_swap(w0, w1, false, false); u32x2 w; w.x = s0[0]; w.y = s0[1];
                            if (nq) *(u32x2*)(Q8 + (size_t)row * 512 + pn * 256 + 64 * wc + 32 * bj + coff) = w;
                            else    *(u32x2*)(K8 + (size_t)row * 128 + 64 * wc + 32 * bj + coff) = w; }
                    } else
#pragma unroll
                    for (int bj = 0; bj < 2; ++bj)
#pragma unroll
                        for (int n = 0; n < 2; ++n) { const f32x4 x = v[bj][n] * fs;
                            unsigned w = (unsigned)__builtin_amdgcn_cvt_pk_fp8_f32(x[0], x[1], 0, false); w = (unsigned)__builtin_amdgcn_cvt_pk_fp8_f32(x[2], x[3], (int)w, true);
                            const int d = 32 * bj + 16 * n + 4 * fq;
                            { const int t = row & 8191, kap = t & 63; const int kp = 32 * ((kap >> 2) & 1) + 16 * (kap >> 5) + (kap & 3) + 4 * ((kap & 31) >> 3);
                                unsigned char* vp = V8T + ((size_t)(((row >> 13) * 2 + (wc - 2)) * 64 + d)) * 8192 + (t & ~63) + kp;
                                vp[0] = (unsigned char)(w & 0xffu); vp[8192] = (unsigned char)((w >> 8) & 0xffu); vp[2 * 8192] = (unsigned char)((w >> 16) & 0xffu); vp[3 * 8192] = (unsigned char)(w >> 24); } }
                }
            }
    }
};

struct EpiX1 {
    static constexpr bool PERM = true, AFTER_DRAIN = false, MIDSCALE = true, EXCH = false;
    const float* x; bf16_t* out; const float* mod;
    const float* ssa; const float* ssb;
    PG8_LAS float* rsl;
    template <class Sched> __device__ __forceinline__ void prep(const Sched& S) const {
        Unit u;
        for (int i = 0; S.next(i, u); ++i) {
            if (threadIdx.x < 256) { const size_t r = (size_t)(u.pm * BM + threadIdx.x) * 8;
                const f32x4 a0 = *(const f32x4*)(ssa + r), a1 = *(const f32x4*)(ssa + r + 4), b0 = *(const f32x4*)(ssb + r), b1 = *(const f32x4*)(ssb + r + 4);
                const float sa = ((a0[0] + a0[1]) + (a0[2] + a0[3])) + ((a1[0] + a1[1]) + (a1[2] + a1[3])), sb = ((b0[0] + b0[1]) + (b0[2] + b0[3])) + ((b1[0] + b1[1]) + (b1[2] + b1[3]));
                const float ra = 1.0f / sqrtf(sa * (1.0f / 512.0f) + 1e-6f), rb = 1.0f / sqrtf(sb * (1.0f / 512.0f) + 1e-6f);
                rsl[(i * 256 + threadIdx.x) * 2] = ra / rb; rsl[(i * 256 + threadIdx.x) * 2 + 1] = rb; }
        }
        __syncthreads();
    }
    __device__ __forceinline__ void mid_scale(f32x4 (&acc)[2][2][4][2], int ui, int wr, int fr) const {
#pragma unroll
        for (int ai = 0; ai < 2; ++ai)
#pragma unroll
            for (int m = 0; m < 4; ++m) { const float sc = rsl[(ui * 256 + ai * HALF + wr * 64 + m * 16 + fr) * 2];
#pragma unroll
                for (int bj = 0; bj < 2; ++bj)
#pragma unroll
                    for (int n = 0; n < 2; ++n) acc[ai][bj][m][n] = acc[ai][bj][m][n] * sc; }
    }
    __device__ __forceinline__ void operator()(const f32x4 (&acc)[2][2][4][2], const Unit& u, int wr, int wc, int fr, int fq, int ui) const {
        const int col0 = u.pn * BM + wc * 32 + 8 * fq;
        const int b = (u.pm * BM) >> 13;
        f32x4 gt[2][2];
#pragma unroll
        for (int bj = 0; bj < 2; ++bj)
#pragma unroll
            for (int n = 0; n < 2; ++n) gt[bj][n] = *(const f32x4*)(mod + b * 6144 + 2048 + col0 + bj * HALF + 4 * n);
#pragma unroll
        for (int ai = 0; ai < 2; ++ai) {
            f32x4 xv[4][2][2];
#pragma unroll
            for (int m = 0; m < 4; ++m) { const size_t off = (size_t)(u.pm * BM + ai * HALF + wr * 64 + m * 16 + fr) * 1024 + col0;
#pragma unroll
                for (int bj = 0; bj < 2; ++bj)
#pragma unroll
                    for (int n = 0; n < 2; ++n) xv[m][bj][n] = *(const f32x4*)(x + off + bj * HALF + 4 * n); }
#pragma unroll
            for (int m = 0; m < 4; ++m) { const size_t off = (size_t)(u.pm * BM + ai * HALF + wr * 64 + m * 16 + fr) * 1024 + col0;
                const float fin = rsl[(ui * 256 + ai * HALF + wr * 64 + m * 16 + fr) * 2 + 1];
#pragma unroll
                for (int bj = 0; bj < 2; ++bj) { const f32x4 y0 = xv[m][bj][0] + gt[bj][0] * (acc[ai][bj][m][0] * fin), y1 = xv[m][bj][1] + gt[bj][1] * (acc[ai][bj][m][1] * fin);
                    u32x4 w; w.x = cvt_pk_bf16(y0[0], y0[1]); w.y = cvt_pk_bf16(y0[2], y0[3]); w.z = cvt_pk_bf16(y1[0], y1[1]); w.w = cvt_pk_bf16(y1[2], y1[3]);
                    *(u32x4*)(out + off + bj * HALF) = w; } }
        }
    }
};

struct EpiX1N {
    static constexpr bool PERM = true, AFTER_DRAIN = false, MIDSCALE = true, EXCH = true;
    const float* x; bf16_t* out; bf16_t* h2; const float* mod; const float* n2g;
    const float* ssa; const float* ssb;
    PG8_LAS float* rsl;
    unsigned* xs; unsigned* cnt;
    template <class Sched> __device__ __forceinline__ void prep(const Sched& S) const {
        Unit u;
        for (int i = 0; S.next(i, u); ++i) {
            if (threadIdx.x < 256) { const size_t r = (size_t)(u.pm * BM + threadIdx.x) * 8;
                const f32x4 a0 = *(const f32x4*)(ssa + r), a1 = *(const f32x4*)(ssa + r + 4), b0 = *(const f32x4*)(ssb + r), b1 = *(const f32x4*)(ssb + r + 4);
                const float sa = ((a0[0] + a0[1]) + (a0[2] + a0[3])) + ((a1[0] + a1[1]) + (a1[2] + a1[3])), sb = ((b0[0] + b0[1]) + (b0[2] + b0[3])) + ((b1[0] + b1[1]) + (b1[2] + b1[3]));
                const float ra = 1.0f / sqrtf(sa * (1.0f / 512.0f) + 1e-6f), rb = 1.0f / sqrtf(sb * (1.0f / 512.0f) + 1e-6f);
                rsl[(i * 256 + threadIdx.x) * 2] = ra / rb; rsl[(i * 256 + threadIdx.x) * 2 + 1] = rb; }
        }
        __syncthreads();
    }
    __device__ __forceinline__ void mid_scale(f32x4 (&acc)[2][2][4][2], int ui, int wr, int fr) const {
#pragma unroll
        for (int ai = 0; ai < 2; ++ai)
#pragma unroll
            for (int m = 0; m < 4; ++m) { const float sc = rsl[(ui * 256 + ai * HALF + wr * 64 + m * 16 + fr) * 2];
#pragma unroll
                for (int bj = 0; bj < 2; ++bj)
#pragma unroll
                    for (int n = 0; n < 2; ++n) acc[ai][bj][m][n] = acc[ai][bj][m][n] * sc; }
    }
    __device__ __forceinline__ void operator()(f32x4 (&acc)[2][2][4][2], const Unit& u, int wr, int wc, int fr, int fq, int ui, int wid, int lane) const {
        unsigned lb = (unsigned)(size_t)rsl; asm volatile("" : "+s"(lb));
        PG8_LAS float* R = (PG8_LAS float*)lb; PG8_LAS float* P = R + 1024; PG8_LAS float* S = R + 2048;
        int r0 = wr * 64 + fr; asm volatile("" : "+v"(r0));
        const int col0 = u.pn * BM + wc * 32 + 8 * fq;
        const int b = (u.pm * BM) >> 13;
        {
            f32x4 gt[2][2];
#pragma unroll
            for (int bj = 0; bj < 2; ++bj)
#pragma unroll
                for (int n = 0; n < 2; ++n) gt[bj][n] = *(const f32x4*)(mod + b * 6144 + 2048 + col0 + bj * HALF + 4 * n);
#pragma unroll
            for (int ai = 0; ai < 2; ++ai) {
                f32x4 xv[4][2][2];
#pragma unroll
                for (int m = 0; m < 4; ++m) { const size_t off = (size_t)(u.pm * BM + ai * HALF + m * 16 + r0) * 1024 + col0;
#pragma unroll
                    for (int bj = 0; bj < 2; ++bj)
#pragma unroll
                        for (int n = 0; n < 2; ++n) xv[m][bj][n] = *(const f32x4*)(x + off + bj * HALF + 4 * n); }
#pragma unroll
                for (int m = 0; m < 4; ++m) { const int r = ai * HALF + m * 16 + r0;
                    const float fin = R[(ui * 256 + r) * 2 + 1]; float s = 0.f;
#pragma unroll
                    for (int bj = 0; bj < 2; ++bj)
#pragma unroll
                        for (int n = 0; n < 2; ++n) { const f32x4 y = xv[m][bj][n] + gt[bj][n] * (acc[ai][bj][m][n] * fin); acc[ai][bj][m][n] = y; s += (y[0] * y[0] + y[1] * y[1]) + (y[2] * y[2] + y[3] * y[3]); }
                    s += __shfl_xor(s, 16); s += __shfl_xor(s, 32);
                    if (fq == 0) P[r * 4 + wc] = s; }
            }
        }
        asm volatile("s_waitcnt lgkmcnt(0)" ::: "memory"); __builtin_amdgcn_s_barrier(); asm volatile("" ::: "memory");
        int row = wid * 32 + (lane & 31); asm volatile("" : "+v"(row));
        if (lane < 32) { const f32x4 p = *(const PG8_LAS f32x4*)(P + row * 4);
            __hip_atomic_store(xs + (size_t)(u.pm * BM + row) * 4 + u.pn, __builtin_bit_cast(unsigned, (p[0] + p[1]) + (p[2] + p[3])), __ATOMIC_RELAXED, __HIP_MEMORY_SCOPE_AGENT); }
        asm volatile("s_waitcnt vmcnt(0)" ::: "memory");
        if (lane == 0) __hip_atomic_fetch_add(cnt + 64 * u.pm, 1u, __ATOMIC_RELAXED, __HIP_MEMORY_SCOPE_AGENT);
        if (wid == 0) {
            unsigned sp = 0u;
            while ((unsigned)__builtin_amdgcn_readfirstlane(__hip_atomic_load(cnt + 64 * u.pm, __ATOMIC_RELAXED, __HIP_MEMORY_SCOPE_AGENT)) < 32u) { __builtin_amdgcn_s_sleep(1); if (++sp > (1u << 22)) break; }
            __builtin_amdgcn_fence(__ATOMIC_ACQUIRE, "agent");
        }
        asm volatile("s_waitcnt vmcnt(0) lgkmcnt(0)" ::: "memory"); __builtin_amdgcn_s_barrier(); asm volatile("" ::: "memory");
        if (lane < 32) { const unsigned* sl = xs + (size_t)(u.pm * BM + row) * 4; float t = 0.f;
#pragma unroll
            for (int k = 0; k < 4; ++k) t += __builtin_bit_cast(float, __hip_atomic_load(sl + k, __ATOMIC_RELAXED, __HIP_MEMORY_SCOPE_AGENT));
            S[row] = 1.0f / sqrtf(t * (1.0f / 1024.0f) + 1e-6f); }
        asm volatile("s_waitcnt lgkmcnt(0)" ::: "memory"); __builtin_amdgcn_s_barrier(); asm volatile("" ::: "memory");
        f32x4 wv[2][2], sv[2][2];
#pragma unroll
        for (int bj = 0; bj < 2; ++bj)
#pragma unroll
            for (int n = 0; n < 2; ++n) { const int c = col0 + bj * HALF + 4 * n;
                wv[bj][n] = *(const f32x4*)(n2g + c) * (*(const f32x4*)(mod + b * 6144 + 4096 + c) + 1.0f); sv[bj][n] = *(const f32x4*)(mod + b * 6144 + 3072 + c); }
#pragma unroll
        for (int ai = 0; ai < 2; ++ai)
#pragma unroll
            for (int m = 0; m < 4; ++m) { const int r = ai * HALF + m * 16 + r0; const size_t off = (size_t)(u.pm * BM + r) * 1024 + col0; const float ri = S[r];
#pragma unroll
                for (int bj = 0; bj < 2; ++bj) { const f32x4 y0 = acc[ai][bj][m][0], y1 = acc[ai][bj][m][1];
                    u32x4 w; w.x = cvt_pk_bf16(y0[0], y0[1]); w.y = cvt_pk_bf16(y0[2], y0[3]); w.z = cvt_pk_bf16(y1[0], y1[1]); w.w = cvt_pk_bf16(y1[2], y1[3]);
                    *(u32x4*)(out + off + bj * HALF) = w;
                    const f32x4 h0 = (y0 * ri) * wv[bj][0] + sv[bj][0], h1 = (y1 * ri) * wv[bj][1] + sv[bj][1];
                    u32x4 g; g.x = cvt_pk_bf16(h0[0], h0[1]); g.y = cvt_pk_bf16(h0[2], h0[3]); g.z = cvt_pk_bf16(h1[0], h1[1]); g.w = cvt_pk_bf16(h1[2], h1[3]);
                    *(u32x4*)(h2 + off + bj * HALF) = g; } }
    }
};


template <class Epi, class Sched, bool ALIGN_EPI = false, bool SP2 = false>
__device__ __forceinline__ void gemm_phase(PG8_LAS unsigned char* lds, const Gemm g, const Sched& S, const Epi& E) {
    const int tid = threadIdx.x, wid = __builtin_amdgcn_readfirstlane(tid >> 6), lane = tid & 63, wr = wid >> 2, wc = wid & 3, fr = lane & 15, fq = lane >> 4;
    const int K = g.K, nt = K / BK;
    unsigned voffA[2], voffB[2];
#pragma unroll
    for (int i = 0; i < 2; ++i) { int R, C; stage_rc(tid * 16 + i * 8192, R, C); const int Rb = Epi::PERM ? ((R & ~31) + perm32(R & 31)) : R;
        voffA[i] = (unsigned)(R * K + C) * 2u; voffB[i] = (unsigned)(Rb * K + C) * 2u; }
    const size_t kstep = (size_t)(BK * 2);
    const size_t hstep = (size_t)HALF * K * 2;
    const size_t tstep = 2 * hstep;
    const unsigned ldsw = (unsigned)wid * 1024u;
    const int aoff = lds_byte(wr * 64 + fr, fq * 8), boff = lds_byte(wc * 32 + fr, fq * 8);
#define PG8_SA(b, h) (((b) * 2 + (h)) * HTB)
#define PG8_SB(b, h) ((4 + (b) * 2 + (h)) * HTB)
#define PG8_STAGE(bufoff, gbase, voff) do { _Pragma("unroll") for (int _i = 0; _i < 2; ++_i) \
        __builtin_amdgcn_global_load_lds((const unsigned*)((const char*)(gbase) + (voff)[_i]), (PG8_LAS unsigned*)(lds + (bufoff) + ldsw + _i * 8192), 16, 0, 0); } while (0)
#define PG8_LDA(dst, b, h) do { _Pragma("unroll") for (int m = 0; m < 4; ++m) _Pragma("unroll") for (int k = 0; k < 2; ++k) dst[m][k] = *(const PG8_LAS bf16x8*)(lds + PG8_SA(b, h) + aoff + m * 2048 + k * 1024); } while (0)
#define PG8_LDB(dst, b, h) do { _Pragma("unroll") for (int n = 0; n < 2; ++n) _Pragma("unroll") for (int k = 0; k < 2; ++k) dst[n][k] = *(const PG8_LAS bf16x8*)(lds + PG8_SB(b, h) + boff + n * 2048 + k * 1024); } while (0)
#define PG8_MMA(ai, bj, At, Bt) do { __builtin_amdgcn_s_setprio(1); _Pragma("unroll") for (int m = 0; m < 4; ++m) _Pragma("unroll") for (int n = 0; n < 2; ++n) _Pragma("unroll") for (int k = 0; k < 2; ++k) \
        acc[ai][bj][m][n] = __builtin_amdgcn_mfma_f32_16x16x32_bf16(Bt[n][k], At[m][k], acc[ai][bj][m][n], 0, 0, 0); __builtin_amdgcn_s_setprio(0); } while (0)
#define PG8_WAIT_V(n) asm volatile("s_waitcnt vmcnt(" #n ")" ::: "memory")
#define PG8_WAIT_L(n) asm volatile("s_waitcnt lgkmcnt(" #n ")" ::: "memory")
#define PG8_BAR __builtin_amdgcn_s_barrier()
#define PG8_SCHED __builtin_amdgcn_sched_barrier(0)
    Unit cur, nxt; int ui = 0;
    if (!S.next(0, cur)) return;
    f32x4 acc[2][2][4][2];
#pragma unroll
    for (int a = 0; a < 2; ++a)
#pragma unroll
        for (int b = 0; b < 2; ++b)
#pragma unroll
            for (int m = 0; m < 4; ++m)
#pragma unroll
                for (int n = 0; n < 2; ++n) acc[a][b][m][n] = (f32x4){0.f, 0.f, 0.f, 0.f};
    bf16x8 At[4][2], B0[2][2], B1[2][2];
    const char* cA = (const char*)g.A + (size_t)cur.pm * tstep; const char* cB = (const char*)g.Bt + (size_t)cur.pn * tstep;
    S.a_ready(cur);
    if constexpr (SP2) {
        PG8_STAGE(PG8_SB(0, 0), cB, voffB); PG8_STAGE(PG8_SB(0, 1), cB + hstep, voffB); PG8_STAGE(PG8_SA(0, 0), cA, voffA); PG8_STAGE(PG8_SA(0, 1), cA + hstep, voffA);
        if (wr == 1) PG8_BAR;
        PG8_WAIT_V(2); PG8_BAR;
        PG8_STAGE(PG8_SB(1, 0), cB + kstep, voffB); PG8_STAGE(PG8_SA(1, 0), cA + kstep, voffA); PG8_STAGE(PG8_SB(1, 1), cB + hstep + kstep, voffB);
        PG8_WAIT_V(6); PG8_BAR;
    } else {
        PG8_STAGE(PG8_SB(0, 0), cB, voffB); PG8_STAGE(PG8_SA(0, 0), cA, voffA); PG8_STAGE(PG8_SB(0, 1), cB + hstep, voffB); PG8_STAGE(PG8_SA(0, 1), cA + hstep, voffA);
        if (wr == 1) PG8_BAR;
        PG8_WAIT_V(4); PG8_BAR;
        PG8_STAGE(PG8_SB(1, 0), cB + kstep, voffB); PG8_STAGE(PG8_SA(1, 0), cA + kstep, voffA); PG8_STAGE(PG8_SB(1, 1), cB + hstep + kstep, voffB);
        PG8_WAIT_V(6); PG8_BAR;
    }
    for (;;) {
        const bool has_next = S.next(ui + 1, nxt);
        const char* nA = has_next ? (const char*)g.A + (size_t)nxt.pm * tstep : cA; const char* nB = has_next ? (const char*)g.Bt + (size_t)nxt.pn * tstep : cB;
        for (int t = 0; t < nt; t += 2) {
            if constexpr (Epi::MIDSCALE) { if (t == nt / 2) E.mid_scale(acc, ui, wr, fr); }
            const bool last = (t == nt - 2);
            const char* a1 = cA + (size_t)(t + 1) * kstep;
            const char* a2 = last ? nA : cA + (size_t)(t + 2) * kstep; const char* b2 = last ? nB : cB + (size_t)(t + 2) * kstep;
            const char* a3 = a2 + kstep; const char* b3 = b2 + kstep;
            if (last && has_next) S.a_ready(nxt);
            if constexpr (SP2) {
            PG8_LDB(B0, 0, 0); PG8_LDB(B1, 0, 1); PG8_SCHED; PG8_LDA(At, 0, 0); PG8_STAGE(PG8_SA(1, 1), a1 + hstep, voffA);
            PG8_WAIT_V(8); PG8_WAIT_L(0); PG8_BAR; PG8_MMA(0, 0, At, B0); PG8_MMA(0, 1, At, B1); PG8_BAR; PG8_SCHED;
            PG8_LDA(At, 0, 1); PG8_STAGE(PG8_SB(0, 0), b2, voffB); PG8_STAGE(PG8_SB(0, 1), b2 + hstep, voffB); PG8_STAGE(PG8_SA(0, 0), a2, voffA);
            PG8_WAIT_V(8); PG8_WAIT_L(0); PG8_BAR; PG8_MMA(1, 0, At, B0); PG8_MMA(1, 1, At, B1); PG8_BAR; PG8_SCHED;
            PG8_LDB(B0, 1, 0); PG8_LDB(B1, 1, 1); PG8_SCHED; PG8_LDA(At, 1, 0); PG8_STAGE(PG8_SA(0, 1), a2 + hstep, voffA);
            PG8_WAIT_V(8); PG8_WAIT_L(0); PG8_BAR; PG8_MMA(0, 0, At, B0); PG8_MMA(0, 1, At, B1); PG8_BAR; PG8_SCHED;
            PG8_LDA(At, 1, 1); PG8_STAGE(PG8_SB(1, 0), b3, voffB); PG8_STAGE(PG8_SB(1, 1), b3 + hstep, voffB); PG8_STAGE(PG8_SA(1, 0), a3, voffA);
            PG8_WAIT_V(8); PG8_WAIT_L(0); PG8_BAR; PG8_MMA(1, 0, At, B0); PG8_MMA(1, 1, At, B1); PG8_BAR; PG8_SCHED;
            } else {
            PG8_LDB(B0, 0, 0); PG8_SCHED; PG8_LDA(At, 0, 0); PG8_STAGE(PG8_SA(1, 1), a1 + hstep, voffA);
            PG8_WAIT_L(8); PG8_BAR; PG8_WAIT_L(0); PG8_MMA(0, 0, At, B0); PG8_BAR; PG8_SCHED;
            PG8_LDB(B1, 0, 1); PG8_STAGE(PG8_SB(0, 0), b2, voffB);
            PG8_BAR; PG8_WAIT_L(0); PG8_MMA(0, 1, At, B1); PG8_BAR;
            PG8_LDA(At, 0, 1); PG8_STAGE(PG8_SA(0, 0), a2, voffA);
            PG8_BAR; PG8_WAIT_L(0); PG8_MMA(1, 0, At, B0); PG8_BAR; PG8_SCHED;
            PG8_STAGE(PG8_SB(0, 1), b2 + hstep, voffB);
            PG8_WAIT_V(6); PG8_BAR; PG8_MMA(1, 1, At, B1); PG8_BAR;
            PG8_LDB(B0, 1, 0); PG8_SCHED; PG8_LDA(At, 1, 0); PG8_STAGE(PG8_SA(0, 1), a2 + hstep, voffA);
            PG8_WAIT_L(8); PG8_BAR; PG8_WAIT_L(0); PG8_MMA(0, 0, At, B0); PG8_BAR; PG8_SCHED;
            PG8_LDB(B1, 1, 1); PG8_STAGE(PG8_SB(1, 0), b3, voffB);
            PG8_BAR; PG8_WAIT_L(0); PG8_MMA(0, 1, At, B1); PG8_BAR;
            PG8_LDA(At, 1, 1); PG8_STAGE(PG8_SA(1, 0), a3, voffA);
            PG8_BAR; PG8_WAIT_L(0); PG8_MMA(1, 0, At, B0); PG8_BAR; PG8_SCHED;
            PG8_STAGE(PG8_SB(1, 1), b3 + hstep, voffB);
            PG8_WAIT_V(6); PG8_BAR; PG8_MMA(1, 1, At, B1); PG8_BAR;
            }
        }
        if constexpr (ALIGN_EPI) { if (wr == 0) PG8_BAR; }
        if constexpr (!Epi::AFTER_DRAIN) { if constexpr (Epi::EXCH) E(acc, cur, wr, wc, fr, fq, ui, wid, lane); else if constexpr (Epi::MIDSCALE) E(acc, cur, wr, wc, fr, fq, ui); else E(acc, cur, wr, wc, fr, fq); S.done(cur); }
        if (!has_next) break;
#pragma unroll
        for (int a = 0; a < 2; ++a)
#pragma unroll
            for (int b = 0; b < 2; ++b)
#pragma unroll
                for (int m = 0; m < 4; ++m)
#pragma unroll
                    for (int n = 0; n < 2; ++n) acc[a][b][m][n] = (f32x4){0.f, 0.f, 0.f, 0.f};
        cur = nxt; cA = nA; cB = nB; ++ui;
        if constexpr (ALIGN_EPI) { if (wr == 1) PG8_BAR; }
    }
    PG8_WAIT_V(0);
    if constexpr (!ALIGN_EPI) { if (wr == 0) PG8_BAR; }
    PG8_BAR;
    if constexpr (Epi::AFTER_DRAIN) { E.fused(acc, cur, wr, wc, fr, fq, lds, wid, lane); S.done(cur); }
#undef PG8_SA
#undef PG8_SB
#undef PG8_STAGE
#undef PG8_LDA
#undef PG8_LDB
#undef PG8_MMA
#undef PG8_WAIT_V
#undef PG8_WAIT_L
#undef PG8_BAR
#undef PG8_SCHED
}
}

namespace attn_body {
using bf16=__hip_bfloat16;
using bf16x8=__attribute__((ext_vector_type(8)))short;
using s16x4=__attribute__((ext_vector_type(4)))short;
using f32x16=__attribute__((ext_vector_type(16)))float;
using u32x4=__attribute__((ext_vector_type(4)))unsigned;
constexpr int BATCH=4,NHEAD=8,NKV=2,SEQ=8192,D=64,PP=2304,OP=1024;
constexpr int NW=8,QBLK=32,QB=QBLK*NW,KVBLK=64,NQB=SEQ/QB;
constexpr int ATTN_UNIT_ROWS=QB;
__device__ __forceinline__ int crow(int r,int hi){return (r&3)+8*(r>>2)+4*hi;}
#define SBAR() __builtin_amdgcn_sched_barrier(0)
__device__ __forceinline__ void cmask(f32x16&p0,f32x16&p1,int jb,int qrel,int hi){
  const float NEG=-INFINITY; int kb=64*jb+4*hi;
  #pragma unroll
  for(int r=0;r<16;++r){int kv=kb+(r&3)+8*(r>>2); if(kv>qrel)p0[r]=NEG; if(kv+32>qrel)p1[r]=NEG;}
}

constexpr int NSLOT=3, SLOTB=8192;
constexpr int LDS_K=0, LDS_V=NSLOT*SLOTB, LDS_WS=2*NSLOT*SLOTB, LDS_OST=LDS_WS+NW*64*4, LDS_BYTES=LDS_OST+NW*4096;
constexpr float C2=0.125f*1.4426950408889634f;
__device__ __forceinline__ void glds16(const void*gsrc,unsigned lds_dst){unsigned keep;
  asm volatile("s_mov_b32 %0, m0\n\ts_mov_b32 m0, %2\n\ts_nop 0\n\tglobal_load_lds_dwordx4 %1, off\n\ts_mov_b32 m0, %0":"=&s"(keep):"v"(gsrc),"s"(lds_dst):"memory");}
__device__ __forceinline__ float max3f(float a,float b,float c){float r;asm("v_max3_f32 %0, %1, %2, %3":"=v"(r):"v"(a),"v"(b),"v"(c));return r;}
__device__ __forceinline__ float max2f(float a,float b){float r;asm("v_max_f32_e32 %0, %1, %2":"=v"(r):"v"(a),"v"(b));return r;}
__device__ __forceinline__ float fadd_s(float a,float b){float r;asm("v_add_f32_e32 %0, %1, %2":"=v"(r):"v"(a),"v"(b));return r;}
__device__ __forceinline__ float fsub_s(float a,float b){float r;asm("v_sub_f32_e32 %0, %1, %2":"=v"(r):"v"(a),"v"(b));return r;}
typedef float f32x2_t __attribute__((ext_vector_type(2))); typedef __bf16 bf16x2_t __attribute__((ext_vector_type(2)));
__device__ __forceinline__ unsigned cvtpk_s(float lo,float hi){f32x2_t v={lo,hi};bf16x2_t b=__builtin_convertvector(v,bf16x2_t);return __builtin_bit_cast(unsigned,b);}
#define WAIT_BAR(N) asm volatile("s_waitcnt vmcnt(" #N ") lgkmcnt(0)\n\ts_barrier":::"memory")

__device__ __forceinline__ void qkt(f32x16&p0,f32x16&p1,const char*Kslot,const bf16x8*qr,const f32x16&negm,int r32,int hi){
  const char*kb=Kslot+hi*1024+r32*16;
  #pragma unroll
  for(int d0=0;d0<4;++d0){
    const bf16x8 b0=*reinterpret_cast<const bf16x8*>(kb+d0*2048);
    const bf16x8 b1=*reinterpret_cast<const bf16x8*>(kb+d0*2048+512);
    if(d0==0){p0=__builtin_amdgcn_mfma_f32_32x32x16_bf16(b0,qr[0],negm,0,0,0);p1=__builtin_amdgcn_mfma_f32_32x32x16_bf16(b1,qr[0],negm,0,0,0);}
    else{p0=__builtin_amdgcn_mfma_f32_32x32x16_bf16(b0,qr[d0],p0,0,0,0);p1=__builtin_amdgcn_mfma_f32_32x32x16_bf16(b1,qr[d0],p1,0,0,0);}}
}
typedef __attribute__((address_space(3))) const char* lds_cptr;
typedef short v4i16_t __attribute__((ext_vector_type(4)));
__device__ __forceinline__ void kload8(bf16x8*kf,lds_cptr kp){
  kf[0]=*(const __attribute__((address_space(3))) bf16x8*)(kp);      kf[1]=*(const __attribute__((address_space(3))) bf16x8*)(kp+512);
  kf[2]=*(const __attribute__((address_space(3))) bf16x8*)(kp+2048); kf[3]=*(const __attribute__((address_space(3))) bf16x8*)(kp+2560);
  kf[4]=*(const __attribute__((address_space(3))) bf16x8*)(kp+4096); kf[5]=*(const __attribute__((address_space(3))) bf16x8*)(kp+4608);
  kf[6]=*(const __attribute__((address_space(3))) bf16x8*)(kp+6144); kf[7]=*(const __attribute__((address_space(3))) bf16x8*)(kp+6656);
}
__device__ __forceinline__ void kload2(bf16x8*kf,lds_cptr kp,int j){ kf[2*j]=*(const __attribute__((address_space(3))) bf16x8*)(kp+j*2048); kf[2*j+1]=*(const __attribute__((address_space(3))) bf16x8*)(kp+j*2048+512); }
__device__ __forceinline__ s16x4 vtr(lds_cptr p){ return __builtin_bit_cast(s16x4,__builtin_amdgcn_ds_read_tr16_b64_v4i16((__attribute__((address_space(3))) v4i16_t*)p)); }
__device__ __forceinline__ float rowmax(const f32x16&p0,const f32x16&p1){
  float a=max3f(p0[0],p0[1],p1[0]),b=max3f(p0[2],p0[3],p1[1]);a=max3f(a,p1[2],p1[3]);
  #pragma unroll
  for(int r=4;r<16;r+=4){a=max3f(a,p0[r],p0[r+1]);b=max3f(b,p0[r+2],p0[r+3]);a=max3f(a,p1[r],p1[r+1]);b=max3f(b,p1[r+2],p1[r+3]);}
  const float m=max2f(a,b);
  auto rr=__builtin_amdgcn_permlane32_swap(__float_as_uint(m),__float_as_uint(m),false,false);
  return max2f(__uint_as_float(rr[0]),__uint_as_float(rr[1]));
}
__device__ __forceinline__ void pv(f32x16*o,int vb,bf16x8 pa0,bf16x8 pa1,bf16x8 pa2,bf16x8 pa3){
  #pragma unroll
  for(int d0=0;d0<2;++d0){s16x4 lo[4],hi[4];
    #pragma unroll
    for(int ks=0;ks<4;++ks){
      asm volatile("ds_read_b64_tr_b16 %0,%1 offset:%c2":"=&v"(lo[ks]):"v"(vb),"i"(d0*4096+ks*1024):"memory");
      asm volatile("ds_read_b64_tr_b16 %0,%1 offset:%c2":"=&v"(hi[ks]):"v"(vb),"i"(d0*4096+ks*1024+512):"memory");}
    asm volatile("s_waitcnt lgkmcnt(0)":::"memory");SBAR();
    #define PK(k) (bf16x8){lo[k][0],lo[k][1],lo[k][2],lo[k][3],hi[k][0],hi[k][1],hi[k][2],hi[k][3]}
    o[d0]=__builtin_amdgcn_mfma_f32_32x32x16_bf16(pa0,PK(0),o[d0],0,0,0);
    o[d0]=__builtin_amdgcn_mfma_f32_32x32x16_bf16(pa1,PK(1),o[d0],0,0,0);
    o[d0]=__builtin_amdgcn_mfma_f32_32x32x16_bf16(pa2,PK(2),o[d0],0,0,0);
    o[d0]=__builtin_amdgcn_mfma_f32_32x32x16_bf16(pa3,PK(3),o[d0],0,0,0);
    #undef PK
  }
}

#ifndef ATTN_STORE16
#define ATTN_STORE16(p,v) (*(u32x4*)(p)=(v))
#endif
template<int THRL> __device__ __forceinline__ void attn_unit(float cb,int b,int h,int kvh,int qb,const bf16*Q,const bf16*__restrict__ K,const bf16*__restrict__ V,bf16*O,float*SS,char*shm){
  const int tid=threadIdx.x,lane=tid&63,r32=lane&31,hi=lane>>5; const int wid=__builtin_amdgcn_readfirstlane(tid>>6);
  const long rowbase=(long)b*SEQ; const int q0=qb*QB;
  const bf16*Qw=Q+(rowbase+q0+wid*QBLK)*PP+h*D;
  const bf16*Kh=K+rowbase*PP+kvh*D,*Vh=V+rowbase*PP+kvh*D;
  const unsigned lds0=(unsigned)(uintptr_t)shm;
  float*wsf=(float*)(shm+LDS_WS)+wid*64;
  const bf16*ksrc=Kh+(long)lane*PP+wid*8;
  const bf16*vsrc=Vh+(long)(16*(wid&3)+(lane>>2))*PP+(wid>>2)*32+(lane&3)*8;
  const unsigned kdst=lds0+LDS_K+wid*1024, vdst=lds0+LDS_V+wid*1024;
  #define DMA_K(t,slot) glds16(ksrc+(long)(t)*KVBLK*PP,(unsigned)__builtin_amdgcn_readfirstlane(kdst+(slot)))
  #define DMA_V(t,slot) glds16(vsrc+(long)(t)*KVBLK*PP,(unsigned)__builtin_amdgcn_readfirstlane(vdst+(slot)))
  const int vb0=(int)(lds0+LDS_V)+((lane>>4)&1)*32+(lane&3)*8+(4*hi+((lane&15)>>2))*64;
  const char*Kbase=shm+LDS_K; bf16x8 kf[8];
  const lds_cptr shm3=(lds_cptr)shm; const lds_cptr kp0=shm3+LDS_K+hi*1024+r32*16; const lds_cptr vp0=shm3+LDS_V+((lane>>4)&1)*32+(lane&3)*8+(4*hi+((lane&15)>>2))*64;
  const int NT=SEQ/KVBLK;
  DMA_K(0,0);DMA_V(0,0);DMA_K(1,SLOTB);
  bf16x8 qr[4];
  #pragma unroll
  for(int d0=0;d0<4;++d0)qr[d0]=*reinterpret_cast<const bf16x8*>(&Qw[(long)r32*PP+d0*16+hi*8]);
  float l_reg=0.f;f32x16 o[2];o[0]=f32x16{};o[1]=f32x16{};f32x16 negm;
  #pragma unroll
  for(int r=0;r<16;++r)negm[r]=-cb;
  asm volatile("":"+v"(negm));
  const int qrel=wid*QBLK+r32;
  #define CMASK(P0,P1,t) do{}while(0)
  #define START(P0,P1) do{ _Pragma("unroll") for(int r=0;r<16;++r)P0[r]=__builtin_amdgcn_exp2f(P0[r]); }while(0)
  #define RESC() do{}while(0)
  f32x16 pA0,pA1,pB0,pB1;
  int sl_prev=0,sl_cur=0,sl_next=SLOTB;
  #define ROT() do{sl_prev=sl_cur;sl_cur=sl_next;sl_next=(sl_next==(NSLOT-1)*SLOTB)?0:sl_next+SLOTB;}while(0)
  DMA_K(2,2*SLOTB);
  WAIT_BAR(3);
  qkt(pA0,pA1,Kbase,qr,negm,r32,hi);asm volatile("s_nop 15\n\ts_nop 7":"+v"(pA0),"+v"(pA1));CMASK(pA0,pA1,0);
  START(pA0,pA1);
  _Pragma("unroll") for(int r=0;r<16;++r)pA1[r]=__builtin_amdgcn_exp2f(pA1[r]);
  WAIT_BAR(0);
  DMA_K(3,0);DMA_V(1,SLOTB);
  ROT();
  kload8(kf,kp0+sl_cur);
  WAIT_BAR(2);
  s16x4 vlo[8],vhi[8]; u32x4 pw0,pw1,pw2,pw3;
  #define PKW(P,B) cvtpk_s(P[B],P[B+1])
  #define PAF(k) __builtin_bit_cast(bf16x8,pw##k)
  #define VFR(i) (bf16x8){vlo[i][0],vlo[i][1],vlo[i][2],vlo[i][3],vhi[i][0],vhi[i][1],vhi[i][2],vhi[i][3]}
  #define PIN(x) asm volatile("":"+v"(x))
  #define MX3(a,b,c) __builtin_fmaxf(__builtin_fmaxf((a),(b)),(c))
  #define GAPA(MF,A0,A1,A2,A3,W0,W1,PW) do{ MF; sacc+=A0; sacc+=A1; sacc+=A2; sacc+=A3; PIN(sacc); W0; W1; PIN(PW); SBAR(); }while(0)
  #define EX(v) __builtin_amdgcn_exp2f(v)
  #define GAPB(MF,X,B) do{ MF; X[B]=EX(X[B]); X[B+1]=EX(X[B+1]); X[B+2]=EX(X[B+2]); X[B+3]=EX(X[B+3]); PIN(X); SBAR(); }while(0)
  #define VRD(i) do{ vlo[i]=vtr(vp_+(((i)>>2)*4096+((i)&3)*1024)); vhi[i]=vtr(vp_+(((i)>>2)*4096+((i)&3)*1024+512)); }while(0)
  #define KRD(G,j) do{ if(G){ kload2(kf,kp0+sl_next,j); SBAR(); } }while(0)
  #define STEP(C0,C1,P0,P1,t,GK,GV,GL) do{ SBAR(); \
    const lds_cptr vp_=vp0+sl_prev; \
    VRD(0); SBAR(); float sacc=(P0[0]+P0[1]); \
    GAPA(C0=__builtin_amdgcn_mfma_f32_32x32x16_bf16(kf[0],qr[0],negm,0,0,0), P0[2],P0[3],P0[4],P0[5],     pw0[0]=PKW(P0,0), pw0[1]=PKW(P0,2), pw0); \
    VRD(4); SBAR(); GAPA(C1=__builtin_amdgcn_mfma_f32_32x32x16_bf16(kf[1],qr[0],negm,0,0,0), P0[6],P0[7],P0[8],P0[9],     pw0[2]=PKW(P0,4), pw0[3]=PKW(P0,6), pw0); \
    VRD(1); SBAR(); GAPA(C0=__builtin_amdgcn_mfma_f32_32x32x16_bf16(kf[2],qr[1],C0,0,0,0),   P0[10],P0[11],P0[12],P0[13], pw1[0]=PKW(P0,8), pw1[1]=PKW(P0,10), pw1); \
    VRD(5); SBAR(); GAPA(C1=__builtin_amdgcn_mfma_f32_32x32x16_bf16(kf[3],qr[1],C1,0,0,0),   P0[14],P0[15],P1[0],P1[1],   pw1[2]=PKW(P0,12),pw1[3]=PKW(P0,14), pw1); \
    VRD(2); SBAR(); GAPA(C0=__builtin_amdgcn_mfma_f32_32x32x16_bf16(kf[4],qr[2],C0,0,0,0),   P1[2],P1[3],P1[4],P1[5],     pw2[0]=PKW(P1,0), pw2[1]=PKW(P1,2), pw2); \
    VRD(6); SBAR(); GAPA(C1=__builtin_amdgcn_mfma_f32_32x32x16_bf16(kf[5],qr[2],C1,0,0,0),   P1[6],P1[7],P1[8],P1[9],     pw2[2]=PKW(P1,4), pw2[3]=PKW(P1,6), pw2); \
    VRD(3); SBAR(); GAPA(C0=__builtin_amdgcn_mfma_f32_32x32x16_bf16(kf[6],qr[3],C0,0,0,0),   P1[10],P1[11],P1[12],P1[13], pw3[0]=PKW(P1,8), pw3[1]=PKW(P1,10), pw3); \
    VRD(7); SBAR(); GAPA(C1=__builtin_amdgcn_mfma_f32_32x32x16_bf16(kf[7],qr[3],C1,0,0,0),   P1[14],P1[15],0.f,0.f,       pw3[2]=PKW(P1,12),pw3[3]=PKW(P1,14), pw3); \
    l_reg+=sacc; \
    if(GK){DMA_K((t)+3,sl_cur);} if(GV){DMA_V((t)+1,sl_next);} \
    CMASK(C0,C1,t); \
    SBAR(); \
    GAPB(o[0]=__builtin_amdgcn_mfma_f32_32x32x16_bf16(PAF(0),VFR(0),o[0],0,0,0), C0,0); \
    GAPB(o[1]=__builtin_amdgcn_mfma_f32_32x32x16_bf16(PAF(0),VFR(4),o[1],0,0,0), C0,4); \
    KRD(GL,0); GAPB(o[0]=__builtin_amdgcn_mfma_f32_32x32x16_bf16(PAF(1),VFR(1),o[0],0,0,0), C0,8); \
    KRD(GL,1); GAPB(o[1]=__builtin_amdgcn_mfma_f32_32x32x16_bf16(PAF(1),VFR(5),o[1],0,0,0), C0,12); \
    KRD(GL,2); GAPB(o[0]=__builtin_amdgcn_mfma_f32_32x32x16_bf16(PAF(2),VFR(2),o[0],0,0,0), C1,0); \
    KRD(GL,3); GAPB(o[1]=__builtin_amdgcn_mfma_f32_32x32x16_bf16(PAF(2),VFR(6),o[1],0,0,0), C1,4); \
    GAPB(o[0]=__builtin_amdgcn_mfma_f32_32x32x16_bf16(PAF(3),VFR(3),o[0],0,0,0), C1,8); \
    GAPB(o[1]=__builtin_amdgcn_mfma_f32_32x32x16_bf16(PAF(3),VFR(7),o[1],0,0,0), C1,12); \
    }while(0)
  int t=1;
  #undef CMASK
  #define CMASK(P0,P1,t) do{}while(0)
  for(;t+5<NT;t+=2){
    STEP(pB0,pB1,pA0,pA1,t,true,true,true);     WAIT_BAR(2); RESC(); ROT();
    STEP(pA0,pA1,pB0,pB1,t+1,true,true,true);   WAIT_BAR(2); RESC(); ROT();
  }
  #undef CMASK
  #define CMASK(P0,P1,t) do{}while(0)
  #define ENDW(tt) do{ if((tt)+3<NT){WAIT_BAR(2);} else if((tt)+2<NT){WAIT_BAR(1);} else {WAIT_BAR(0);} }while(0)
  for(;t+1<NT;t+=2){
    STEP(pB0,pB1,pA0,pA1,t,(t+3<NT),(t+1<NT),(t+1<NT));       ENDW(t);   RESC(); ROT();
    STEP(pA0,pA1,pB0,pB1,t+1,(t+4<NT),(t+2<NT),(t+2<NT));     ENDW(t+1); RESC(); ROT();
  }
  STEP(pB0,pB1,pA0,pA1,NT-1,false,false,false); RESC();
  { float sacc=pB0[0]+pB0[1]; _Pragma("unroll") for(int r=2;r<16;++r)sacc+=pB0[r]; _Pragma("unroll") for(int r=0;r<16;++r)sacc+=pB1[r]; l_reg+=sacc;
    pw0=(u32x4){PKW(pB0,0),PKW(pB0,2),PKW(pB0,4),PKW(pB0,6)};pw1=(u32x4){PKW(pB0,8),PKW(pB0,10),PKW(pB0,12),PKW(pB0,14)};pw2=(u32x4){PKW(pB1,0),PKW(pB1,2),PKW(pB1,4),PKW(pB1,6)};pw3=(u32x4){PKW(pB1,8),PKW(pB1,10),PKW(pB1,12),PKW(pB1,14)};
    SBAR(); pv(o,vb0+sl_cur,PAF(0),PAF(1),PAF(2),PAF(3)); }
  #undef PKW
  #undef PAF
  #undef VFR
  #undef PIN
  #undef MX3
  #undef GAPA
  #undef GAPB
  #undef EX
  #undef VRD
  #undef KRD
  #undef STEP
  #undef ENDW
  {auto rr=__builtin_amdgcn_permlane32_swap(__float_as_uint(l_reg),__float_as_uint(l_reg),false,false);l_reg=__uint_as_float(rr[0])+__uint_as_float(rr[1]);}
  if(hi==0)wsf[32+r32]=l_reg;asm volatile("s_waitcnt lgkmcnt(0)":::"memory");
  float rli[16];
  #pragma unroll
  for(int r=0;r<16;++r)rli[r]=__builtin_amdgcn_rcpf(wsf[32+crow(r,hi)]);
  bf16*Ow=O+(rowbase+q0+wid*QBLK)*OP+h*D;
  { bf16*stg=(bf16*)(shm+LDS_OST)+wid*2048;
    #pragma unroll
    for(int r=0;r<16;++r){const int orow=crow(r,hi);
      #pragma unroll
      for(int d0=0;d0<2;++d0)stg[orow*64+d0*32+r32]=__float2bfloat16(o[d0][r]*rli[r]);}
    asm volatile("s_waitcnt lgkmcnt(0)":::"memory");
    #pragma unroll
    for(int i=0;i<4;++i){const int row=i*8+(lane>>3),ch=lane&7; const u32x4 v=*(const u32x4*)(stg+row*64+ch*8); ATTN_STORE16(Ow+(long)row*OP+ch*8,v);
      float q=0.f; { const unsigned w4[4]={v.x,v.y,v.z,v.w};
        #pragma unroll
        for(int k=0;k<4;++k){const float a=__uint_as_float(w4[k]<<16),b2=__uint_as_float(w4[k]&0xffff0000u); q+=a*a+b2*b2;} }
      q+=__builtin_bit_cast(float,__builtin_amdgcn_update_dpp(0,__builtin_bit_cast(int,q),0xB1,0xF,0xF,true));
      q+=__builtin_bit_cast(float,__builtin_amdgcn_update_dpp(0,__builtin_bit_cast(int,q),0x4E,0xF,0xF,true));
      q+=__builtin_bit_cast(float,__builtin_amdgcn_update_dpp(0,__builtin_bit_cast(int,q),0x141,0xF,0xF,true));
      if(ch==0)SS[(rowbase+q0+wid*QBLK+row)*8+h]=q; } }
  asm volatile("s_waitcnt lgkmcnt(0)\n\ts_barrier":::"memory");
  #undef DMA_K
  #undef DMA_V
  #undef CMASK
  #undef START
  #undef RESC
  #undef ROT
}
constexpr int ATTN_LDS_BYTES=LDS_BYTES;
struct AttnTensors { const bf16* Q; const bf16* K; const bf16* V; bf16* O; float* SS; };
struct AttnUnit { int b, h, kvh, qb; };
struct StaticOrder {
  int vcu, G;
  __device__ __forceinline__ explicit StaticOrder(int grid,int block):vcu((grid%8==0)?(block%8)*(grid/8)+block/8:block),G(grid){}
  __device__ __forceinline__ bool next(int i,AttnUnit&u)const{ const int id=vcu+i*G; const int per=NQB*BATCH*NKV; if(id>=4*per)return false;
    const int hq=id/per, rem=id%per, bk=rem/NQB; u.qb=rem%NQB; u.b=bk/NKV; u.kvh=bk%NKV; u.h=u.kvh*4+hq; return true; }
  __device__ __forceinline__ void a_ready(const AttnUnit&)const{}
  __device__ __forceinline__ void done(const AttnUnit&)const{}
};
template<class Sched,int THRL=8> __device__ __forceinline__ void attn_phase(char*lds,const AttnTensors&T,const Sched&S,float cb){
  AttnUnit u;
  for(int i=0;S.next(i,u);++i){ S.a_ready(u); attn_unit<THRL>(cb,u.b,u.h,u.kvh,u.qb,T.Q,T.K,T.V,T.O,T.SS,lds); S.done(u); }
}
#undef SBAR
#undef WAIT_BAR
}

namespace attn8 {
typedef int v8i __attribute__((ext_vector_type(8)));
using f32x16 = __attribute__((ext_vector_type(16))) float;
using u32x4 = __attribute__((ext_vector_type(4))) unsigned;
typedef __attribute__((address_space(3))) const unsigned char* lds_cptr;
constexpr int SEQ = 8192, QB = 256, NQB = SEQ / QB, KVT = 64, NT = SEQ / KVT, OP = 1024;
constexpr int NSLOT = 8, SLOTB = 8192, LDS_OST = NSLOT * SLOTB, LDS_BYTES = LDS_OST + 8 * 4096;
__device__ __forceinline__ int crow(int r, int hi) { return (r & 3) + 8 * (r >> 2) + 4 * hi; }
__device__ __forceinline__ unsigned f2bf_rne(float f) { const unsigned u = __float_as_uint(f); return (u + 0x7fffu + ((u >> 16) & 1u)) >> 16; }
__host__ __device__ __forceinline__ int kpos(int kappa) { return 32 * ((kappa >> 2) & 1) + 16 * (kappa >> 5) + (kappa & 3) + 4 * ((kappa & 31) >> 3); }
__device__ __forceinline__ void glds16(const void* gsrc, unsigned lds_dst) { unsigned keep;
    asm volatile("s_mov_b32 %0, m0\n\ts_mov_b32 m0, %2\n\ts_nop 0\n\tglobal_load_lds_dwordx4 %1, off\n\ts_mov_b32 m0, %0" : "=&s"(keep) : "v"(gsrc), "s"(lds_dst) : "memory"); }
#define A8_MFMA(a, b, c) __builtin_amdgcn_mfma_scale_f32_32x32x64_f8f6f4(a, b, c, 0, 0, 0, 0x7F7F7F7F, 0, 0x7F7F7F7F)
struct Tensors { const unsigned char* Q8; const unsigned char* K8; const unsigned char* V8T; unsigned short* O; float* SS; };

__device__ __forceinline__ void unit(float cb8, int b, int h, int kvh, int qb, const Tensors& T, char* shm) {
    const int tid = threadIdx.x, lane = tid & 63, r32 = lane & 31, hi = lane >> 5; const int wid = __builtin_amdgcn_readfirstlane(tid >> 6);
    const long rowbase = (long)b * SEQ; const int q0 = qb * QB;
    const unsigned lds0 = (unsigned)(uintptr_t)shm;
    const int prow = 16 * (wid & 3) + (lane >> 2), pch = (lane & 3) ^ ((prow >> 2) & 3);
    const unsigned char* src = (wid < 4) ? T.K8 + (size_t)(rowbase + prow) * 128 + kvh * 64 + pch * 16
                                         : T.V8T + ((size_t)((b * 2 + kvh) * 64 + prow)) * SEQ + pch * 16;
    const long tstep = (wid < 4) ? (long)KVT * 128 : (long)KVT;
    const unsigned dst0 = lds0 + (wid < 4 ? 0 : 4096) + (wid & 3) * 1024;
#define A8_DMA(t, slot) glds16(src + (long)(t) * tstep, (unsigned)__builtin_amdgcn_readfirstlane(dst0 + (slot) * SLOTB))
    A8_DMA(0, 0); A8_DMA(1, 1); A8_DMA(2, 2);
    v8i qv; { const unsigned char* qp = T.Q8 + (size_t)(rowbase + q0 + wid * 32 + r32) * 512 + h * 64 + 32 * hi;
              const u32x4 a = *(const u32x4*)qp, c = *(const u32x4*)(qp + 16); qv = (v8i){(int)a.x, (int)a.y, (int)a.z, (int)a.w, (int)c.x, (int)c.y, (int)c.z, (int)c.w}; }
    const int f = (r32 >> 2) & 3;
    const int o0 = r32 * 64 + 16 * ((2 * hi) ^ f), o1 = r32 * 64 + 16 * ((2 * hi + 1) ^ f);
    const lds_cptr sh3 = (lds_cptr)shm;
    f32x16 negc, O0 = f32x16{}, O1 = f32x16{};
#pragma unroll
    for (int r = 0; r < 16; ++r) negc[r] = -cb8;
    f32x16 L = f32x16{}; v8i ones = {0x38383838, 0x38383838, 0x38383838, 0x38383838, 0x38383838, 0x38383838, 0x38383838, 0x38383838};
    asm volatile("" : "+v"(ones));
#define A8_FRAG(p, blk) ({ const u32x4 x_ = *(const __attribute__((address_space(3))) u32x4*)((p) + (blk) * 2048 + o0), y_ = *(const __attribute__((address_space(3))) u32x4*)((p) + (blk) * 2048 + o1); \
                           (v8i){(int)x_.x, (int)x_.y, (int)x_.z, (int)x_.w, (int)y_.x, (int)y_.y, (int)y_.z, (int)y_.w}; })
#define A8_SB __builtin_amdgcn_sched_barrier(0)
#define A8_E(S, r) S[r] = __builtin_amdgcn_exp2f(S[r])
#define A8_C(PW, w, S, d) { PW[w] = __builtin_amdgcn_cvt_pk_fp8_f32(S[4 * (d)], S[4 * (d) + 1], PW[w], false); PW[w] = __builtin_amdgcn_cvt_pk_fp8_f32(S[4 * (d) + 2], S[4 * (d) + 3], PW[w], true); }
#define A8_ITER(t, SA0, SA1, SB0, SB1, PW, PR, PV) { \
        asm volatile("s_waitcnt vmcnt(1) lgkmcnt(0)\n\ts_barrier" ::: "memory");        \
        { const int tn = (t) + 3 < NT ? (t) + 3 : NT - 1; A8_DMA(tn, ((t) + 3) & (NSLOT - 1)); }     \
        const lds_cptr kn = sh3 + (((t) + 1) & (NSLOT - 1)) * SLOTB, vb = sh3 + (((t) + NSLOT - 1) & (NSLOT - 1)) * SLOTB + 4096; \
        const v8i k0 = A8_FRAG(kn, 0), k1 = A8_FRAG(kn, 1); v8i v0 = k0, v1 = k1; if (PV) { v0 = A8_FRAG(vb, 0); v1 = A8_FRAG(vb, 1); } \
        A8_SB; A8_E(SA0, 0); A8_E(SA0, 1); A8_E(SA0, 2); A8_E(SA0, 3); A8_E(SA0, 4); A8_E(SA0, 5); A8_SB; \
        SB0 = A8_MFMA(k0, qv, negc); A8_SB; \
        A8_E(SA0, 6); A8_E(SA0, 7); A8_E(SA0, 8); A8_E(SA0, 9); A8_E(SA0, 10); A8_E(SA0, 11); A8_E(SA0, 12); A8_SB; \
        SB1 = A8_MFMA(k1, qv, negc); A8_SB; \
        A8_E(SA0, 13); A8_E(SA0, 14); A8_E(SA0, 15); A8_E(SA1, 0); A8_E(SA1, 1); A8_E(SA1, 2); A8_E(SA1, 3); A8_SB; \
        if (PV) O0 = A8_MFMA(v0, PR, O0); A8_SB; \
        A8_E(SA1, 4); A8_E(SA1, 5); A8_E(SA1, 6); A8_E(SA1, 7); A8_E(SA1, 8); A8_E(SA1, 9); A8_SB; \
        if (PV) O1 = A8_MFMA(v1, PR, O1); A8_SB; \
        A8_E(SA1, 10); A8_E(SA1, 11); A8_E(SA1, 12); A8_E(SA1, 13); A8_E(SA1, 14); A8_E(SA1, 15); A8_C(PW, 0, SA0, 0); A8_C(PW, 1, SA0, 1); A8_SB; \
        if (PV) L = A8_MFMA(ones, PR, L); A8_SB; \
        A8_C(PW, 2, SA0, 2); A8_C(PW, 3, SA0, 3); A8_C(PW, 4, SA1, 0); A8_C(PW, 5, SA1, 1); A8_C(PW, 6, SA1, 2); A8_C(PW, 7, SA1, 3); A8_SB; }
    asm volatile("s_waitcnt vmcnt(2) lgkmcnt(0)\n\ts_barrier" ::: "memory");
    f32x16 Sa0, Sa1, Sb0, Sb1; v8i pA = {0, 0, 0, 0, 0, 0, 0, 0}, pB = {0, 0, 0, 0, 0, 0, 0, 0};
    { const v8i k0 = A8_FRAG(sh3, 0), k1 = A8_FRAG(sh3, 1); Sa0 = A8_MFMA(k0, qv, negc); Sa1 = A8_MFMA(k1, qv, negc); }
    A8_ITER(0, Sa0, Sa1, Sb0, Sb1, pA, pB, false);
    A8_ITER(1, Sb0, Sb1, Sa0, Sa1, pB, pA, true);
    for (int t = 2; t < NT; t += 2) {
        A8_ITER(t, Sa0, Sa1, Sb0, Sb1, pA, pB, true);
        A8_ITER(t + 1, Sb0, Sb1, Sa0, Sa1, pB, pA, true);
    }
    { const lds_cptr vb = sh3 + ((NT - 1) & (NSLOT - 1)) * SLOTB + 4096; const v8i v0 = A8_FRAG(vb, 0), v1 = A8_FRAG(vb, 1);
      O0 = A8_MFMA(v0, pB, O0); O1 = A8_MFMA(v1, pB, O1); L = A8_MFMA(ones, pB, L); }
#undef A8_ITER
#undef A8_C
#undef A8_E
#undef A8_SB
    const float rl = 1.0f / (8.0f * L[0]);
    unsigned short* stg = (unsigned short*)(shm + LDS_OST) + wid * 2048;
#pragma unroll
    for (int r = 0; r < 16; ++r) { const int d = crow(r, hi);
        stg[r32 * 64 + d] = (unsigned short)(f2bf_rne(O0[r] * rl)); stg[r32 * 64 + 32 + d] = (unsigned short)(f2bf_rne(O1[r] * rl)); }
    asm volatile("s_waitcnt lgkmcnt(0)" ::: "memory");
    unsigned short* Ow = T.O + (rowbase + q0 + wid * 32) * OP + h * 64;
#pragma unroll
    for (int i = 0; i < 4; ++i) { const int row = i * 8 + (lane >> 3), ch = lane & 7; const u32x4 v = *(const u32x4*)(stg + row * 64 + ch * 8); *(u32x4*)(Ow + (long)row * OP + ch * 8) = v;
        float q = 0.f; { const unsigned w4[4] = {v.x, v.y, v.z, v.w};
#pragma unroll
            for (int k = 0; k < 4; ++k) { const float a = __uint_as_float(w4[k] << 16), b2 = __uint_as_float(w4[k] & 0xffff0000u); q += a * a + b2 * b2; } }
        q += __builtin_bit_cast(float, __builtin_amdgcn_update_dpp(0, __builtin_bit_cast(int, q), 0xB1, 0xF, 0xF, true));
        q += __builtin_bit_cast(float, __builtin_amdgcn_update_dpp(0, __builtin_bit_cast(int, q), 0x4E, 0xF, 0xF, true));
        q += __builtin_bit_cast(float, __builtin_amdgcn_update_dpp(0, __builtin_bit_cast(int, q), 0x141, 0xF, 0xF, true));
        if (ch == 0) T.SS[(rowbase + q0 + wid * 32 + row) * 8 + h] = q; }
    asm volatile("s_waitcnt vmcnt(0) lgkmcnt(0)\n\ts_barrier" ::: "memory");
#undef A8_DMA
#undef A8_FRAG
}
__device__ __forceinline__ void phase(char* lds, const Tensors& T, int grid, int block, float cb8) {
    const int vcu = (grid % 8 == 0) ? (block % 8) * (grid / 8) + block / 8 : block;
    for (int id = vcu; id < 4 * NQB * 8; id += grid) {
        const int per = NQB * 8, hq = id / per, rem = id % per, bk = rem / NQB, qb = rem % NQB, b = bk / 2, kvh = bk % 2;
        unit(cb8, b, kvh * 4 + hq, kvh, qb, T, lds);
    }
}
#undef A8_MFMA
}

namespace natten {
using bf16x8 = __attribute__((ext_vector_type(8))) short;
using s16x4 = __attribute__((ext_vector_type(4))) short;
using f32x4 = __attribute__((ext_vector_type(4))) float;
using u32x4 = __attribute__((ext_vector_type(4))) unsigned;
using u32x2 = __attribute__((ext_vector_type(2))) unsigned;
typedef unsigned short bf16_t;
typedef __attribute__((address_space(3))) unsigned char* lds_ptr;
typedef short v4i16_t __attribute__((ext_vector_type(4)));
constexpr int SEQ = 8192, GW = 64, ROWS = 128, PP = 2304, OP = 1024, KH = 8, KW = 16;
constexpr int LDS_K = 0, LDS_V = 9 * 64 * 128, LDS_BIAS = 2 * LDS_V, LDS_BYTES = LDS_BIAS + 15 * 64 * 4;
__device__ __forceinline__ int clampi(int v, int lo, int hi) { return v < lo ? lo : (v > hi ? hi : v); }
__device__ __forceinline__ unsigned cvtpk(float lo, float hi) { unsigned r; asm volatile("v_cvt_pk_bf16_f32 %0, %1, %2" : "=v"(r) : "v"(lo), "v"(hi)); return r; }
__device__ __forceinline__ s16x4 vtr(const __attribute__((address_space(3))) unsigned char* p) { return __builtin_bit_cast(s16x4, __builtin_amdgcn_ds_read_tr16_b64_v4i16((__attribute__((address_space(3))) v4i16_t*)p)); }

__device__ __forceinline__ int win_lo(int rp) { return clampi(2 * rp - 4, 0, ROWS - KH); }
__device__ __forceinline__ int win_hi(int rp) { const int lo = win_lo(rp); return lo + ((ROWS - lo) < 9 ? (ROWS - lo) : 9) - 1; }
__device__ __forceinline__ void stage_chunk(lds_ptr lds, int row, int col, int c, bool isv, u32x4 v) {
    const int s = row % 9;
    if (!isv) *(__attribute__((address_space(3))) u32x4*)(lds + LDS_K + s * 8192 + col * 128 + 16 * (c ^ ((col >> 1) & 7))) = v;
    else      *(__attribute__((address_space(3))) u32x4*)(lds + LDS_V + s * 8192 + col * 128 + 32 * ((c >> 1) ^ ((col >> 1) & 3)) + 16 * (c & 1)) = v;
}
__device__ __forceinline__ void natten_block(int b, int h, int rp0, int nun, const bf16_t* Qb, const bf16_t* Kb, const bf16_t* Vb, const float* rpb, bf16_t* O, float* SS, lds_ptr lds) {
    const int tid = threadIdx.x, lane = tid & 63, wid = __builtin_amdgcn_readfirstlane(tid >> 6);
    for (int n = tid; n < 15 * 64; n += 512) {
        const int dr = n >> 6, x = (n & 63) - 16;
        const float v = (x >= 0 && x < 31) ? rpb[(h * 15 + dr) * 31 + x] * 1.4426950408889634f : 0.f;
        *(__attribute__((address_space(3))) float*)(lds + LDS_BIAS + n * 4) = v;
    }
    int have_hi = win_hi(rp0);
    { const int lo = win_lo(rp0), nr = have_hi - lo + 1;
      for (int n = tid; n < nr * 1024; n += 512) {
          const int r = n >> 10, m = n & 1023, isv = m >> 9, col = (m & 511) >> 3, c = m & 7;
          const size_t tokk = (size_t)b * SEQ + (size_t)(lo + r) * GW + col;
          stage_chunk(lds, lo + r, col, c, isv, *(const u32x4*)((isv ? Vb : Kb) + tokk * PP + h * 64 + c * 8));
      } }
    __syncthreads();
    const int g = lane >> 4, i16 = lane & 15, q4 = i16 >> 2, p4 = lane & 3;
    for (int u = 0; u < nun; ++u) {
        const int rp = rp0 + u;
        u32x4 pf[4]; int nnew = 0;
        if (u + 1 < nun) { nnew = win_hi(rp + 1) - have_hi;
#pragma unroll
            for (int i = 0; i < 4; ++i) { const int n = tid + 512 * i; const int r = n >> 10, m = n & 1023, isv = m >> 9, col = (m & 511) >> 3, c = m & 7;
                if (r < nnew) { const size_t tokk = (size_t)b * SEQ + (size_t)(have_hi + 1 + r) * GW + col; pf[i] = *(const u32x4*)((isv ? Vb : Kb) + tokk * PP + h * 64 + c * 8); } } }
        const int rq = 2 * rp + (wid >> 2), c0 = 16 * (wid & 3), cw = clampi(c0 - 8, 0, 32), rs = clampi(rq - 4, 0, ROWS - KH);
        const int cq = c0 + i16, csq = clampi(cq - 8, 0, GW - KW);
        const size_t tok = (size_t)b * SEQ + (size_t)rq * GW + cq;
        bf16x8 qf[2];
#pragma unroll
        for (int ks = 0; ks < 2; ++ks) qf[ks] = *(const bf16x8*)(Qb + tok * PP + h * 64 + 32 * ks + 8 * g);
        const int swk = ((cw + i16) >> 1) & 7;
        const lds_ptr kp0 = lds + LDS_K + (cw + i16) * 128 + 16 * ((0 + g) ^ swk);
        const lds_ptr kp1 = lds + LDS_K + (cw + i16) * 128 + 16 * ((4 + g) ^ swk);
        int sl[8];
#pragma unroll
        for (int j = 0; j < 8; ++j) sl[j] = ((rs + j) % 9) * 8192;
        f32x4 s[16];
#pragma unroll
        for (int kb = 0; kb < 16; ++kb) {
            const int off = sl[kb >> 1] + (16 * (kb & 1)) * 128;
            const bf16x8 a0 = *(const __attribute__((address_space(3))) bf16x8*)(kp0 + off);
            const bf16x8 a1 = *(const __attribute__((address_space(3))) bf16x8*)(kp1 + off);
            f32x4 z = {0.f, 0.f, 0.f, 0.f};
            z = __builtin_amdgcn_mfma_f32_16x16x32_bf16(a0, qf[0], z, 0, 0, 0);
            s[kb] = __builtin_amdgcn_mfma_f32_16x16x32_bf16(a1, qf[1], z, 0, 0, 0);
        }
        const lds_ptr bp = lds + LDS_BIAS + ((rs - rq + 7) * 64 + (cw + 4 * g - cq + 31)) * 4;
        bool ok[2][4];
#pragma unroll
        for (int hh = 0; hh < 2; ++hh)
#pragma unroll
            for (int r = 0; r < 4; ++r) ok[hh][r] = (unsigned)(cw + 16 * hh + 4 * g + r - csq) < 16u;
        float mx = -3.0e38f;
#pragma unroll
        for (int kb = 0; kb < 16; ++kb)
#pragma unroll
            for (int r = 0; r < 4; ++r) {
                const float bias = *(const __attribute__((address_space(3))) float*)(bp + ((kb >> 1) * 64 + 16 * (kb & 1) + r) * 4);
                const float v = ok[kb & 1][r] ? s[kb][r] + bias : -3.0e38f;
                s[kb][r] = v; mx = fmaxf(mx, v);
            }
        mx = fmaxf(mx, __shfl_xor(mx, 16)); mx = fmaxf(mx, __shfl_xor(mx, 32));
        float l = 0.f;
#pragma unroll
        for (int kb = 0; kb < 16; ++kb)
#pragma unroll
            for (int r = 0; r < 4; ++r) { const float p = __builtin_amdgcn_exp2f(s[kb][r] - mx); s[kb][r] = p; l += p; }
        l += __shfl_xor(l, 16); l += __shfl_xor(l, 32);
        const int swv = (2 * g + (q4 >> 1)) & 3;
        lds_ptr vp[4];
#pragma unroll
        for (int db = 0; db < 4; ++db) vp[db] = lds + LDS_V + (cw + 4 * g + q4) * 128 + 32 * (db ^ swv) + 8 * p4;
        f32x4 o[4];
#pragma unroll
        for (int db = 0; db < 4; ++db) o[db] = (f32x4){0.f, 0.f, 0.f, 0.f};
#pragma unroll
        for (int kk = 0; kk < 8; ++kk) {
            u32x4 pw; pw.x = cvtpk(s[2 * kk][0], s[2 * kk][1]); pw.y = cvtpk(s[2 * kk][2], s[2 * kk][3]); pw.z = cvtpk(s[2 * kk + 1][0], s[2 * kk + 1][1]); pw.w = cvtpk(s[2 * kk + 1][2], s[2 * kk + 1][3]);
            const bf16x8 pb = __builtin_bit_cast(bf16x8, pw);
#pragma unroll
            for (int db = 0; db < 4; ++db) {
                const s16x4 lo = vtr(vp[db] + sl[kk]), hi = vtr(vp[db] + sl[kk] + 16 * 128);
                const bf16x8 a = (bf16x8){lo[0], lo[1], lo[2], lo[3], hi[0], hi[1], hi[2], hi[3]};
                o[db] = __builtin_amdgcn_mfma_f32_16x16x32_bf16(a, pb, o[db], 0, 0, 0);
            }
        }
        const float rl = 1.0f / l;
        bf16_t* op = O + tok * OP + 512 + h * 64 + 4 * g;
        float qs = 0.f;
#pragma unroll
        for (int db = 0; db < 4; ++db) { u32x2 w; w.x = cvtpk(o[db][0] * rl, o[db][1] * rl); w.y = cvtpk(o[db][2] * rl, o[db][3] * rl); *(u32x2*)(op + 16 * db) = w;
            const float a0 = __uint_as_float(w.x << 16), a1 = __uint_as_float(w.x & 0xffff0000u), a2 = __uint_as_float(w.y << 16), a3 = __uint_as_float(w.y & 0xffff0000u); qs += (a0 * a0 + a1 * a1) + (a2 * a2 + a3 * a3); }
        qs += __shfl_xor(qs, 16); qs += __shfl_xor(qs, 32);
        if (g == 0) SS[tok * 8 + h] = qs;
        __syncthreads();
        if (u + 1 < nun) {
#pragma unroll
            for (int i = 0; i < 4; ++i) { const int n = tid + 512 * i; const int r = n >> 10, m = n & 1023, isv = m >> 9, col = (m & 511) >> 3, c = m & 7;
                if (r < nnew) stage_chunk(lds, have_hi + 1 + r, col, c, isv, pf[i]); }
            have_hi += nnew;
            __syncthreads();
        }
    }
}
__device__ __forceinline__ void natten_phase(lds_ptr lds, const bf16_t* Qb, const bf16_t* Kb, const bf16_t* Vb, const float* rpb, bf16_t* O, float* SS, int vcu, int G) {
    for (int it = vcu; it < 256; it += G) { natten_block(it >> 6, (it >> 3) & 7, (it & 7) * 8, 8, Qb, Kb, Vb, rpb, O, SS, lds); __syncthreads(); }
}
}

namespace peer {
using bf16x8 = __attribute__((ext_vector_type(8))) short;
using f32x4 = __attribute__((ext_vector_type(4))) float;
using u32x4 = __attribute__((ext_vector_type(4))) unsigned;
typedef unsigned short bf16_t;
typedef __bf16 bf16x2_t __attribute__((ext_vector_type(2)));
typedef __attribute__((address_space(3))) unsigned char* lds_ptr;
constexpr int LDS_SK = 0, LDS_TAB = 65536, LDS_WV = LDS_TAB + 256, LDS_BYTES = LDS_WV + 8 * 4096;
constexpr float LOG2E = 1.4426950408889634f;

#define PEER_CE(a, b) do { const float hi_ = fmaxf(a, b), lo_ = fminf(a, b); a = hi_; b = lo_; } while (0)
template <int N, bool DESC> __device__ __forceinline__ void bitonic_sort(float (&v)[N]) {
#pragma unroll
    for (int k = 2; k <= N; k <<= 1)
#pragma unroll
        for (int j = k >> 1; j > 0; j >>= 1)
#pragma unroll
            for (int i = 0; i < N; ++i) { const int l = i ^ j; if (l > i) { const bool d = (((i & k) == 0) == DESC); if (d) PEER_CE(v[i], v[l]); else PEER_CE(v[l], v[i]); } }
}
template <bool DESC> __device__ __forceinline__ void oem_sort16(float (&v)[16]) {
#pragma unroll
    for (int p = 1; p < 16; p <<= 1)
#pragma unroll
        for (int k = p; k >= 1; k >>= 1)
#pragma unroll
            for (int j = k % p; j <= 15 - k; j += 2 * k)
#pragma unroll
                for (int i = 0; i < k; ++i) { if (i <= 15 - j - k && ((i + j) / (2 * p) == (i + j + k) / (2 * p))) { if (DESC) PEER_CE(v[i + j], v[i + j + k]); else PEER_CE(v[i + j + k], v[i + j]); } }
}
__device__ __forceinline__ void bitonic_merge16_desc(float (&v)[16]) {
#pragma unroll
    for (int j = 8; j > 0; j >>= 1)
#pragma unroll
        for (int i = 0; i < 16; ++i) { const int l = i ^ j; if (l > i) PEER_CE(v[i], v[l]); }
}
__device__ __forceinline__ void xlane_merge16(float (&v)[16], int mask) {
    float t[16];
#pragma unroll
    for (int i = 0; i < 16; ++i) t[i] = fmaxf(v[i], __shfl_xor(v[15 - i], mask));
#pragma unroll
    for (int i = 0; i < 16; ++i) v[i] = t[i];
    bitonic_merge16_desc(v);
}
__device__ __forceinline__ float gelu_erf(float v) {
    const float av = fabsf(v), t = 1.0f / (1.0f + 0.2316418882f * av);
    float q = t * 0.5307027145f + (-0.7265760135f); q = q * t + 0.7107068705f; q = q * t + (-0.142248368f); q = q * t + 0.127414796f; q = q * t;
    const float e = __builtin_amdgcn_exp2f((v * v) * (-0.72134752044f));
    const float m = v * (q * e);
    return v < 0.f ? m : v - m;
}
__device__ __forceinline__ float dot8(u32x4 a, u32x4 b, float acc) {
    typedef __bf16 bf16x8_t __attribute__((ext_vector_type(8)));
    const bf16x8_t va = __builtin_bit_cast(bf16x8_t, a), vb = __builtin_bit_cast(bf16x8_t, b);
    acc = __builtin_amdgcn_fdot2_f32_bf16((bf16x2_t){va[0], va[1]}, (bf16x2_t){vb[0], vb[1]}, acc, false);
    acc = __builtin_amdgcn_fdot2_f32_bf16((bf16x2_t){va[2], va[3]}, (bf16x2_t){vb[2], vb[3]}, acc, false);
    acc = __builtin_amdgcn_fdot2_f32_bf16((bf16x2_t){va[4], va[5]}, (bf16x2_t){vb[4], vb[5]}, acc, false);
    acc = __builtin_amdgcn_fdot2_f32_bf16((bf16x2_t){va[6], va[7]}, (bf16x2_t){vb[6], vb[7]}, acc, false);
    return acc;
}
__device__ __forceinline__ float blo(unsigned w) { return __uint_as_float(w << 16); }
__device__ __forceinline__ float bhi(unsigned w) { return __uint_as_float(w & 0xffff0000u); }

struct PeerArgs {
    const bf16_t* PQ;
    const bf16_t* SK;
    const bf16_t* H2;
    const unsigned char* U; const unsigned char* V;
    const float* US; const float* VS;
    int* eidx; float* egate2; float* wts;
    const bf16_t* xin; float* xout;
    const float* mod;
    const float* fg;
};

__device__ __forceinline__ void route16(const PeerArgs& A, lds_ptr lds, int tok0, int wid, int lane) {
    const int g = lane >> 4, i16 = lane & 15;
    const lds_ptr wv = lds + LDS_WV + wid * 4096;
    const bf16_t* qrow = A.PQ + (size_t)(tok0 + i16) * 2048;
    bf16x8 qn[4];
#pragma unroll
    for (int ks = 0; ks < 4; ++ks) qn[ks] = *(const bf16x8*)(qrow + 32 * ks + 8 * g);
    for (int h = 0; h < 8; ++h) {
        if (((h ^ (wid >> 2)) & 1) != 0) __builtin_amdgcn_s_setprio(1); else __builtin_amdgcn_s_setprio(0);
        float top[2][16];
#pragma unroll
        for (int half = 0; half < 2; ++half) {
            bf16x8 qf[4];
#pragma unroll
            for (int ks = 0; ks < 4; ++ks) qf[ks] = qn[ks];
            { const int nx = (2 * h + half + 1) & 15;
#pragma unroll
              for (int ks = 0; ks < 4; ++ks) qn[ks] = *(const bf16x8*)(qrow + nx * 128 + 32 * ks + 8 * g); }
            float v[32];
#pragma unroll
            for (int kb = 0; kb < 8; ++kb) {
                f32x4 s = {0.f, 0.f, 0.f, 0.f};
#pragma unroll
                for (int ks = 0; ks < 4; ++ks) {
                    const int row = 16 * kb + i16, c = 4 * ks + g;
                    const bf16x8 a = *(const __attribute__((address_space(3))) bf16x8*)(lds + LDS_SK + half * 32768 + row * 256 + 16 * (c ^ i16));
                    s = __builtin_amdgcn_mfma_f32_16x16x32_bf16(a, qf[ks], s, 0, 0, 0);
                }
#pragma unroll
                for (int r = 0; r < 4; ++r) v[4 * kb + r] = __uint_as_float((__float_as_uint(s[r]) & ~127u) | (unsigned)(16 * kb + 4 * g + r));
            }
            float a16[16], b16[16];
#pragma unroll
            for (int i = 0; i < 16; ++i) { a16[i] = v[i]; b16[i] = v[16 + i]; }
            oem_sort16<true>(a16); oem_sort16<false>(b16);
#pragma unroll
            for (int i = 0; i < 16; ++i) a16[i] = fmaxf(a16[i], b16[i]);
            bitonic_merge16_desc(a16);
            xlane_merge16(a16, 16); xlane_merge16(a16, 32);
#pragma unroll
            for (int i = 0; i < 16; ++i) top[half][i] = a16[i];
        }
        if (g == 0) {
#pragma unroll
            for (int i = 0; i < 16; ++i) { *(__attribute__((address_space(3))) float*)(wv + (i16 * 32 + i) * 4) = top[0][i]; *(__attribute__((address_space(3))) float*)(wv + (i16 * 32 + 16 + i) * 4) = top[1][i]; }
        }
        float cs[16];
#pragma unroll
        for (int j = 0; j < 16; ++j) {
            constexpr int A1[16] = {1, 1, 1, 1, 1, 1, 1, 1, 4, 4, 4, 5, 5, 8, 9, 10}, B1[16] = {0, 1, 2, 3, 4, 5, 6, 7, 0, 1, 2, 0, 1, 0, 0, 0};
            constexpr int A2[16] = {2, 2, 2, 2, 2, 3, 3, 3, 3, 6, 6, 7, 7, 11, 12, 13}, B2[16] = {0, 1, 2, 3, 4, 0, 1, 2, 3, 0, 1, 0, 1, 0, 0, 0};
            constexpr int A3[16] = {14, 15, 0, 0, 0, 0, 0, 0, 0, 0, 0, 0, 0, 0, 0, 0};
            const float x1 = g == 0 ? top[0][0] : (g == 1 ? top[0][A1[j]] : (g == 2 ? top[0][A2[j]] : top[0][A3[j]]));
            const float x2 = g == 0 ? top[1][j] : (g == 1 ? top[1][B1[j]] : (g == 2 ? top[1][B2[j]] : top[1][0]));
            float sm = __uint_as_float(__float_as_uint(x1) & ~127u) + __uint_as_float(__float_as_uint(x2) & ~127u);
            if (g == 3 && j >= 2) sm = -3.0e38f;
            cs[j] = __uint_as_float((__float_as_uint(sm) & ~63u) | (unsigned)(g * 16 + j));
        }
        oem_sort16<true>(cs);
        xlane_merge16(cs, 16); xlane_merge16(cs, 32);
        float mxs = __uint_as_float(__float_as_uint(cs[0]) & ~63u);
        float val[4]; int ex[4]; float es = 0.f;
#pragma unroll
        for (int k = 0; k < 4; ++k) {
            const float e = g == 0 ? cs[k] : (g == 1 ? cs[4 + k] : (g == 2 ? cs[8 + k] : cs[12 + k]));
            const unsigned slot = __float_as_uint(e) & 63u;
            const unsigned ab = *(const __attribute__((address_space(3))) unsigned char*)(lds + LDS_TAB + slot);
            const unsigned p1 = __float_as_uint(*(const __attribute__((address_space(3))) float*)(wv + (i16 * 32 + (ab >> 4)) * 4));
            const unsigned p2 = __float_as_uint(*(const __attribute__((address_space(3))) float*)(wv + (i16 * 32 + 16 + (ab & 15)) * 4));
            ex[k] = (int)((p1 & 127u) * 128u + (p2 & 127u));
            val[k] = __builtin_amdgcn_exp2f((__uint_as_float(p1 & ~127u) + __uint_as_float(p2 & ~127u) - mxs) * LOG2E);
            es += val[k];
        }
        es += __shfl_xor(es, 16); es += __shfl_xor(es, 32);
        const float ri = 1.0f / es;
        int* ep = A.eidx + (size_t)(tok0 + i16) * 128 + h * 16 + 4 * g;
        float* gp = A.egate2 + ((size_t)(tok0 + i16) * 128 + h * 16 + 4 * g) * 2;
        *(int4*)ep = make_int4(ex[0], ex[1], ex[2], ex[3]);
        *(float4*)gp = make_float4(A.US[ex[0]], val[0] * ri * A.VS[ex[0]], A.US[ex[1]], val[1] * ri * A.VS[ex[1]]);
        *(float4*)(gp + 4) = make_float4(A.US[ex[2]], val[2] * ri * A.VS[ex[2]], A.US[ex[3]], val[3] * ri * A.VS[ex[3]]);
    }
    __builtin_amdgcn_s_setprio(0);
}

typedef float f32x2 __attribute__((ext_vector_type(2)));
__device__ __forceinline__ float row16_sum(float x) {
    x += __builtin_bit_cast(float, __builtin_amdgcn_update_dpp(0, __builtin_bit_cast(int, x), 0xB1, 0xF, 0xF, true));
    x += __builtin_bit_cast(float, __builtin_amdgcn_update_dpp(0, __builtin_bit_cast(int, x), 0x4E, 0xF, 0xF, true));
    x += __builtin_bit_cast(float, __builtin_amdgcn_update_dpp(0, __builtin_bit_cast(int, x), 0x141, 0xF, 0xF, true));
    x += __builtin_bit_cast(float, __builtin_amdgcn_update_dpp(0, __builtin_bit_cast(int, x), 0x140, 0xF, 0xF, true));
    return x;
}
__device__ __forceinline__ f32x2 dot16_fp8(u32x4 w, const f32x2 (&h)[8], f32x2 acc) {
    acc += __builtin_amdgcn_cvt_pk_f32_fp8(w.x, false) * h[0]; acc += __builtin_amdgcn_cvt_pk_f32_fp8(w.x, true) * h[1];
    acc += __builtin_amdgcn_cvt_pk_f32_fp8(w.y, false) * h[2]; acc += __builtin_amdgcn_cvt_pk_f32_fp8(w.y, true) * h[3];
    acc += __builtin_amdgcn_cvt_pk_f32_fp8(w.z, false) * h[4]; acc += __builtin_amdgcn_cvt_pk_f32_fp8(w.z, true) * h[5];
    acc += __builtin_amdgcn_cvt_pk_f32_fp8(w.w, false) * h[6]; acc += __builtin_amdgcn_cvt_pk_f32_fp8(w.w, true) * h[7];
    return acc;
}
__device__ __forceinline__ void axpy16_fp8(u32x4 v, float wt, f32x2 (&acc)[8]) {
    const f32x2 w2 = {wt, wt};
    acc[0] += w2 * __builtin_amdgcn_cvt_pk_f32_fp8(v.x, false); acc[1] += w2 * __builtin_amdgcn_cvt_pk_f32_fp8(v.x, true);
    acc[2] += w2 * __builtin_amdgcn_cvt_pk_f32_fp8(v.y, false); acc[3] += w2 * __builtin_amdgcn_cvt_pk_f32_fp8(v.y, true);
    acc[4] += w2 * __builtin_amdgcn_cvt_pk_f32_fp8(v.z, false); acc[5] += w2 * __builtin_amdgcn_cvt_pk_f32_fp8(v.z, true);
    acc[6] += w2 * __builtin_amdgcn_cvt_pk_f32_fp8(v.w, false); acc[7] += w2 * __builtin_amdgcn_cvt_pk_f32_fp8(v.w, true);
}
typedef unsigned v6u __attribute__((ext_vector_type(6)));
typedef float v32f __attribute__((ext_vector_type(32)));
typedef __bf16 v32bf __attribute__((ext_vector_type(32)));
typedef unsigned u32x2 __attribute__((ext_vector_type(2)));
__device__ __forceinline__ float dot32_bf16(v32bf c, u32x4 h0, u32x4 h1, u32x4 h2, u32x4 h3, float acc) {
    typedef __bf16 bf16x8_t __attribute__((ext_vector_type(8)));
    const bf16x8_t a0 = __builtin_bit_cast(bf16x8_t, h0), a1 = __builtin_bit_cast(bf16x8_t, h1), a2 = __builtin_bit_cast(bf16x8_t, h2), a3 = __builtin_bit_cast(bf16x8_t, h3);
#pragma unroll
    for (int i = 0; i < 4; ++i) {
        acc = __builtin_amdgcn_fdot2_f32_bf16((bf16x2_t){c[2 * i], c[2 * i + 1]}, (bf16x2_t){a0[2 * i], a0[2 * i + 1]}, acc, false);
        acc = __builtin_amdgcn_fdot2_f32_bf16((bf16x2_t){c[8 + 2 * i], c[8 + 2 * i + 1]}, (bf16x2_t){a1[2 * i], a1[2 * i + 1]}, acc, false);
        acc = __builtin_amdgcn_fdot2_f32_bf16((bf16x2_t){c[16 + 2 * i], c[16 + 2 * i + 1]}, (bf16x2_t){a2[2 * i], a2[2 * i + 1]}, acc, false);
        acc = __builtin_amdgcn_fdot2_f32_bf16((bf16x2_t){c[24 + 2 * i], c[24 + 2 * i + 1]}, (bf16x2_t){a3[2 * i], a3[2 * i + 1]}, acc, false);
    }
    return acc;
}
__device__ __forceinline__ float udot64(u32x4 p0, u32x4 p1, u32x4 p2, const u32x4 (&hp)[8]) {
    const v6u ga = {p0.x, p0.y, p0.z, p0.w, p1.x, p1.y}, gb = {p1.z, p1.w, p2.x, p2.y, p2.z, p2.w};
    const v32bf ca = __builtin_amdgcn_cvt_scalef32_pk32_bf16_fp6(ga, 1.0f), cb = __builtin_amdgcn_cvt_scalef32_pk32_bf16_fp6(gb, 1.0f);
    float d = dot32_bf16(ca, hp[0], hp[1], hp[2], hp[3], 0.f);
    return dot32_bf16(cb, hp[4], hp[5], hp[6], hp[7], d);
}
__device__ __forceinline__ void upass_token(const PeerArgs& A, int tok, int lane) {
    const int e4 = lane >> 4, l16 = lane & 15;
    u32x4 hp[8];
#pragma unroll
    for (int k = 0; k < 8; ++k) hp[k] = *(const u32x4*)(A.H2 + (size_t)tok * 1024 + 64 * l16 + 8 * k);
    const int2* ei = (const int2*)(A.eidx + (size_t)tok * 128 + e4 * 32); const f32x4* eg = (const f32x4*)(A.egate2 + ((size_t)tok * 128 + e4 * 32) * 2); float* wo = A.wts + (size_t)tok * 128 + e4 * 32;
    const unsigned char* ub = A.U + l16 * 16;
    int2 id[5]; u32x4 buf[3][6]; f32x4 gs[3];
#define U_IDS(st) do { id[(st) % 5] = ei[(st)]; } while (0)
#define U_GATHER(st) do { const unsigned char* pa = ub + (size_t)id[(st) % 5].x * 768; const unsigned char* pb = ub + (size_t)id[(st) % 5].y * 768; \
        buf[(st) % 3][0] = *(const u32x4*)pa; buf[(st) % 3][1] = *(const u32x4*)(pa + 256); buf[(st) % 3][2] = *(const u32x4*)(pa + 512); \
        buf[(st) % 3][3] = *(const u32x4*)pb; buf[(st) % 3][4] = *(const u32x4*)(pb + 256); buf[(st) % 3][5] = *(const u32x4*)(pb + 512); gs[(st) % 3] = eg[(st)]; } while (0)
    U_IDS(0); U_IDS(1); U_IDS(2); U_IDS(3);
    U_GATHER(0); U_GATHER(1);
#pragma unroll
    for (int st = 0; st < 16; ++st) {
        if (st + 4 < 16) U_IDS(st + 4);
        if (st + 2 < 16) U_GATHER(st + 2);
        const f32x4 g = gs[st % 3];
        const float ta = row16_sum(udot64(buf[st % 3][0], buf[st % 3][1], buf[st % 3][2], hp)) * g[0];
        const float tb = row16_sum(udot64(buf[st % 3][3], buf[st % 3][4], buf[st % 3][5], hp)) * g[2];
        if (l16 == 0) *(f32x2*)(wo + 2 * st) = (f32x2){gelu_erf(ta) * g[1], gelu_erf(tb) * g[3]};
    }
#undef U_IDS
#undef U_GATHER
}
__device__ __forceinline__ int grab(lds_ptr cnt, int lane) {
    int t = 0;
    if (lane == 0) t = __hip_atomic_fetch_add((__attribute__((address_space(3))) int*)cnt, 1, __ATOMIC_RELAXED, __HIP_MEMORY_SCOPE_WORKGROUP);
    return __builtin_amdgcn_readfirstlane(t);
}
template <bool DYN> __device__ __forceinline__ void vpass_wave(const PeerArgs& A, int tok0, int tstride, int ntok, int lane, lds_ptr cnt = nullptr) {
    const int hw = lane >> 5, l32 = lane & 31;
    const unsigned char* vb = A.V + l32 * 16; const unsigned char* vc = A.V + 512 + l32 * 8;
    int4 id[4]; f32x4 wg[4]; u32x4 p0[4][4]; u32x2 p1[4][4];
#define V_EI(t) ((const int4*)(A.eidx + (size_t)(t) * 128 + hw * 64))
#define V_WI(t) ((const f32x4*)(A.wts + (size_t)(t) * 128 + hw * 64))
#define V_IDS(t, gr) do { id[(gr) % 4] = V_EI(t)[(gr) % 16]; wg[(gr) % 4] = V_WI(t)[(gr) % 16]; } while (0)
#define V_GATHER(gr) do { const int4 t_ = id[(gr) % 4]; \
        p0[(gr) % 4][0] = *(const u32x4*)(vb + (size_t)t_.x * 768); p1[(gr) % 4][0] = *(const u32x2*)(vc + (size_t)t_.x * 768); \
        p0[(gr) % 4][1] = *(const u32x4*)(vb + (size_t)t_.y * 768); p1[(gr) % 4][1] = *(const u32x2*)(vc + (size_t)t_.y * 768); \
        p0[(gr) % 4][2] = *(const u32x4*)(vb + (size_t)t_.z * 768); p1[(gr) % 4][2] = *(const u32x2*)(vc + (size_t)t_.z * 768); \
        p0[(gr) % 4][3] = *(const u32x4*)(vb + (size_t)t_.w * 768); p1[(gr) % 4][3] = *(const u32x2*)(vc + (size_t)t_.w * 768); } while (0)
    int cur = 0, nxt = 1;
    if (DYN) { cur = grab(cnt, lane); if (cur >= ntok) return; nxt = grab(cnt, lane); tok0 += cur; }
    V_IDS(tok0, 0); V_IDS(tok0, 1); V_IDS(tok0, 2);
    V_GATHER(0); V_GATHER(1);
    int tokd = tok0;
    for (int t = 0; DYN || t < ntok; ++t) {
        const int tok = DYN ? tokd : tok0 + t * tstride, tokn = DYN ? (nxt < ntok ? tok - cur + nxt : tok) : ((t + 1 < ntok) ? tok + tstride : tok);
        v32f acc;
#pragma unroll
        for (int i = 0; i < 32; ++i) acc[i] = 0.f;
#pragma unroll
        for (int gr = 0; gr < 16; ++gr) {
            V_GATHER(gr + 2);
            const f32x4 w = wg[gr % 4];
            if (gr + 3 < 16) V_IDS(tok, gr + 3); else V_IDS(tokn, gr + 3);
#pragma unroll
            for (int k = 0; k < 4; ++k) {
                const v6u g = {p0[gr % 4][k].x, p0[gr % 4][k].y, p0[gr % 4][k].z, p0[gr % 4][k].w, p1[gr % 4][k].x, p1[gr % 4][k].y};
                const v32f c = __builtin_amdgcn_cvt_scalef32_pk32_f32_fp6(g, 1.0f);
                acc += c * w[k];
            }
        }
#pragma unroll
        for (int i = 0; i < 32; ++i) acc[i] += __shfl_xor(acc[i], 32);
        float f[16];
#pragma unroll
        for (int i = 0; i < 16; ++i) f[i] = hw ? acc[16 + i] : acc[i];
        const int b = tok >> 13, col = 32 * l32 + 16 * hw;
        const bf16_t* xr = A.xin + (size_t)tok * 1024 + col; float* xo = A.xout + (size_t)tok * 1024 + col; const float* g2 = A.mod + b * 6144 + 5120 + col; const float* fgp = A.fg + col;
        float y[16]; float ss = 0.f;
        { const u32x4 xa = *(const u32x4*)xr, xb = *(const u32x4*)(xr + 8);
          y[0] = blo(xa.x); y[1] = bhi(xa.x); y[2] = blo(xa.y); y[3] = bhi(xa.y); y[4] = blo(xa.z); y[5] = bhi(xa.z); y[6] = blo(xa.w); y[7] = bhi(xa.w);
          y[8] = blo(xb.x); y[9] = bhi(xb.x); y[10] = blo(xb.y); y[11] = bhi(xb.y); y[12] = blo(xb.z); y[13] = bhi(xb.z); y[14] = blo(xb.w); y[15] = bhi(xb.w); }
#pragma unroll
        for (int q = 0; q < 4; ++q) {
            const f32x4 gv = *(const f32x4*)(g2 + 4 * q);
#pragma unroll
            for (int i = 0; i < 4; ++i) { y[4 * q + i] = y[4 * q + i] + gv[i] * f[4 * q + i]; ss += y[4 * q + i] * y[4 * q + i]; }
        }
#pragma unroll
        for (int o = 1; o < 64; o <<= 1) ss += __shfl_xor(ss, o);
        const float rinv = 1.0f / sqrtf(ss * (1.0f / 1024.0f) + 1e-6f);
#pragma unroll
        for (int q = 0; q < 4; ++q) {
            const f32x4 fv = *(const f32x4*)(fgp + 4 * q); f32x4 o;
#pragma unroll
            for (int i = 0; i < 4; ++i) o[i] = y[4 * q + i] * rinv * fv[i];
            *(f32x4*)(xo + 4 * q) = o;
        }
        if (DYN) { if (nxt >= ntok) break; tokd = tokn; cur = nxt; nxt = grab(cnt, lane); }
    }
#undef V_EI
#undef V_WI
#undef V_IDS
#undef V_GATHER
}

__device__ __forceinline__ void peer_phase(lds_ptr lds, const PeerArgs& A, int vcu, int G, int wid) {
    const int lane = (int)__builtin_amdgcn_mbcnt_hi(~0u, __builtin_amdgcn_mbcnt_lo(~0u, 0u)), tid = wid * 64 + lane;
    for (int n = tid; n < 2 * 128 * 16; n += 512) {
        const int tb = n >> 11, row = (n >> 4) & 127, c = n & 15;
        *(__attribute__((address_space(3))) u32x4*)(lds + LDS_SK + tb * 32768 + row * 256 + 16 * (c ^ (row & 15))) = *(const u32x4*)(A.SK + (size_t)tb * 16384 + row * 128 + c * 8);
    }
    if (tid < 64) {
        const unsigned long long A1 = 0xA985544411111111ull, B1 = 0x0001021076543210ull, A2 = 0xDCB7766333322222ull, B2 = 0x0001010321043210ull;
        const int gq = tid >> 4, j = tid & 15; int a = 0, b = 0;
        if (gq == 0) { a = 0; b = j; } else if (gq == 1) { a = (int)((A1 >> (4 * j)) & 15); b = (int)((B1 >> (4 * j)) & 15); } else if (gq == 2) { a = (int)((A2 >> (4 * j)) & 15); b = (int)((B2 >> (4 * j)) & 15); } else { a = j == 0 ? 14 : 15; b = 0; }
        *(__attribute__((address_space(3))) unsigned char*)(lds + LDS_TAB + tid) = (unsigned char)((a << 4) | b);
    }
    __syncthreads();
    const lds_ptr cU = lds + 160 * 1024 - 256 + 24 * 4, cV = cU + 4;
    for (int task_ = vcu; task_ < 256; task_ += G) {
        const int task = __builtin_amdgcn_readfirstlane(task_);
        if (tid == 0) { *(__attribute__((address_space(3))) int*)cU = 0; *(__attribute__((address_space(3))) int*)cV = 0; }
        const int tok0 = task * 128 + wid * 16;
        { int ln_ = lane; asm volatile("" : "+v"(ln_)); route16(A, lds, tok0, wid, ln_); }
        int lane2 = lane;
        asm volatile("s_waitcnt vmcnt(0) lgkmcnt(0)" : "+v"(lane2) :: "memory");
        __syncthreads();
        for (int t = grab(cU, lane2); t < 128; t = grab(cU, lane2)) upass_token(A, task * 128 + t, lane2);
        asm volatile("s_waitcnt vmcnt(0)" ::: "memory");
        __syncthreads();
        vpass_wave<true>(A, task * 128, 1, 128, lane2, cV);
        __syncthreads();
    }
}
__device__ __forceinline__ void peer_vphase_local(const PeerArgs& A, int vcu, int G) {
    const int lane = threadIdx.x & 63, wid = __builtin_amdgcn_readfirstlane(threadIdx.x >> 6);
    asm volatile("s_waitcnt vmcnt(0)" ::: "memory");
    for (int task = vcu; task < 256; task += G) vpass_wave<false>(A, task * 128 + wid * 16, 1, 16, lane);
}
__device__ __forceinline__ void peer_vphase(const PeerArgs& A, int vcu, int G) {
    const int lane = threadIdx.x & 63, wid = __builtin_amdgcn_readfirstlane(threadIdx.x >> 6);
    { const int w0 = vcu * 8 + wid, nw = G * 8; if (w0 < 32768) vpass_wave<false>(A, w0, nw, (32768 - w0 + nw - 1) / nw, lane); }
}
#undef PEER_CE
}

constexpr int NWAVES = 8;
#ifndef MK_N_LAUNCHES
#define MK_N_LAUNCHES 1
#endif
constexpr int PER_PHASE = 10;
constexpr int N_LAUNCHES = MK_N_LAUNCHES;

constexpr int BATCH = 4, T = 8192, D = 1024, M = BATCH * T, NIN = 2304, NPQ = 2048, NEXP = 16384;
constexpr float EPS = 1e-6f;
constexpr float C2 = 0.125f * 1.4426950408889634f;

constexpr size_t MiB = 1u << 20;
constexpr size_t WS_CTL = 0, CTL_ZERO_BYTES = 1 * MiB;
constexpr size_t WS_TAB = 1 * MiB;
constexpr size_t WS_WIN = 2 * MiB, WS_WOUT = 8 * MiB, WS_WQ = 10 * MiB, WS_SK = 14 * MiB;
constexpr size_t WS_U = 16 * MiB, WS_V = 32 * MiB;
constexpr size_t WS_US = 48 * MiB, WS_VS = 49 * MiB, WS_XS = 50 * MiB  ;
constexpr size_t WS_H = 80 * MiB;
constexpr size_t WS_P = 144 * MiB;
constexpr size_t WS_O = 288 * MiB;
constexpr size_t WS_EI = 352 * MiB, WS_EG = 368 * MiB  , WS_EW = 400 * MiB, WS_SSA = 416 * MiB, WS_SSB = 417 * MiB, WS_X1 = 420 * MiB, WS_END = 484 * MiB;
constexpr size_t WS_Q8 = 420 * MiB, WS_K8 = 436 * MiB, WS_V8T = 440 * MiB;
constexpr int CW_BAR = 4096;
constexpr int CW_PCNT = 8192;
constexpr int CW_MOD = 131072;

constexpr int LDS_BYTES = 160 * 1024;
constexpr int MISC_OFF = LDS_BYTES - 256;

#define GAS __attribute__((address_space(1)))
#define LAS __attribute__((address_space(3)))
typedef unsigned short bf16;
typedef unsigned v4u __attribute__((ext_vector_type(4)));
typedef float f32x4 __attribute__((ext_vector_type(4)));
typedef GAS unsigned gu32;
#define RLX_AGENT __ATOMIC_RELAXED, __HIP_MEMORY_SCOPE_AGENT
#define LDS_WAIT() asm volatile("s_waitcnt lgkmcnt(0)" ::: "memory")
__device__ __forceinline__ unsigned f2bf(float f) { unsigned u = __builtin_bit_cast(unsigned, f); return (u + 0x7fffu + ((u >> 16) & 1u)) >> 16; }
__device__ __forceinline__ unsigned pk2(float lo, float hi) { return f2bf(lo) | (f2bf(hi) << 16); }

#define XB_TMO      128
#define XB_XCNT(j)  (256  + 64 * (j))
#define XB_XSUB(j)  (1280 + 64 * (j))
#define XB_XGEN(j)  (2304 + 64 * (j))
#define XB_TOP      3328
#define XB_TOPGEN   3392
#define XCD_BAR_WORDS 3456
#define XB_SPIN_CAP (1u << 20)

__device__ __forceinline__ unsigned xb_ld(unsigned* p)              { return __hip_atomic_load(p, __ATOMIC_RELAXED, __HIP_MEMORY_SCOPE_AGENT); }
__device__ __forceinline__ unsigned xb_add(unsigned* p, unsigned v) { return __hip_atomic_fetch_add(p, v, __ATOMIC_RELAXED, __HIP_MEMORY_SCOPE_AGENT); }
__device__ __forceinline__ unsigned xb_xcc_id() { return (unsigned)__builtin_amdgcn_s_getreg((3 << 11) | 20) & 0xFu; }
#define XB_SPIN(cond, bar) do { unsigned _sp = 0; while (cond) { __builtin_amdgcn_s_sleep(1); \
    if ((++_sp & 255u) == 0u) { if (xb_ld(&(bar)[XB_TMO])) break; if (_sp > XB_SPIN_CAP) { atomicAdd(&(bar)[XB_TMO], 1u); break; } } } } while (0)

struct XcdBarrier { unsigned* bar; unsigned x; volatile LAS unsigned* st; };

__device__ __forceinline__ XcdBarrier xcd_barrier_post(unsigned* bar, volatile LAS unsigned* st) {
    XcdBarrier b; b.bar = bar; b.x = xb_xcc_id(); b.st = st;
    if (threadIdx.x == 0) (void)xb_add(&bar[XB_XCNT(b.x)], 1u);
    return b;
}
__device__ __forceinline__ void xcd_barrier_complete(unsigned* bar, unsigned x, unsigned& nloc, unsigned& nx) {
    const unsigned G = gridDim.x * gridDim.y * gridDim.z;
    unsigned sum, cnt, mine, sp = 0u;
    for (;;) {
        sum = 0u; cnt = 0u; mine = 0u;
#pragma unroll
        for (unsigned j = 0; j < 16; ++j) { const unsigned c = xb_ld(&bar[XB_XCNT(j)]); sum += c; cnt += (c > 0u) ? 1u : 0u; mine = (j == x) ? c : mine; }
        if (sum == G) break;
        __builtin_amdgcn_s_sleep(1);
        if ((++sp & 255u) == 0u) { if (xb_ld(&bar[XB_TMO])) break; if (sp > XB_SPIN_CAP) { atomicAdd(&bar[XB_TMO], 1u); break; } }
    }
    nloc = mine > 0u ? mine : 1u; nx = cnt > 0u ? cnt : 1u;
}
__device__ __forceinline__ void xcd_barrier(const XcdBarrier& b) {
    asm volatile("s_waitcnt vmcnt(0)" ::: "memory");
    __syncthreads();
    if (threadIdx.x == 0) {
        unsigned* bar = b.bar;
        __builtin_amdgcn_s_waitcnt(0);
        unsigned nloc = b.st[0], nx = b.st[1];
        if (nloc == 0u) { xcd_barrier_complete(bar, b.x, nloc, nx); b.st[0] = nloc; b.st[1] = nx; }
        const unsigned old = xb_add(&bar[XB_XSUB(b.x)], 1u);
        const unsigned gen = old / nloc;
        if (old + 1u == (gen + 1u) * nloc) {
            __builtin_amdgcn_fence(__ATOMIC_RELEASE, "agent");
            asm volatile("s_waitcnt vmcnt(0)" ::: "memory");
            const unsigned og = xb_add(&bar[XB_TOP], 1u);
            const unsigned tg = og / nx;
            if (og + 1u == (tg + 1u) * nx) xb_add(&bar[XB_TOPGEN], 1u);
            else XB_SPIN(xb_ld(&bar[XB_TOPGEN]) == tg, bar);
            __builtin_amdgcn_fence(__ATOMIC_ACQUIRE, "agent");
            xb_add(&bar[XB_XGEN(b.x)], 1u);
            asm volatile("s_waitcnt vmcnt(0)" ::: "memory");
        } else {
            XB_SPIN(xb_ld(&bar[XB_XGEN(b.x)]) == gen, bar);
            __builtin_amdgcn_fence(__ATOMIC_ACQUIRE, "agent");
            asm volatile("s_waitcnt vmcnt(0)" ::: "memory");
        }
    }
    __syncthreads();
}

__device__ __forceinline__ float wave_sum(float v) {
#pragma unroll
    for (int o = 1; o < 64; o <<= 1) v += __shfl_xor(v, o);
    return v;
}
template <bool PERMUTE> __device__ __forceinline__ void p0_transpose_item(const float* W, int K, int N, bf16* WT, LAS float* scr, int item, int lane, const float* ks0 = nullptr, const float* ks1 = nullptr) {
    const int nblk = N / 32, kb = item / nblk, nb = item % nblk, k0 = 64 * kb, n0 = 32 * nb;
    int r0 = n0;
    if (PERMUTE) { const int tile = nb >> 3, ob = nb & 7, wc = ob >> 1, bj = ob & 1; r0 = tile * 256 + 32 * (4 * bj + wc); }
#pragma unroll
    for (int i = 0; i < 32; ++i) { const int kk = 2 * i + (lane >> 5); const int kg = k0 + kk; const float sc = ks0 ? (kg < 512 ? ks0[kg] : ks1[kg - 512]) : 1.0f; scr[kk * 33 + (lane & 31)] = W[(size_t)kg * N + n0 + (lane & 31)] * sc; }
    LDS_WAIT(); asm volatile("" ::: "memory");
    const int c = lane & 7;
#pragma unroll
    for (int j = 0; j < 4; ++j) { const int n = (lane >> 3) + 8 * j; const LAS float* s = scr + (8 * c) * 33 + n;
        v4u o; o.x = pk2(s[0 * 33], s[1 * 33]); o.y = pk2(s[2 * 33], s[3 * 33]); o.z = pk2(s[4 * 33], s[5 * 33]); o.w = pk2(s[6 * 33], s[7 * 33]);
        *(GAS v4u*)(WT + (size_t)(r0 + n) * K + k0 + 8 * c) = o; }
    LDS_WAIT(); asm volatile("" ::: "memory");
}
__device__ __forceinline__ void sincos_d(double a, double& s, double& c) {
    const double TWO_PI = 6.283185307179586476925286766559, INV = 0.15915494309189533576888376337251;
    const double k = __builtin_rint(a * INV); const double x = a - k * TWO_PI; const double x2 = x * x;
    double ts = x, tc = 1.0, ss = x, cc = 1.0;
#pragma unroll
    for (int n = 1; n <= 16; ++n) { tc = -tc * x2 / (double)((2 * n - 1) * (2 * n)); ts = -ts * x2 / (double)((2 * n) * (2 * n + 1)); cc += tc; ss += ts; }
    s = ss; c = cc;
}
__device__ __forceinline__ float silu_f(float v) { return v / (1.0f + __expf(-v)); }

struct Ptrs {
    const float *x, *c, *w_ada, *b_ada, *n1g, *w_in, *qng, *kng, *rpb, *gag, *gbg, *w_out, *n2g, *wq, *sk1, *sk2, *pu, *pv, *fng;
    float* out; unsigned char* ws;
};

template <int PART> __device__ __forceinline__ void p0_prologue(const Ptrs& A, LAS unsigned char* lds, int vcu, int G, int wave, int lane, int gw, int NGW) {
    LAS float* scr = (LAS float*)(lds + wave * 16384);
    bf16* Win_t = (bf16*)(A.ws + WS_WIN); bf16* Wout_t = (bf16*)(A.ws + WS_WOUT); bf16* Wq_t = (bf16*)(A.ws + WS_WQ);
    constexpr int I_IN = (D / 64) * (NIN / 32), I_OUT = (D / 64) * (D / 32), I_Q = (D / 64) * (NPQ / 32);
    if (PART == 0) { for (int it = gw; it < I_IN; it += NGW) p0_transpose_item<true>(A.w_in, D, NIN, Win_t, scr, it, lane); }
    else if (PART == 1) { for (int it = gw; it < I_Q; it += NGW) p0_transpose_item<false>(A.wq, D, NPQ, Wq_t, scr, it, lane); }
    else { for (int it = gw; it < I_OUT; it += NGW) p0_transpose_item<false>(A.w_out, D, D, Wout_t, scr, it, lane, A.gag, A.gbg); return; }
    if (PART == 1) {
        typedef float v16f __attribute__((ext_vector_type(16))); typedef unsigned v6u __attribute__((ext_vector_type(6)));
        unsigned char* U6 = A.ws + WS_U; unsigned char* V6 = A.ws + WS_V; float* USc = (float*)(A.ws + WS_US); float* VSc = (float*)(A.ws + WS_VS);
        const int hw = lane >> 5, l32 = lane & 31;
        for (int it = gw; it < NEXP; it += NGW) {
            const int r = 2 * it + hw; const bool isv = r >= NEXP; const int row = isv ? r - NEXP : r;
            const float* src = (isv ? A.pv : A.pu) + (size_t)row * D + l32 * 32;
            f32x4 v[8]; float mx = 0.f;
#pragma unroll
            for (int j = 0; j < 8; ++j) { v[j] = *(const GAS f32x4*)(src + 4 * j); mx = fmaxf(mx, fmaxf(fmaxf(fabsf(v[j][0]), fabsf(v[j][1])), fmaxf(fabsf(v[j][2]), fabsf(v[j][3])))); }
#pragma unroll
            for (int o = 1; o < 32; o <<= 1) mx = fmaxf(mx, __shfl_xor(mx, o));
            const float sc = mx > 0.f ? __uint_as_float(__float_as_uint(7.5f / mx) & 0x7f800000u) : 1.0f;
            v16f a, b;
#pragma unroll
            for (int j = 0; j < 4; ++j)
#pragma unroll
                for (int i = 0; i < 4; ++i) { a[4 * j + i] = v[2 * j + (i >> 1)][2 * (i & 1)] * sc; b[4 * j + i] = v[2 * j + (i >> 1)][2 * (i & 1) + 1] * sc; }
            const v6u q = __builtin_amdgcn_cvt_scalef32_2xpk16_fp6_f32(a, b, 1.0f);
            if (isv) {
                unsigned char* dst = V6 + (size_t)row * 768;
                *(GAS v4u*)(dst + 16 * l32) = (v4u){q[0], q[1], q[2], q[3]};
                *(GAS unsigned long long*)(dst + 512 + 8 * l32) = (unsigned long long)q[4] | ((unsigned long long)q[5] << 32);
            } else {
                unsigned char* dst = U6 + (size_t)row * 768 + 16 * (l32 >> 1);
                if ((l32 & 1) == 0) { *(GAS v4u*)dst = (v4u){q[0], q[1], q[2], q[3]}; *(GAS unsigned long long*)(dst + 256) = (unsigned long long)q[4] | ((unsigned long long)q[5] << 32); }
                else { *(GAS unsigned long long*)(dst + 256 + 8) = (unsigned long long)q[0] | ((unsigned long long)q[1] << 32); *(GAS v4u*)(dst + 512) = (v4u){q[2], q[3], q[4], q[5]}; }
            }
            if (l32 == 0) (isv ? VSc : USc)[row] = 1.0f / sc;
        }
        bf16* SKb = (bf16*)(A.ws + WS_SK);
        for (int it = gw; it < 64; it += NGW) {
            const float* src = it < 32 ? A.sk1 : A.sk2; const int r = it & 31;
            const size_t e = (size_t)r * 512 + lane * 8;
            const f32x4 a = *(const GAS f32x4*)(src + e), b = *(const GAS f32x4*)(src + e + 4);
            v4u o; o.x = pk2(a[0], a[1]); o.y = pk2(a[2], a[3]); o.z = pk2(b[0], b[1]); o.w = pk2(b[2], b[3]);
            *(GAS v4u*)(SKb + (it < 32 ? 0 : 16384) + e) = o;
        }
    }
    if (PART == 0) {
        float* rc = (float*)(A.ws + WS_TAB); float* rs = rc + 128 * 16;
        const int gt = gw * 64 + lane;
        if (gt < 128 * 16) {
            const int pos = gt >> 4, i = gt & 15;
            const double f4[4] = {1.0, 0.56234132519034908039495103977648, 0.31622776601683793319988935444327, 0.17782794100389228012254211951927};
            double fr = (i & 3) == 0 ? f4[0] : ((i & 3) == 1 ? f4[1] : ((i & 3) == 2 ? f4[2] : f4[3]));
            fr *= (i >> 2) == 0 ? 1.0 : ((i >> 2) == 1 ? 0.1 : ((i >> 2) == 2 ? 0.01 : 0.001));
            double s, c; sincos_d((double)pos * fr, s, c);
            rc[gt] = (float)c; rs[gt] = (float)s;
        }
    }
    if (PART == 0) {
        float* mod = (float*)(A.ws + WS_CTL) + CW_MOD;
        LAS float* part = (LAS float*)(lds + 131072);
        LAS float* sc_l = (LAS float*)(lds + 131072 + 8192);
        if (vcu < 96) { for (int i = threadIdx.x; i < 4096; i += 512) sc_l[i] = silu_f(A.c[i]); __syncthreads(); }
        for (int it = vcu; it < 96; it += G) {
            const int col = it * 64 + lane;
            float acc[4] = {0.f, 0.f, 0.f, 0.f};
#pragma unroll 16
            for (int k = 0; k < 128; ++k) {
                const int kk = wave * 128 + k;
                const float w = A.w_ada[(size_t)kk * 6144 + col];
#pragma unroll
                for (int b = 0; b < 4; ++b) acc[b] += w * sc_l[b * 1024 + kk];
            }
#pragma unroll
            for (int b = 0; b < 4; ++b) part[(wave * 4 + b) * 64 + lane] = acc[b];
            __syncthreads();
            if (wave < 4) {
                float s = A.b_ada[col];
#pragma unroll
                for (int w8 = 0; w8 < 8; ++w8) s += part[(w8 * 4 + wave) * 64 + lane];
                mod[wave * 6144 + col] = s;
            }
            __syncthreads();
        }
    }
}
__device__ __forceinline__ void modnorm_row(const float* xrow, const float* g, const float* shift, const float* scale, bf16* orow, int lane) {
    const GAS f32x4* xr = (const GAS f32x4*)xrow + lane;
    f32x4 v[4]; float s = 0.f;
#pragma unroll
    for (int j = 0; j < 4; ++j) { v[j] = xr[64 * j]; s += (v[j].x * v[j].x + v[j].y * v[j].y) + (v[j].z * v[j].z + v[j].w * v[j].w); }
    const float rinv = 1.0f / sqrtf(wave_sum(s) * (1.0f / D) + EPS);
    GAS unsigned long long* o8 = (GAS unsigned long long*)orow + lane;
#pragma unroll
    for (int j = 0; j < 4; ++j) {
        const f32x4 gv = *((const f32x4*)g + lane + 64 * j), sh = *((const f32x4*)shift + lane + 64 * j), sc = *((const f32x4*)scale + lane + 64 * j);
        const f32x4 y = v[j] * rinv * gv * (sc + 1.0f) + sh;
        o8[64 * j] = (unsigned long long)pk2(y.x, y.y) | ((unsigned long long)pk2(y.z, y.w) << 32);
    }
}
__device__ __forceinline__ void modnorm_row_b(const bf16* xrow, const float* g, const float* shift, const float* scale, bf16* orow, int lane) {
    float f[2][8]; float s = 0.f;
#pragma unroll
    for (int j = 0; j < 2; ++j) { const v4u w = *(const GAS v4u*)(xrow + 512 * j + lane * 8);
        f[j][0] = __uint_as_float(w.x << 16); f[j][1] = __uint_as_float(w.x & 0xffff0000u); f[j][2] = __uint_as_float(w.y << 16); f[j][3] = __uint_as_float(w.y & 0xffff0000u);
        f[j][4] = __uint_as_float(w.z << 16); f[j][5] = __uint_as_float(w.z & 0xffff0000u); f[j][6] = __uint_as_float(w.w << 16); f[j][7] = __uint_as_float(w.w & 0xffff0000u);
#pragma unroll
        for (int i = 0; i < 8; ++i) s += f[j][i] * f[j][i]; }
    const float rinv = 1.0f / sqrtf(wave_sum(s) * (1.0f / D) + EPS);
#pragma unroll
    for (int j = 0; j < 2; ++j) { const int c = 512 * j + lane * 8; float y[8];
#pragma unroll
        for (int q = 0; q < 2; ++q) { const f32x4 gv = *(const f32x4*)(g + c + 4 * q), sh = *(const f32x4*)(shift + c + 4 * q), sc = *(const f32x4*)(scale + c + 4 * q);
#pragma unroll
            for (int i = 0; i < 4; ++i) y[4 * q + i] = f[j][4 * q + i] * rinv * gv[i] * (sc[i] + 1.0f) + sh[i]; }
        v4u o; o.x = pk2(y[0], y[1]); o.y = pk2(y[2], y[3]); o.z = pk2(y[4], y[5]); o.w = pk2(y[6], y[7]);
        *(GAS v4u*)(orow + c) = o; }
}
__device__ __forceinline__ void groupnorm_row(const bf16* orow, const float* ga, const float* gb, bf16* mrow, int lane) {
#pragma unroll
    for (int j = 0; j < 2; ++j) {
        const v4u w = *(const GAS v4u*)(orow + 512 * j + lane * 8);
        float f[8]; f[0] = __uint_as_float(w.x << 16); f[1] = __uint_as_float(w.x & 0xffff0000u); f[2] = __uint_as_float(w.y << 16); f[3] = __uint_as_float(w.y & 0xffff0000u);
        f[4] = __uint_as_float(w.z << 16); f[5] = __uint_as_float(w.z & 0xffff0000u); f[6] = __uint_as_float(w.w << 16); f[7] = __uint_as_float(w.w & 0xffff0000u);
        float s = 0.f;
#pragma unroll
        for (int i = 0; i < 8; ++i) s += f[i] * f[i];
        const float rinv = 1.0f / sqrtf(wave_sum(s) * (1.0f / 512.0f) + EPS);
        const float* gp = (j ? gb : ga) + lane * 8;
        const f32x4 g0 = *(const f32x4*)gp, g1 = *(const f32x4*)(gp + 4);
        v4u o; o.x = pk2(f[0] * rinv * g0[0], f[1] * rinv * g0[1]); o.y = pk2(f[2] * rinv * g0[2], f[3] * rinv * g0[3]); o.z = pk2(f[4] * rinv * g1[0], f[5] * rinv * g1[1]); o.w = pk2(f[6] * rinv * g1[2], f[7] * rinv * g1[3]);
        *(GAS v4u*)(mrow + 512 * j + lane * 8) = o;
    }
}

struct Args { Ptrs p; int ph_lo, ph_hi; };
__global__ void __launch_bounds__(NWAVES * 64, 2) hymba_fwd(Args args) {
    extern __shared__ __attribute__((aligned(16))) unsigned char lds_raw[];
    LAS unsigned char* lds = (LAS unsigned char*)lds_raw;
    volatile LAS unsigned* MISC = (volatile LAS unsigned*)(lds + MISC_OFF);
    const Ptrs& A = args.p;
    const int tid = threadIdx.x, lane = tid & 63, wave = __builtin_amdgcn_readfirstlane(tid >> 6);
    const int G = gridDim.x; const int bx = blockIdx.x; const int vcu = (G % 8 == 0) ? (bx % 8) * (G / 8) + bx / 8 : bx;
    gu32* ctl = (gu32*)(A.ws + WS_CTL);
    if (tid < 64) MISC[tid] = 0u;
    __syncthreads();
    XcdBarrier bar; bar.bar = (unsigned*)(ctl + CW_BAR); bar.x = 0; bar.st = nullptr;
    if (N_LAUNCHES != PER_PHASE) bar = xcd_barrier_post((unsigned*)(ctl + CW_BAR), MISC + 8);
#define GRID_BAR() do { if (N_LAUNCHES != PER_PHASE) xcd_barrier(bar); } while (0)
    const int lo = args.ph_lo, hi = args.ph_hi;
#define IN(k) (lo <= (k) && (k) < hi)
#define BOTH(k) (IN(k) && IN((k) + 1))
    const float* mod = (const float*)(A.ws + WS_CTL) + CW_MOD;
    bf16* Hb = (bf16*)(A.ws + WS_H); bf16* Pb = (bf16*)(A.ws + WS_P); bf16* Ob = (bf16*)(A.ws + WS_O);
    const int gw = vcu * NWAVES + wave, NGW = G * NWAVES;

    if (IN(0)) { p0_prologue<0>(A, lds, vcu, G, wave, lane, gw, NGW); if (BOTH(0)) GRID_BAR(); }
    if (IN(1)) {
        for (int m = gw; m < M; m += NGW) { const float* md = mod + (m >> 13) * 6144; modnorm_row(A.x + (size_t)m * D, A.n1g, md, md + 1024, Hb + (size_t)m * D, lane); }
        if (BOTH(1)) GRID_BAR();
    }
    if (IN(2)) {
        pg8::Gemm g{Hb, (const bf16*)(A.ws + WS_WIN), M, NIN, D}; pg8::StaticOrder S; S.init(M, NIN, G, bx);
        { const float* tab = (const float*)(A.ws + WS_TAB); LAS float* tl = (LAS float*)(lds + 131072);
          for (int i = tid; i < 2 * 128 * 16; i += NWAVES * 64) tl[i] = tab[i];
          __syncthreads(); }
        pg8::EpiInProj E{Pb, A.ws + WS_Q8, A.ws + WS_K8, A.ws + WS_V8T, A.qng, A.kng, (const LAS float*)(lds + 131072), (const LAS float*)(lds + 131072) + 128 * 16, C2};
        pg8::gemm_phase<pg8::EpiInProj, pg8::StaticOrder, true, true>(lds, g, S, E);
        {
            const int nunits = (M / 256) * (NIN / 256), rounds = (nunits + G - 1) / G, busy = nunits - (rounds - 1) * G, nidle = G - busy;
            __syncthreads();
            if (nidle == 0) { p0_prologue<1>(A, lds, vcu, G, wave, lane, bx * NWAVES + wave, G * NWAVES); p0_prologue<2>(A, lds, vcu, G, wave, lane, bx * NWAVES + wave, G * NWAVES); }
            else if (bx >= busy) p0_prologue<1>(A, lds, vcu, G, wave, lane, (bx - busy) * NWAVES + wave, nidle * NWAVES);
            else if (wave < 4) p0_prologue<2>(A, lds, vcu, G, wave, lane, bx * 4 + wave, busy * 4);
        }
        if (BOTH(2)) GRID_BAR();
    }
    if (IN(3)) {
        float cb; { const float gq = fabsf(A.qng[lane]), gk = fabsf(A.kng[lane]); float mq = gq, mk = gk;
#pragma unroll
            for (int o = 1; o < 64; o <<= 1) { mq = fmaxf(mq, __shfl_xor(mq, o)); mk = fmaxf(mk, __shfl_xor(mk, o)); }
            cb = 8.0f * 1.4426950408889634f * mq * mk; }
        const attn8::Tensors AT{A.ws + WS_Q8, A.ws + WS_K8, A.ws + WS_V8T, Ob, (float*)(A.ws + WS_SSA)};
        attn8::phase((char*)lds_raw, AT, G, bx, cb - 8.0f);
        __syncthreads();
        natten::natten_phase(lds, Pb + 768, Pb + 1280, Pb + 1792, A.rpb, Ob, (float*)(A.ws + WS_SSB), vcu, G);
        if (BOTH(3)) GRID_BAR();
    }
    if (IN(5)) {
        pg8::Gemm g{Ob, (const bf16*)(A.ws + WS_WOUT), M, D, D}; pg8::StaticOrder S; S.init(M, D, G, bx);
        pg8::EpiX1N E{A.x, (bf16*)(A.ws + WS_X1), Hb, mod, A.n2g, (const float*)(A.ws + WS_SSA), (const float*)(A.ws + WS_SSB), (LAS float*)(lds + 131072), (unsigned*)(A.ws + WS_XS), (unsigned*)(ctl + CW_PCNT)};
        E.prep(S);
        pg8::gemm_phase<pg8::EpiX1N, pg8::StaticOrder, true, true>(lds, g, S, E);
        if (BOTH(5)) GRID_BAR();
    }
    if (IN(7)) {
        pg8::Gemm g{Hb, (const bf16*)(A.ws + WS_WQ), M, NPQ, D}; pg8::StaticOrder S; S.init(M, NPQ, G, bx);
        pg8::EpiBf16 E{Pb, NPQ};
        pg8::gemm_phase<pg8::EpiBf16, pg8::StaticOrder, true, true>(lds, g, S, E);
        if (BOTH(7)) GRID_BAR();
    }
    if (IN(8) || IN(9)) {
        peer::PeerArgs PA{Pb, (const bf16*)(A.ws + WS_SK), Hb, A.ws + WS_U, A.ws + WS_V, (const float*)(A.ws + WS_US), (const float*)(A.ws + WS_VS), (int*)(A.ws + WS_EI), (float*)(A.ws + WS_EG), (float*)(A.ws + WS_EW), (const bf16*)(A.ws + WS_X1), A.out, mod, A.fng};
        if (IN(8)) peer::peer_phase(lds, PA, vcu, G, wave);
    }
#undef IN
#undef BOTH
#undef GRID_BAR
}

extern "C" void kernel_launch(void* const* d_in, const int* in_sizes, int n_in, void* d_out, int out_size, void* d_ws, size_t ws_size, hipStream_t stream) {
    static int grid = 0;
    if (grid == 0) {
        if (n_in != 19 || in_sizes[0] != M * D || out_size != M * D || ws_size < WS_END) { fprintf(stderr, "kernel_launch: unexpected problem shape (n_in %d, in0 %d, out %d, ws %zu); nothing launched\n", n_in, n_in > 0 ? in_sizes[0] : -1, out_size, ws_size); grid = -1; return; }
        int dev = 0, cus = 0, per_cu = 0;
        if (hipGetDevice(&dev) != hipSuccess || hipDeviceGetAttribute(&cus, hipDeviceAttributeMultiprocessorCount, dev) != hipSuccess) { grid = -1; return; }
        if (hipFuncSetAttribute((const void*)hymba_fwd, hipFuncAttributeMaxDynamicSharedMemorySize, LDS_BYTES) != hipSuccess) { fprintf(stderr, "kernel_launch: hipFuncSetAttribute failed\n"); grid = -1; return; }
        if (hipOccupancyMaxActiveBlocksPerMultiprocessor(&per_cu, (const void*)hymba_fwd, NWAVES * 64, LDS_BYTES) != hipSuccess || per_cu < 1) { fprintf(stderr, "kernel_launch: occupancy query reports %d workgroups per CU; nothing launched\n", per_cu); (void)hipGetLastError(); grid = -1; return; }
        grid = cus;
    }
    if (grid < 0) return;
    if (hipMemsetAsync((char*)d_ws + WS_CTL, 0, CTL_ZERO_BYTES, stream) != hipSuccess) { fprintf(stderr, "kernel_launch: hipMemsetAsync failed\n"); return; }
    Args a{};
    a.p.x = (const float*)d_in[0]; a.p.c = (const float*)d_in[1]; a.p.w_ada = (const float*)d_in[2]; a.p.b_ada = (const float*)d_in[3]; a.p.n1g = (const float*)d_in[4];
    a.p.w_in = (const float*)d_in[5]; a.p.qng = (const float*)d_in[6]; a.p.kng = (const float*)d_in[7]; a.p.rpb = (const float*)d_in[8]; a.p.gag = (const float*)d_in[9];
    a.p.gbg = (const float*)d_in[10]; a.p.w_out = (const float*)d_in[11]; a.p.n2g = (const float*)d_in[12]; a.p.wq = (const float*)d_in[13]; a.p.sk1 = (const float*)d_in[14];
    a.p.sk2 = (const float*)d_in[15]; a.p.pu = (const float*)d_in[16]; a.p.pv = (const float*)d_in[17]; a.p.fng = (const float*)d_in[18];
    a.p.out = (float*)d_out; a.p.ws = (unsigned char*)d_ws;
    for (int li = 0; li < N_LAUNCHES; ++li) {
        a.ph_lo = (N_LAUNCHES == PER_PHASE) ? li : 0; a.ph_hi = (N_LAUNCHES == PER_PHASE) ? li + 1 : PER_PHASE;
        hipLaunchKernelGGL(hymba_fwd, dim3(grid), dim3(NWAVES * 64), LDS_BYTES, stream, a);
        const hipError_t le = hipPeekAtLastError();
        if (le != hipSuccess) { fprintf(stderr, "kernel_launch: launch %d failed: %s\n", li, hipGetErrorName(le)); break; }
    }
}
```

```cpp
#include <hip/hip_runtime.h>
#include <hip/hip_bf16.h>
#include <cstdio>
#include <cstdint>
#include <cmath>
namespace pg8 {
#define PG8_LAS __attribute__((address_space(3)))
typedef unsigned short bf16_t;
typedef short bf16x8 __attribute__((ext_vector_type(8)));
typedef float f32x4 __attribute__((ext_vector_type(4)));
typedef unsigned u32x4 __attribute__((ext_vector_type(4)));
typedef unsigned u32x2 __attribute__((ext_vector_type(2)));
constexpr int BM = 256, BK = 64, HALF = 128, HTB = HALF * BK * 2  , STAGE_BYTES = 8 * HTB, NXCD = 8, WGM = 8;

__host__ __device__ __forceinline__ int lds_byte(int r, int c) { const int st = (r >> 4) * 2 + (c >> 5), rr = r & 15, cc = c & 31, ob = rr * 64 + cc * 2; return st * 1024 + (ob ^ (((ob >> 9) & 1) << 5)); }
__host__ __device__ __forceinline__ void stage_rc(int b, int& R, int& C) { const int st = b / 1024, sb = b % 1024, swz = sb ^ (((sb >> 9) & 1) << 5); R = (st >> 1) * 16 + swz / 64; C = (st & 1) * 32 + (swz % 64) / 2; }
__host__ __device__ __forceinline__ int perm32(int rho) { const int n = rho >> 4, i = rho & 15; return 8 * (i >> 2) + 4 * n + (i & 3); }

struct Unit { int pm, pn; };
struct Gemm { const bf16_t* A; const bf16_t* Bt; int M, N, K; };

struct StaticOrder {
    int nM, nN, nwg, G, c;
    __host__ __device__ void init(int M, int N, int G_, int c_) { nM = M / BM; nN = N / BM; nwg = nM * nN; G = G_; c = c_; }
    __host__ __device__ bool next(int i, Unit& u) const {
        const long L = (long)i * G + c; if (L >= nwg) return false;
        int wgid = (int)L; { const int q = nwg / NXCD, r = nwg % NXCD, xcd = wgid % NXCD, off = wgid / NXCD; wgid = (xcd < r ? xcd * (q + 1) : r * (q + 1) + (xcd - r) * q) + off; }
        const int nig = WGM * nN, gid = wgid / nig, fm = gid * WGM, gsz = (nM - fm) < WGM ? (nM - fm) : WGM;
        u.pm = fm + ((wgid % nig) % gsz); u.pn = (wgid % nig) / gsz; return true;
    }
    __device__ __forceinline__ void a_ready(const Unit&) const {}
    __device__ __forceinline__ void done(const Unit&) const {}
};

__device__ __forceinline__ unsigned cvt_pk_bf16(float lo, float hi) { unsigned r; asm volatile("v_cvt_pk_bf16_f32 %0, %1, %2" : "=v"(r) : "v"(lo), "v"(hi)); return r; }

struct EpiBf16 {
    static constexpr bool PERM = true, AFTER_DRAIN = false, MIDSCALE = false, EXCH = false;
    bf16_t* O; int ldc;
    __device__ __forceinline__ void operator()(const f32x4 (&acc)[2][2][4][2], const Unit& u, int wr, int wc, int fr, int fq) const {
        const int row0 = u.pm * BM + wr * 64 + fr; const int col0 = u.pn * BM + wc * 32 + 8 * fq;
#pragma unroll
        for (int ai = 0; ai < 2; ++ai)
#pragma unroll
            for (int m = 0; m < 4; ++m) { bf16_t* rowp = O + (size_t)(row0 + ai * HALF + m * 16) * ldc + col0;
#pragma unroll
                for (int bj = 0; bj < 2; ++bj) { const f32x4 v0 = acc[ai][bj][m][0], v1 = acc[ai][bj][m][1];
                    u32x4 w; w.x = cvt_pk_bf16(v0[0], v0[1]); w.y = cvt_pk_bf16(v0[2], v0[3]); w.z = cvt_pk_bf16(v1[0], v1[1]); w.w = cvt_pk_bf16(v1[2], v1[3]);
                    *(u32x4*)(rowp + bj * HALF) = w; } }
    }
};

typedef unsigned u32x2v __attribute__((__vector_size__(2 * sizeof(unsigned))));
struct EpiInProj {
    static constexpr bool PERM = false, AFTER_DRAIN = false, MIDSCALE = false, EXCH = false;
    bf16_t* P; unsigned char* Q8; unsigned char* K8; unsigned char* V8T;
    const float* qg; const float* kg; const PG8_LAS float* rc; const PG8_LAS float* rs; float c2;
    __device__ __forceinline__ void operator()(const f32x4 (&acc)[2][2][4][2], const Unit& u, int wr, int wc, int fr, int fq) const {
        const int pn = u.pn;
        const bool nq = pn < 2, nk = (pn == 2 && wc < 2), normed = nq || nk;
        const float sc = (nq || pn == 3 || pn == 4) ? c2 : 1.0f;
        const float* g = nq ? qg : kg;
        f32x4 gv[2][2];
#pragma unroll
        for (int bj = 0; bj < 2; ++bj)
#pragma unroll
            for (int n = 0; n < 2; ++n) gv[bj][n] = normed ? *(const f32x4*)(g + 32 * bj + 16 * n + 4 * fq) : (f32x4){1.f, 1.f, 1.f, 1.f};
        const int colb = pn * BM + 64 * wc + 4 * fq;
#pragma unroll
        for (int ai = 0; ai < 2; ++ai)
#pragma unroll
            for (int m = 0; m < 4; ++m) {
                const int row = u.pm * BM + ai * HALF + wr * 64 + m * 16 + fr;
                f32x4 v[2][2];
#pragma unroll
                for (int bj = 0; bj < 2; ++bj)
#pragma unroll
                    for (int n = 0; n < 2; ++n) v[bj][n] = acc[ai][bj][m][n];
                if (normed) {
                    float ss = 0.f;
#pragma unroll
                    for (int bj = 0; bj < 2; ++bj)
#pragma unroll
                        for (int n = 0; n < 2; ++n) { const f32x4 x = v[bj][n]; ss += (x[0] * x[0] + x[1] * x[1]) + (x[2] * x[2] + x[3] * x[3]); }
                    ss += __shfl_xor(ss, 16); ss += __shfl_xor(ss, 32);
                    const float rinv = 1.0f / sqrtf(ss * (1.0f / 64.0f) + 1e-6f);
                    const int t = row & 8191, prow = t >> 6, pcol = t & 63;
#pragma unroll
                    for (int bj = 0; bj < 2; ++bj) {
                        const int pos = bj ? pcol : prow;
                        const f32x4 c4 = *(const PG8_LAS f32x4*)(rc + pos * 16 + 4 * fq), s4 = *(const PG8_LAS f32x4*)(rs + pos * 16 + 4 * fq);
                        const f32x4 x1 = v[bj][0] * rinv * gv[bj][0], x2 = v[bj][1] * rinv * gv[bj][1];
                        v[bj][0] = x1 * c4 - x2 * s4; v[bj][1] = x1 * s4 + x2 * c4;
                    }
                }
                const int coff = (fq & 1) ? 12 + 4 * fq : 4 * fq;
                if (pn > 2) {
                    bf16_t* rowp = P + (size_t)row * 2304 + pn * BM + 64 * wc + coff;
#pragma unroll
                    for (int bj = 0; bj < 2; ++bj) { const f32x4 x = v[bj][0] * sc, y = v[bj][1] * sc;
                        const u32x2v s0 = __builtin_amdgcn_permlane16_swap(cvt_pk_bf16(x[0], x[1]), cvt_pk_bf16(y[0], y[1]), false, false), s1 = __builtin_amdgcn_permlane16_swap(cvt_pk_bf16(x[2], x[3]), cvt_pk_bf16(y[2], y[3]), false, false);
                        u32x4 w; w.x = s0[0]; w.y = s1[0]; w.z = s0[1]; w.w = s1[1]; *(u32x4*)(rowp + 32 * bj) = w; }
                } else {
                    const float fs = nq ? sc * 4.0f : (nk ? 0.25f : 8.0f);
                    if (nq || nk) {
#pragma unroll
                        for (int bj = 0; bj < 2; ++bj) { const f32x4 x = v[bj][0] * fs, y = v[bj][1] * fs;
                            unsigned w0 = (unsigned)__builtin_amdgcn_cvt_pk_fp8_f32(x[0], x[1], 0, false); w0 = (unsigned)__builtin_amdgcn_cvt_pk_fp8_f32(x[2], x[3], (int)w0, true);
                            unsigned w1 = (unsigned)__builtin_amdgcn_cvt_pk_fp8_f32(y[0], y[1], 0, false); w1 = (unsigned)__builtin_amdgcn_cvt_pk_fp8_f32(y[2], y[3], (int)w1, true);
                            const u32x2v s0 = __builtin_amdgcn_permlane16_swap(w0, w1, false, false); u32x2 w; w.x = s0[0]; w.y = s0[1];
                            if (nq) *(u32x2*)(Q8 + (size_t)row * 512 + pn * 256 + 64 * wc + 32 * bj + coff) = w;
                            else    *(u32x2*)(K8 + (size_t)row * 128 + 64 * wc + 32 * bj + coff) = w; }
                    } else
#pragma unroll
                    for (int bj = 0; bj < 2; ++bj)
#pragma unroll
                        for (int n = 0; n < 2; ++n) { const f32x4 x = v[bj][n] * fs;
                            unsigned w = (unsigned)__builtin_amdgcn_cvt_pk_fp8_f32(x[0], x[1], 0, false); w = (unsigned)__builtin_amdgcn_cvt_pk_fp8_f32(x[2], x[3], (int)w, true);
                            const int d = 32 * bj + 16 * n + 4 * fq;
                            { const int t = row & 8191, kap = t & 63; const int kp = 32 * ((kap >> 2) & 1) + 16 * (kap >> 5) + (kap & 3) + 4 * ((kap & 31) >> 3);
                                unsigned char* vp = V8T + ((size_t)(((row >> 13) * 2 + (wc - 2)) * 64 + d)) * 8192 + (t & ~63) + kp;
                                vp[0] = (unsigned char)(w & 0xffu); vp[8192] = (unsigned char)((w >> 8) & 0xffu); vp[2 * 8192] = (unsigned char)((w >> 16) & 0xffu); vp[3 * 8192] = (unsigned char)(w >> 24); } }
                }
            }
    }
};

struct EpiX1 {
    static constexpr bool PERM = true, AFTER_DRAIN = false, MIDSCALE = true, EXCH = false;
    const float* x; bf16_t* out; const float* mod;
    const float* ssa; const float* ssb;
    PG8_LAS float* rsl;
    template <class Sched> __device__ __forceinline__ void prep(const Sched& S) const {
        Unit u;
        for (int i = 0; S.next(i, u); ++i) {
            if (threadIdx.x < 256) { const size_t r = (size_t)(u.pm * BM + threadIdx.x) * 8;
                const f32x4 a0 = *(const f32x4*)(ssa + r), a1 = *(const f32x4*)(ssa + r + 4), b0 = *(const f32x4*)(ssb + r), b1 = *(const f32x4*)(ssb + r + 4);
                const float sa = ((a0[0] + a0[1]) + (a0[2] + a0[3])) + ((a1[0] + a1[1]) + (a1[2] + a1[3])), sb = ((b0[0] + b0[1]) + (b0[2] + b0[3])) + ((b1[0] + b1[1]) + (b1[2] + b1[3]));
                const float ra = 1.0f / sqrtf(sa * (1.0f / 512.0f) + 1e-6f), rb = 1.0f / sqrtf(sb * (1.0f / 512.0f) + 1e-6f);
                rsl[(i * 256 + threadIdx.x) * 2] = ra / rb; rsl[(i * 256 + threadIdx.x) * 2 + 1] = rb; }
        }
        __syncthreads();
    }
    __device__ __forceinline__ void mid_scale(f32x4 (&acc)[2][2][4][2], int ui, int wr, int fr) const {
#pragma unroll
        for (int ai = 0; ai < 2; ++ai)
#pragma unroll
            for (int m = 0; m < 4; ++m) { const float sc = rsl[(ui * 256 + ai * HALF + wr * 64 + m * 16 + fr) * 2];
#pragma unroll
                for (int bj = 0; bj < 2; ++bj)
#pragma unroll
                    for (int n = 0; n < 2; ++n) acc[ai][bj][m][n] = acc[ai][bj][m][n] * sc; }
    }
    __device__ __forceinline__ void operator()(const f32x4 (&acc)[2][2][4][2], const Unit& u, int wr, int wc, int fr, int fq, int ui) const {
        const int col0 = u.pn * BM + wc * 32 + 8 * fq;
        const int b = (u.pm * BM) >> 13;
        f32x4 gt[2][2];
#pragma unroll
        for (int bj = 0; bj < 2; ++bj)
#pragma unroll
            for (int n = 0; n < 2; ++n) gt[bj][n] = *(const f32x4*)(mod + b * 6144 + 2048 + col0 + bj * HALF + 4 * n);
#pragma unroll
        for (int ai = 0; ai < 2; ++ai) {
            f32x4 xv[4][2][2];
#pragma unroll
            for (int m = 0; m < 4; ++m) { const size_t off = (size_t)(u.pm * BM + ai * HALF + wr * 64 + m * 16 + fr) * 1024 + col0;
#pragma unroll
                for (int bj = 0; bj < 2; ++bj)
#pragma unroll
                    for (int n = 0; n < 2; ++n) xv[m][bj][n] = *(const f32x4*)(x + off + bj * HALF + 4 * n); }
#pragma unroll
            for (int m = 0; m < 4; ++m) { const size_t off = (size_t)(u.pm * BM + ai * HALF + wr * 64 + m * 16 + fr) * 1024 + col0;
                const float fin = rsl[(ui * 256 + ai * HALF + wr * 64 + m * 16 + fr) * 2 + 1];
#pragma unroll
                for (int bj = 0; bj < 2; ++bj) { const f32x4 y0 = xv[m][bj][0] + gt[bj][0] * (acc[ai][bj][m][0] * fin), y1 = xv[m][bj][1] + gt[bj][1] * (acc[ai][bj][m][1] * fin);
                    u32x4 w; w.x = cvt_pk_bf16(y0[0], y0[1]); w.y = cvt_pk_bf16(y0[2], y0[3]); w.z = cvt_pk_bf16(y1[0], y1[1]); w.w = cvt_pk_bf16(y1[2], y1[3]);
                    *(u32x4*)(out + off + bj * HALF) = w; } }
        }
    }
};

struct EpiX1N {
    static constexpr bool PERM = true, AFTER_DRAIN = false, MIDSCALE = true, EXCH = true;
    const float* x; bf16_t* out; bf16_t* h2; const float* mod; const float* n2g;
    const float* ssa; const float* ssb;
    PG8_LAS float* rsl;
    unsigned* xs; unsigned* cnt;
    template <class Sched> __device__ __forceinline__ void prep(const Sched& S) const {
        Unit u;
        for (int i = 0; S.next(i, u); ++i) {
            if (threadIdx.x < 256) { const size_t r = (size_t)(u.pm * BM + threadIdx.x) * 8;
                const f32x4 a0 = *(const f32x4*)(ssa + r), a1 = *(const f32x4*)(ssa + r + 4), b0 = *(const f32x4*)(ssb + r), b1 = *(const f32x4*)(ssb + r + 4);
                const float sa = ((a0[0] + a0[1]) + (a0[2] + a0[3])) + ((a1[0] + a1[1]) + (a1[2] + a1[3])), sb = ((b0[0] + b0[1]) + (b0[2] + b0[3])) + ((b1[0] + b1[1]) + (b1[2] + b1[3]));
                const float ra = 1.0f / sqrtf(sa * (1.0f / 512.0f) + 1e-6f), rb = 1.0f / sqrtf(sb * (1.0f / 512.0f) + 1e-6f);
                rsl[(i * 256 + threadIdx.x) * 2] = ra / rb; rsl[(i * 256 + threadIdx.x) * 2 + 1] = rb; }
        }
        __syncthreads();
    }
    __device__ __forceinline__ void mid_scale(f32x4 (&acc)[2][2][4][2], int ui, int wr, int fr) const {
#pragma unroll
        for (int ai = 0; ai < 2; ++ai)
#pragma unroll
            for (int m = 0; m < 4; ++m) { const float sc = rsl[(ui * 256 + ai * HALF + wr * 64 + m * 16 + fr) * 2];
#pragma unroll
                for (int bj = 0; bj < 2; ++bj)
#pragma unroll
                    for (int n = 0; n < 2; ++n) acc[ai][bj][m][n] = acc[ai][bj][m][n] * sc; }
    }
    __device__ __forceinline__ void operator()(f32x4 (&acc)[2][2][4][2], const Unit& u, int wr, int wc, int fr, int fq, int ui, int wid, int lane) const {
        unsigned lb = (unsigned)(size_t)rsl; asm volatile("" : "+s"(lb));
        PG8_LAS float* R = (PG8_LAS float*)lb; PG8_LAS float* P = R + 1024; PG8_LAS float* S = R + 2048;
        int r0 = wr * 64 + fr; asm volatile("" : "+v"(r0));
        const int col0 = u.pn * BM + wc * 32 + 8 * fq;
        const int b = (u.pm * BM) >> 13;
        {
            f32x4 gt[2][2];
#pragma unroll
            for (int bj = 0; bj < 2; ++bj)
#pragma unroll
                for (int n = 0; n < 2; ++n) gt[bj][n] = *(const f32x4*)(mod + b * 6144 + 2048 + col0 + bj * HALF + 4 * n);
#pragma unroll
            for (int ai = 0; ai < 2; ++ai) {
                f32x4 xv[4][2][2];
#pragma unroll
                for (int m = 0; m < 4; ++m) { const size_t off = (size_t)(u.pm * BM + ai * HALF + m * 16 + r0) * 1024 + col0;
#pragma unroll
                    for (int bj = 0; bj < 2; ++bj)
#pragma unroll
                        for (int n = 0; n < 2; ++n) xv[m][bj][n] = *(const f32x4*)(x + off + bj * HALF + 4 * n); }
#pragma unroll
                for (int m = 0; m < 4; ++m) { const int r = ai * HALF + m * 16 + r0;
                    const float fin = R[(ui * 256 + r) * 2 + 1]; float s = 0.f;
#pragma unroll
                    for (int bj = 0; bj < 2; ++bj)
#pragma unroll
                        for (int n = 0; n < 2; ++n) { const f32x4 y = xv[m][bj][n] + gt[bj][n] * (acc[ai][bj][m][n] * fin); acc[ai][bj][m][n] = y; s += (y[0] * y[0] + y[1] * y[1]) + (y[2] * y[2] + y[3] * y[3]); }
                    s += __shfl_xor(s, 16); s += __shfl_xor(s, 32);
                    if (fq == 0) P[r * 4 + wc] = s; }
            }
        }
        asm volatile("s_waitcnt lgkmcnt(0)" ::: "memory"); __builtin_amdgcn_s_barrier(); asm volatile("" ::: "memory");
        int row = wid * 32 + (lane & 31); asm volatile("" : "+v"(row));
        if (lane < 32) { const f32x4 p = *(const PG8_LAS f32x4*)(P + row * 4);
            __hip_atomic_store(xs + (size_t)(u.pm * BM + row) * 4 + u.pn, __builtin_bit_cast(unsigned, (p[0] + p[1]) + (p[2] + p[3])), __ATOMIC_RELAXED, __HIP_MEMORY_SCOPE_AGENT); }
        asm volatile("s_waitcnt vmcnt(0)" ::: "memory");
        if (lane == 0) __hip_atomic_fetch_add(cnt + 64 * u.pm, 1u, __ATOMIC_RELAXED, __HIP_MEMORY_SCOPE_AGENT);
        if (wid == 0) {
            unsigned sp = 0u;
            while ((unsigned)__builtin_amdgcn_readfirstlane(__hip_atomic_load(cnt + 64 * u.pm, __ATOMIC_RELAXED, __HIP_MEMORY_SCOPE_AGENT)) < 32u) { __builtin_amdgcn_s_sleep(1); if (++sp > (1u << 22)) break; }
            __builtin_amdgcn_fence(__ATOMIC_ACQUIRE, "agent");
        }
        asm volatile("s_waitcnt vmcnt(0) lgkmcnt(0)" ::: "memory"); __builtin_amdgcn_s_barrier(); asm volatile("" ::: "memory");
        if (lane < 32) { const unsigned* sl = xs + (size_t)(u.pm * BM + row) * 4; float t = 0.f;
#pragma unroll
            for (int k = 0; k < 4; ++k) t += __builtin_bit_cast(float, __hip_atomic_load(sl + k, __ATOMIC_RELAXED, __HIP_MEMORY_SCOPE_AGENT));
            S[row] = 1.0f / sqrtf(t * (1.0f / 1024.0f) + 1e-6f); }
        asm volatile("s_waitcnt lgkmcnt(0)" ::: "memory"); __builtin_amdgcn_s_barrier(); asm volatile("" ::: "memory");
        f32x4 wv[2][2], sv[2][2];
#pragma unroll
        for (int bj = 0; bj < 2; ++bj)
#pragma unroll
            for (int n = 0; n < 2; ++n) { const int c = col0 + bj * HALF + 4 * n;
                wv[bj][n] = *(const f32x4*)(n2g + c) * (*(const f32x4*)(mod + b * 6144 + 4096 + c) + 1.0f); sv[bj][n] = *(const f32x4*)(mod + b * 6144 + 3072 + c); }
#pragma unroll
        for (int ai = 0; ai < 2; ++ai)
#pragma unroll
            for (int m = 0; m < 4; ++m) { const int r = ai * HALF + m * 16 + r0; const size_t off = (size_t)(u.pm * BM + r) * 1024 + col0; const float ri = S[r];
#pragma unroll
                for (int bj = 0; bj < 2; ++bj) { const f32x4 y0 = acc[ai][bj][m][0], y1 = acc[ai][bj][m][1];
                    u32x4 w; w.x = cvt_pk_bf16(y0[0], y0[1]); w.y = cvt_pk_bf16(y0[2], y0[3]); w.z = cvt_pk_bf16(y1[0], y1[1]); w.w = cvt_pk_bf16(y1[2], y1[3]);
                    *(u32x4*)(out + off + bj * HALF) = w;
                    const f32x4 h0 = (y0 * ri) * wv[bj][0] + sv[bj][0], h1 = (y1 * ri) * wv[bj][1] + sv[bj][1];
                    u32x4 g; g.x = cvt_pk_bf16(h0[0], h0[1]); g.y = cvt_pk_bf16(h0[2], h0[3]); g.z = cvt_pk_bf16(h1[0], h1[1]); g.w = cvt_pk_bf16(h1[2], h1[3]);
                    *(u32x4*)(h2 + off + bj * HALF) = g; } }
    }
};


template <class Epi, class Sched, bool ALIGN_EPI = false, bool SP2 = false>
__device__ __forceinline__ void gemm_phase(PG8_LAS unsigned char* lds, const Gemm g, const Sched& S, const Epi& E) {
    const int tid = threadIdx.x, wid = __builtin_amdgcn_readfirstlane(tid >> 6), lane = tid & 63, wr = wid >> 2, wc = wid & 3, fr = lane & 15, fq = lane >> 4;
    const int K = g.K, nt = K / BK;
    unsigned voffA[2], voffB[2];
#pragma unroll
    for (int i = 0; i < 2; ++i) { int R, C; stage_rc(tid * 16 + i * 8192, R, C); const int Rb = Epi::PERM ? ((R & ~31) + perm32(R & 31)) : R;
        voffA[i] = (unsigned)(R * K + C) * 2u; voffB[i] = (unsigned)(Rb * K + C) * 2u; }
    const size_t kstep = (size_t)(BK * 2);
    const size_t hstep = (size_t)HALF * K * 2;
    const size_t tstep = 2 * hstep;
    const unsigned ldsw = (unsigned)wid * 1024u;
    const int aoff = lds_byte(wr * 64 + fr, fq * 8), boff = lds_byte(wc * 32 + fr, fq * 8);
#define PG8_SA(b, h) (((b) * 2 + (h)) * HTB)
#define PG8_SB(b, h) ((4 + (b) * 2 + (h)) * HTB)
#define PG8_STAGE(bufoff, gbase, voff) do { _Pragma("unroll") for (int _i = 0; _i < 2; ++_i) \
        __builtin_amdgcn_global_load_lds((const unsigned*)((const char*)(gbase) + (voff)[_i]), (PG8_LAS unsigned*)(lds + (bufoff) + ldsw + _i * 8192), 16, 0, 0); } while (0)
#define PG8_LDA(dst, b, h) do { _Pragma("unroll") for (int m = 0; m < 4; ++m) _Pragma("unroll") for (int k = 0; k < 2; ++k) dst[m][k] = *(const PG8_LAS bf16x8*)(lds + PG8_SA(b, h) + aoff + m * 2048 + k * 1024); } while (0)
#define PG8_LDB(dst, b, h) do { _Pragma("unroll") for (int n = 0; n < 2; ++n) _Pragma("unroll") for (int k = 0; k < 2; ++k) dst[n][k] = *(const PG8_LAS bf16x8*)(lds + PG8_SB(b, h) + boff + n * 2048 + k * 1024); } while (0)
#define PG8_MMA(ai, bj, At, Bt) do { __builtin_amdgcn_s_setprio(1); _Pragma("unroll") for (int m = 0; m < 4; ++m) _Pragma("unroll") for (int n = 0; n < 2; ++n) _Pragma("unroll") for (int k = 0; k < 2; ++k) \
        acc[ai][bj][m][n] = __builtin_amdgcn_mfma_f32_16x16x32_bf16(Bt[n][k], At[m][k], acc[ai][bj][m][n], 0, 0, 0); __builtin_amdgcn_s_setprio(0); } while (0)
#define PG8_WAIT_V(n) asm volatile("s_waitcnt vmcnt(" #n ")" ::: "memory")
#define PG8_WAIT_L(n) asm volatile("s_waitcnt lgkmcnt(" #n ")" ::: "memory")
#define PG8_BAR __builtin_amdgcn_s_barrier()
#define PG8_SCHED __builtin_amdgcn_sched_barrier(0)
    Unit cur, nxt; int ui = 0;
    if (!S.next(0, cur)) return;
    f32x4 acc[2][2][4][2];
#pragma unroll
    for (int a = 0; a < 2; ++a)
#pragma unroll
        for (int b = 0; b < 2; ++b)
#pragma unroll
            for (int m = 0; m < 4; ++m)
#pragma unroll
                for (int n = 0; n < 2; ++n) acc[a][b][m][n] = (f32x4){0.f, 0.f, 0.f, 0.f};
    bf16x8 At[4][2], B0[2][2], B1[2][2];
    const char* cA = (const char*)g.A + (size_t)cur.pm * tstep; const char* cB = (const char*)g.Bt + (size_t)cur.pn * tstep;
    S.a_ready(cur);
    if constexpr (SP2) {
        PG8_STAGE(PG8_SB(0, 0), cB, voffB); PG8_STAGE(PG8_SB(0, 1), cB + hstep, voffB); PG8_STAGE(PG8_SA(0, 0), cA, voffA); PG8_STAGE(PG8_SA(0, 1), cA + hstep, voffA);
        if (wr == 1) PG8_BAR;
        PG8_WAIT_V(2); PG8_BAR;
        PG8_STAGE(PG8_SB(1, 0), cB + kstep, voffB); PG8_STAGE(PG8_SA(1, 0), cA + kstep, voffA); PG8_STAGE(PG8_SB(1, 1), cB + hstep + kstep, voffB);
        PG8_WAIT_V(6); PG8_BAR;
    } else {
        PG8_STAGE(PG8_SB(0, 0), cB, voffB); PG8_STAGE(PG8_SA(0, 0), cA, voffA); PG8_STAGE(PG8_SB(0, 1), cB + hstep, voffB); PG8_STAGE(PG8_SA(0, 1), cA + hstep, voffA);
        if (wr == 1) PG8_BAR;
        PG8_WAIT_V(4); PG8_BAR;
        PG8_STAGE(PG8_SB(1, 0), cB + kstep, voffB); PG8_STAGE(PG8_SA(1, 0), cA + kstep, voffA); PG8_STAGE(PG8_SB(1, 1), cB + hstep + kstep, voffB);
        PG8_WAIT_V(6); PG8_BAR;
    }
    for (;;) {
        const bool has_next = S.next(ui + 1, nxt);
        const char* nA = has_next ? (const char*)g.A + (size_t)nxt.pm * tstep : cA; const char* nB = has_next ? (const char*)g.Bt + (size_t)nxt.pn * tstep : cB;
        for (int t = 0; t < nt; t += 2) {
            if constexpr (Epi::MIDSCALE) { if (t == nt / 2) E.mid_scale(acc, ui, wr, fr); }
            const bool last = (t == nt - 2);
            const char* a1 = cA + (size_t)(t + 1) * kstep;
            const char* a2 = last ? nA : cA + (size_t)(t + 2) * kstep; const char* b2 = last ? nB : cB + (size_t)(t + 2) * kstep;
            const char* a3 = a2 + kstep; const char* b3 = b2 + kstep;
            if (last && has_next) S.a_ready(nxt);
            if constexpr (SP2) {
            PG8_LDB(B0, 0, 0); PG8_LDB(B1, 0, 1); PG8_SCHED; PG8_LDA(At, 0, 0); PG8_STAGE(PG8_SA(1, 1), a1 + hstep, voffA);
            PG8_WAIT_V(8); PG8_WAIT_L(0); PG8_BAR; PG8_MMA(0, 0, At, B0); PG8_MMA(0, 1, At, B1); PG8_BAR; PG8_SCHED;
            PG8_LDA(At, 0, 1); PG8_STAGE(PG8_SB(0, 0), b2, voffB); PG8_STAGE(PG8_SB(0, 1), b2 + hstep, voffB); PG8_STAGE(PG8_SA(0, 0), a2, voffA);
            PG8_WAIT_V(8); PG8_WAIT_L(0); PG8_BAR; PG8_MMA(1, 0, At, B0); PG8_MMA(1, 1, At, B1); PG8_BAR; PG8_SCHED;
            PG8_LDB(B0, 1, 0); PG8_LDB(B1, 1, 1); PG8_SCHED; PG8_LDA(At, 1, 0); PG8_STAGE(PG8_SA(0, 1), a2 + hstep, voffA);
            PG8_WAIT_V(8); PG8_WAIT_L(0); PG8_BAR; PG8_MMA(0, 0, At, B0); PG8_MMA(0, 1, At, B1); PG8_BAR; PG8_SCHED;
            PG8_LDA(At, 1, 1); PG8_STAGE(PG8_SB(1, 0), b3, voffB); PG8_STAGE(PG8_SB(1, 1), b3 + hstep, voffB); PG8_STAGE(PG8_SA(1, 0), a3, voffA);
            PG8_WAIT_V(8); PG8_WAIT_L(0); PG8_BAR; PG8_MMA(1, 0, At, B0); PG8_MMA(1, 1, At, B1); PG8_BAR; PG8_SCHED;
            } else {
            PG8_LDB(B0, 0, 0); PG8_SCHED; PG8_LDA(At, 0, 0); PG8_STAGE(PG8_SA(1, 1), a1 + hstep, voffA);
            PG8_WAIT_L(8); PG8_BAR; PG8_WAIT_L(0); PG8_MMA(0, 0, At, B0); PG8_BAR; PG8_SCHED;
            PG8_LDB(B1, 0, 1); PG8_STAGE(PG8_SB(0, 0), b2, voffB);
            PG8_BAR; PG8_WAIT_L(0); PG8_MMA(0, 1, At, B1); PG8_BAR;
            PG8_LDA(At, 0, 1); PG8_STAGE(PG8_SA(0, 0), a2, voffA);
            PG8_BAR; PG8_WAIT_L(0); PG8_MMA(1, 0, At, B0); PG8_BAR; PG8_SCHED;
            PG8_STAGE(PG8_SB(0, 1), b2 + hstep, voffB);
            PG8_WAIT_V(6); PG8_BAR; PG8_MMA(1, 1, At, B1); PG8_BAR;
            PG8_LDB(B0, 1, 0); PG8_SCHED; PG8_LDA(At, 1, 0); PG8_STAGE(PG8_SA(0, 1), a2 + hstep, voffA);
            PG8_WAIT_L(8); PG8_BAR; PG8_WAIT_L(0); PG8_MMA(0, 0, At, B0); PG8_BAR; PG8_SCHED;
            PG8_LDB(B1, 1, 1); PG8_STAGE(PG8_SB(1, 0), b3, voffB);
            PG8_BAR; PG8_WAIT_L(0); PG8_MMA(0, 1, At, B1); PG8_BAR;
            PG8_LDA(At, 1, 1); PG8_STAGE(PG8_SA(1, 0), a3, voffA);
            PG8_BAR; PG8_WAIT_L(0); PG8_MMA(1, 0, At, B0); PG8_BAR; PG8_SCHED;
            PG8_STAGE(PG8_SB(1, 1), b3 + hstep, voffB);
            PG8_WAIT_V(6); PG8_BAR; PG8_MMA(1, 1, At, B1); PG8_BAR;
            }
        }
        if constexpr (ALIGN_EPI) { if (wr == 0) PG8_BAR; }
        if constexpr (!Epi::AFTER_DRAIN) { if constexpr (Epi::EXCH) E(acc, cur, wr, wc, fr, fq, ui, wid, lane); else if constexpr (Epi::MIDSCALE) E(acc, cur, wr, wc, fr, fq, ui); else E(acc, cur, wr, wc, fr, fq); S.done(cur); }
        if (!has_next) break;
#pragma unroll
        for (int a = 0; a < 2; ++a)
#pragma unroll
            for (int b = 0; b < 2; ++b)
#pragma unroll
                for (int m = 0; m < 4; ++m)
#pragma unroll
                    for (int n = 0; n < 2; ++n) acc[a][b][m][n] = (f32x4){0.f, 0.f, 0.f, 0.f};
        cur = nxt; cA = nA; cB = nB; ++ui;
        if constexpr (ALIGN_EPI) { if (wr == 1) PG8_BAR; }
    }
    PG8_WAIT_V(0);
    if constexpr (!ALIGN_EPI) { if (wr == 0) PG8_BAR; }
    PG8_BAR;
    if constexpr (Epi::AFTER_DRAIN) { E.fused(acc, cur, wr, wc, fr, fq, lds, wid, lane); S.done(cur); }
#undef PG8_SA
#undef PG8_SB
#undef PG8_STAGE
#undef PG8_LDA
#undef PG8_LDB
#undef PG8_MMA
#undef PG8_WAIT_V
#undef PG8_WAIT_L
#undef PG8_BAR
#undef PG8_SCHED
}
}

namespace attn_body {
using bf16=__hip_bfloat16;
using bf16x8=__attribute__((ext_vector_type(8)))short;
using s16x4=__attribute__((ext_vector_type(4)))short;
using f32x16=__attribute__((ext_vector_type(16)))float;
using u32x4=__attribute__((ext_vector_type(4)))unsigned;
constexpr int BATCH=4,NHEAD=8,NKV=2,SEQ=8192,D=64,PP=2304,OP=1024;
constexpr int NW=8,QBLK=32,QB=QBLK*NW,KVBLK=64,NQB=SEQ/QB;
constexpr int ATTN_UNIT_ROWS=QB;
__device__ __forceinline__ int crow(int r,int hi){return (r&3)+8*(r>>2)+4*hi;}
#define SBAR() __builtin_amdgcn_sched_barrier(0)
__device__ __forceinline__ void cmask(f32x16&p0,f32x16&p1,int jb,int qrel,int hi){
  const float NEG=-INFINITY; int kb=64*jb+4*hi;
  #pragma unroll
  for(int r=0;r<16;++r){int kv=kb+(r&3)+8*(r>>2); if(kv>qrel)p0[r]=NEG; if(kv+32>qrel)p1[r]=NEG;}
}

constexpr int NSLOT=3, SLOTB=8192;
constexpr int LDS_K=0, LDS_V=NSLOT*SLOTB, LDS_WS=2*NSLOT*SLOTB, LDS_OST=LDS_WS+NW*64*4, LDS_BYTES=LDS_OST+NW*4096;
constexpr float C2=0.125f*1.4426950408889634f;
__device__ __forceinline__ void glds16(const void*gsrc,unsigned lds_dst){unsigned keep;
  asm volatile("s_mov_b32 %0, m0\n\ts_mov_b32 m0, %2\n\ts_nop 0\n\tglobal_load_lds_dwordx4 %1, off\n\ts_mov_b32 m0, %0":"=&s"(keep):"v"(gsrc),"s"(lds_dst):"memory");}
__device__ __forceinline__ float max3f(float a,float b,float c){float r;asm("v_max3_f32 %0, %1, %2, %3":"=v"(r):"v"(a),"v"(b),"v"(c));return r;}
__device__ __forceinline__ float max2f(float a,float b){float r;asm("v_max_f32_e32 %0, %1, %2":"=v"(r):"v"(a),"v"(b));return r;}
__device__ __forceinline__ float fadd_s(float a,float b){float r;asm("v_add_f32_e32 %0, %1, %2":"=v"(r):"v"(a),"v"(b));return r;}
__device__ __forceinline__ float fsub_s(float a,float b){float r;asm("v_sub_f32_e32 %0, %1, %2":"=v"(r):"v"(a),"v"(b));return r;}
typedef float f32x2_t __attribute__((ext_vector_type(2))); typedef __bf16 bf16x2_t __attribute__((ext_vector_type(2)));
__device__ __forceinline__ unsigned cvtpk_s(float lo,float hi){f32x2_t v={lo,hi};bf16x2_t b=__builtin_convertvector(v,bf16x2_t);return __builtin_bit_cast(unsigned,b);}
#define WAIT_BAR(N) asm volatile("s_waitcnt vmcnt(" #N ") lgkmcnt(0)\n\ts_barrier":::"memory")

__device__ __forceinline__ void qkt(f32x16&p0,f32x16&p1,const char*Kslot,const bf16x8*qr,const f32x16&negm,int r32,int hi){
  const char*kb=Kslot+hi*1024+r32*16;
  #pragma unroll
  for(int d0=0;d0<4;++d0){
    const bf16x8 b0=*reinterpret_cast<const bf16x8*>(kb+d0*2048);
    const bf16x8 b1=*reinterpret_cast<const bf16x8*>(kb+d0*2048+512);
    if(d0==0){p0=__builtin_amdgcn_mfma_f32_32x32x16_bf16(b0,qr[0],negm,0,0,0);p1=__builtin_amdgcn_mfma_f32_32x32x16_bf16(b1,qr[0],negm,0,0,0);}
    else{p0=__builtin_amdgcn_mfma_f32_32x32x16_bf16(b0,qr[d0],p0,0,0,0);p1=__builtin_amdgcn_mfma_f32_32x32x16_bf16(b1,qr[d0],p1,0,0,0);}}
}
typedef __attribute__((address_space(3))) const char* lds_cptr;
typedef short v4i16_t __attribute__((ext_vector_type(4)));
__device__ __forceinline__ void kload8(bf16x8*kf,lds_cptr kp){
  kf[0]=*(const __attribute__((address_space(3))) bf16x8*)(kp);      kf[1]=*(const __attribute__((address_space(3))) bf16x8*)(kp+512);
  kf[2]=*(const __attribute__((address_space(3))) bf16x8*)(kp+2048); kf[3]=*(const __attribute__((address_space(3))) bf16x8*)(kp+2560);
  kf[4]=*(const __attribute__((address_space(3))) bf16x8*)(kp+4096); kf[5]=*(const __attribute__((address_space(3))) bf16x8*)(kp+4608);
  kf[6]=*(const __attribute__((address_space(3))) bf16x8*)(kp+6144); kf[7]=*(const __attribute__((address_space(3))) bf16x8*)(kp+6656);
}
__device__ __forceinline__ void kload2(bf16x8*kf,lds_cptr kp,int j){ kf[2*j]=*(const __attribute__((address_space(3))) bf16x8*)(kp+j*2048); kf[2*j+1]=*(const __attribute__((address_space(3))) bf16x8*)(kp+j*2048+512); }
__device__ __forceinline__ s16x4 vtr(lds_cptr p){ return __builtin_bit_cast(s16x4,__builtin_amdgcn_ds_read_tr16_b64_v4i16((__attribute__((address_space(3))) v4i16_t*)p)); }
__device__ __forceinline__ float rowmax(const f32x16&p0,const f32x16&p1){
  float a=max3f(p0[0],p0[1],p1[0]),b=max3f(p0[2],p0[3],p1[1]);a=max3f(a,p1[2],p1[3]);
  #pragma unroll
  for(int r=4;r<16;r+=4){a=max3f(a,p0[r],p0[r+1]);b=max3f(b,p0[r+2],p0[r+3]);a=max3f(a,p1[r],p1[r+1]);b=max3f(b,p1[r+2],p1[r+3]);}
  const float m=max2f(a,b);
  auto rr=__builtin_amdgcn_permlane32_swap(__float_as_uint(m),__float_as_uint(m),false,false);
  return max2f(__uint_as_float(rr[0]),__uint_as_float(rr[1]));
}
__device__ __forceinline__ void pv(f32x16*o,int vb,bf16x8 pa0,bf16x8 pa1,bf16x8 pa2,bf16x8 pa3){
  #pragma unroll
  for(int d0=0;d0<2;++d0){s16x4 lo[4],hi[4];
    #pragma unroll
    for(int ks=0;ks<4;++ks){
      asm volatile("ds_read_b64_tr_b16 %0,%1 offset:%c2":"=&v"(lo[ks]):"v"(vb),"i"(d0*4096+ks*1024):"memory");
      asm volatile("ds_read_b64_tr_b16 %0,%1 offset:%c2":"=&v"(hi[ks]):"v"(vb),"i"(d0*4096+ks*1024+512):"memory");}
    asm volatile("s_waitcnt lgkmcnt(0)":::"memory");SBAR();
    #define PK(k) (bf16x8){lo[k][0],lo[k][1],lo[k][2],lo[k][3],hi[k][0],hi[k][1],hi[k][2],hi[k][3]}
    o[d0]=__builtin_amdgcn_mfma_f32_32x32x16_bf16(pa0,PK(0),o[d0],0,0,0);
    o[d0]=__builtin_amdgcn_mfma_f32_32x32x16_bf16(pa1,PK(1),o[d0],0,0,0);
    o[d0]=__builtin_amdgcn_mfma_f32_32x32x16_bf16(pa2,PK(2),o[d0],0,0,0);
    o[d0]=__builtin_amdgcn_mfma_f32_32x32x16_bf16(pa3,PK(3),o[d0],0,0,0);
    #undef PK
  }
}

#ifndef ATTN_STORE16
#define ATTN_STORE16(p,v) (*(u32x4*)(p)=(v))
#endif
template<int THRL> __device__ __forceinline__ void attn_unit(float cb,int b,int h,int kvh,int qb,const bf16*Q,const bf16*__restrict__ K,const bf16*__restrict__ V,bf16*O,float*SS,char*shm){
  const int tid=threadIdx.x,lane=tid&63,r32=lane&31,hi=lane>>5; const int wid=__builtin_amdgcn_readfirstlane(tid>>6);
  const long rowbase=(long)b*SEQ; const int q0=qb*QB;
  const bf16*Qw=Q+(rowbase+q0+wid*QBLK)*PP+h*D;
  const bf16*Kh=K+rowbase*PP+kvh*D,*Vh=V+rowbase*PP+kvh*D;
  const unsigned lds0=(unsigned)(uintptr_t)shm;
  float*wsf=(float*)(shm+LDS_WS)+wid*64;
  const bf16*ksrc=Kh+(long)lane*PP+wid*8;
  const bf16*vsrc=Vh+(long)(16*(wid&3)+(lane>>2))*PP+(wid>>2)*32+(lane&3)*8;
  const unsigned kdst=lds0+LDS_K+wid*1024, vdst=lds0+LDS_V+wid*1024;
  #define DMA_K(t,slot) glds16(ksrc+(long)(t)*KVBLK*PP,(unsigned)__builtin_amdgcn_readfirstlane(kdst+(slot)))
  #define DMA_V(t,slot) glds16(vsrc+(long)(t)*KVBLK*PP,(unsigned)__builtin_amdgcn_readfirstlane(vdst+(slot)))
  const int vb0=(int)(lds0+LDS_V)+((lane>>4)&1)*32+(lane&3)*8+(4*hi+((lane&15)>>2))*64;
  const char*Kbase=shm+LDS_K; bf16x8 kf[8];
  const lds_cptr shm3=(lds_cptr)shm; const lds_cptr kp0=shm3+LDS_K+hi*1024+r32*16; const lds_cptr vp0=shm3+LDS_V+((lane>>4)&1)*32+(lane&3)*8+(4*hi+((lane&15)>>2))*64;
  const int NT=SEQ/KVBLK;
  DMA_K(0,0);DMA_V(0,0);DMA_K(1,SLOTB);
  bf16x8 qr[4];
  #pragma unroll
  for(int d0=0;d0<4;++d0)qr[d0]=*reinterpret_cast<const bf16x8*>(&Qw[(long)r32*PP+d0*16+hi*8]);
  float l_reg=0.f;f32x16 o[2];o[0]=f32x16{};o[1]=f32x16{};f32x16 negm;
  #pragma unroll
  for(int r=0;r<16;++r)negm[r]=-cb;
  asm volatile("":"+v"(negm));
  const int qrel=wid*QBLK+r32;
  #define CMASK(P0,P1,t) do{}while(0)
  #define START(P0,P1) do{ _Pragma("unroll") for(int r=0;r<16;++r)P0[r]=__builtin_amdgcn_exp2f(P0[r]); }while(0)
  #define RESC() do{}while(0)
  f32x16 pA0,pA1,pB0,pB1;
  int sl_prev=0,sl_cur=0,sl_next=SLOTB;
  #define ROT() do{sl_prev=sl_cur;sl_cur=sl_next;sl_next=(sl_next==(NSLOT-1)*SLOTB)?0:sl_next+SLOTB;}while(0)
  DMA_K(2,2*SLOTB);
  WAIT_BAR(3);
  qkt(pA0,pA1,Kbase,qr,negm,r32,hi);asm volatile("s_nop 15\n\ts_nop 7":"+v"(pA0),"+v"(pA1));CMASK(pA0,pA1,0);
  START(pA0,pA1);
  _Pragma("unroll") for(int r=0;r<16;++r)pA1[r]=__builtin_amdgcn_exp2f(pA1[r]);
  WAIT_BAR(0);
  DMA_K(3,0);DMA_V(1,SLOTB);
  ROT();
  kload8(kf,kp0+sl_cur);
  WAIT_BAR(2);
  s16x4 vlo[8],vhi[8]; u32x4 pw0,pw1,pw2,pw3;
  #define PKW(P,B) cvtpk_s(P[B],P[B+1])
  #define PAF(k) __builtin_bit_cast(bf16x8,pw##k)
  #define VFR(i) (bf16x8){vlo[i][0],vlo[i][1],vlo[i][2],vlo[i][3],vhi[i][0],vhi[i][1],vhi[i][2],vhi[i][3]}
  #define PIN(x) asm volatile("":"+v"(x))
  #define MX3(a,b,c) __builtin_fmaxf(__builtin_fmaxf((a),(b)),(c))
  #define GAPA(MF,A0,A1,A2,A3,W0,W1,PW) do{ MF; sacc+=A0; sacc+=A1; sacc+=A2; sacc+=A3; PIN(sacc); W0; W1; PIN(PW); SBAR(); }while(0)
  #define EX(v) __builtin_amdgcn_exp2f(v)
  #define GAPB(MF,X,B) do{ MF; X[B]=EX(X[B]); X[B+1]=EX(X[B+1]); X[B+2]=EX(X[B+2]); X[B+3]=EX(X[B+3]); PIN(X); SBAR(); }while(0)
  #define VRD(i) do{ vlo[i]=vtr(vp_+(((i)>>2)*4096+((i)&3)*1024)); vhi[i]=vtr(vp_+(((i)>>2)*4096+((i)&3)*1024+512)); }while(0)
  #define KRD(G,j) do{ if(G){ kload2(kf,kp0+sl_next,j); SBAR(); } }while(0)
  #define STEP(C0,C1,P0,P1,t,GK,GV,GL) do{ SBAR(); \
    const lds_cptr vp_=vp0+sl_prev; \
    VRD(0); SBAR(); float sacc=(P0[0]+P0[1]); \
    GAPA(C0=__builtin_amdgcn_mfma_f32_32x32x16_bf16(kf[0],qr[0],negm,0,0,0), P0[2],P0[3],P0[4],P0[5],     pw0[0]=PKW(P0,0), pw0[1]=PKW(P0,2), pw0); \
    VRD(4); SBAR(); GAPA(C1=__builtin_amdgcn_mfma_f32_32x32x16_bf16(kf[1],qr[0],negm,0,0,0), P0[6],P0[7],P0[8],P0[9],     pw0[2]=PKW(P0,4), pw0[3]=PKW(P0,6), pw0); \
    VRD(1); SBAR(); GAPA(C0=__builtin_amdgcn_mfma_f32_32x32x16_bf16(kf[2],qr[1],C0,0,0,0),   P0[10],P0[11],P0[12],P0[13], pw1[0]=PKW(P0,8), pw1[1]=PKW(P0,10), pw1); \
    VRD(5); SBAR(); GAPA(C1=__builtin_amdgcn_mfma_f32_32x32x16_bf16(kf[3],qr[1],C1,0,0,0),   P0[14],P0[15],P1[0],P1[1],   pw1[2]=PKW(P0,12),pw1[3]=PKW(P0,14), pw1); \
    VRD(2); SBAR(); GAPA(C0=__builtin_amdgcn_mfma_f32_32x32x16_bf16(kf[4],qr[2],C0,0,0,0),   P1[2],P1[3],P1[4],P1[5],     pw2[0]=PKW(P1,0), pw2[1]=PKW(P1,2), pw2); \
    VRD(6); SBAR(); GAPA(C1=__builtin_amdgcn_mfma_f32_32x32x16_bf16(kf[5],qr[2],C1,0,0,0),   P1[6],P1[7],P1[8],P1[9],     pw2[2]=PKW(P1,4), pw2[3]=PKW(P1,6), pw2); \
    VRD(3); SBAR(); GAPA(C0=__builtin_amdgcn_mfma_f32_32x32x16_bf16(kf[6],qr[3],C0,0,0,0),   P1[10],P1[11],P1[12],P1[13], pw3[0]=PKW(P1,8), pw3[1]=PKW(P1,10), pw3); \
    VRD(7); SBAR(); GAPA(C1=__builtin_amdgcn_mfma_f32_32x32x16_bf16(kf[7],qr[3],C1,0,0,0),   P1[14],P1[15],0.f,0.f,       pw3[2]=PKW(P1,12),pw3[3]=PKW(P1,14), pw3); \
    l_reg+=sacc; \
    if(GK){DMA_K((t)+3,sl_cur);} if(GV){DMA_V((t)+1,sl_next);} \
    CMASK(C0,C1,t); \
    SBAR(); \
    GAPB(o[0]=__builtin_amdgcn_mfma_f32_32x32x16_bf16(PAF(0),VFR(0),o[0],0,0,0), C0,0); \
    GAPB(o[1]=__builtin_amdgcn_mfma_f32_32x32x16_bf16(PAF(0),VFR(4),o[1],0,0,0), C0,4); \
    KRD(GL,0); GAPB(o[0]=__builtin_amdgcn_mfma_f32_32x32x16_bf16(PAF(1),VFR(1),o[0],0,0,0), C0,8); \
    KRD(GL,1); GAPB(o[1]=__builtin_amdgcn_mfma_f32_32x32x16_bf16(PAF(1),VFR(5),o[1],0,0,0), C0,12); \
    KRD(GL,2); GAPB(o[0]=__builtin_amdgcn_mfma_f32_32x32x16_bf16(PAF(2),VFR(2),o[0],0,0,0), C1,0); \
    KRD(GL,3); GAPB(o[1]=__builtin_amdgcn_mfma_f32_32x32x16_bf16(PAF(2),VFR(6),o[1],0,0,0), C1,4); \
    GAPB(o[0]=__builtin_amdgcn_mfma_f32_32x32x16_bf16(PAF(3),VFR(3),o[0],0,0,0), C1,8); \
    GAPB(o[1]=__builtin_amdgcn_mfma_f32_32x32x16_bf16(PAF(3),VFR(7),o[1],0,0,0), C1,12); \
    }while(0)
  int t=1;
  #undef CMASK
  #define CMASK(P0,P1,t) do{}while(0)
  for(;t+5<NT;t+=2){
    STEP(pB0,pB1,pA0,pA1,t,true,true,true);     WAIT_BAR(2); RESC(); ROT();
    STEP(pA0,pA1,pB0,pB1,t+1,true,true,true);   WAIT_BAR(2); RESC(); ROT();
  }
  #undef CMASK
  #define CMASK(P0,P1,t) do{}while(0)
  #define ENDW(tt) do{ if((tt)+3<NT){WAIT_BAR(2);} else if((tt)+2<NT){WAIT_BAR(1);} else {WAIT_BAR(0);} }while(0)
  for(;t+1<NT;t+=2){
    STEP(pB0,pB1,pA0,pA1,t,(t+3<NT),(t+1<NT),(t+1<NT));       ENDW(t);   RESC(); ROT();
    STEP(pA0,pA1,pB0,pB1,t+1,(t+4<NT),(t+2<NT),(t+2<NT));     ENDW(t+1); RESC(); ROT();
  }
  STEP(pB0,pB1,pA0,pA1,NT-1,false,false,false); RESC();
  { float sacc=pB0[0]+pB0[1]; _Pragma("unroll") for(int r=2;r<16;++r)sacc+=pB0[r]; _Pragma("unroll") for(int r=0;r<16;++r)sacc+=pB1[r]; l_reg+=sacc;
    pw0=(u32x4){PKW(pB0,0),PKW(pB0,2),PKW(pB0,4),PKW(pB0,6)};pw1=(u32x4){PKW(pB0,8),PKW(pB0,10),PKW(pB0,12),PKW(pB0,14)};pw2=(u32x4){PKW(pB1,0),PKW(pB1,2),PKW(pB1,4),PKW(pB1,6)};pw3=(u32x4){PKW(pB1,8),PKW(pB1,10),PKW(pB1,12),PKW(pB1,14)};
    SBAR(); pv(o,vb0+sl_cur,PAF(0),PAF(1),PAF(2),PAF(3)); }
  #undef PKW
  #undef PAF
  #undef VFR
  #undef PIN
  #undef MX3
  #undef GAPA
  #undef GAPB
  #undef EX
  #undef VRD
  #undef KRD
  #undef STEP
  #undef ENDW
  {auto rr=__builtin_amdgcn_permlane32_swap(__float_as_uint(l_reg),__float_as_uint(l_reg),false,false);l_reg=__uint_as_float(rr[0])+__uint_as_float(rr[1]);}
  if(hi==0)wsf[32+r32]=l_reg;asm volatile("s_waitcnt lgkmcnt(0)":::"memory");
  float rli[16];
  #pragma unroll
  for(int r=0;r<16;++r)rli[r]=__builtin_amdgcn_rcpf(wsf[32+crow(r,hi)]);
  bf16*Ow=O+(rowbase+q0+wid*QBLK)*OP+h*D;
  { bf16*stg=(bf16*)(shm+LDS_OST)+wid*2048;
    #pragma unroll
    for(int r=0;r<16;++r){const int orow=crow(r,hi);
      #pragma unroll
      for(int d0=0;d0<2;++d0)stg[orow*64+d0*32+r32]=__float2bfloat16(o[d0][r]*rli[r]);}
    asm volatile("s_waitcnt lgkmcnt(0)":::"memory");
    #pragma unroll
    for(int i=0;i<4;++i){const int row=i*8+(lane>>3),ch=lane&7; const u32x4 v=*(const u32x4*)(stg+row*64+ch*8); ATTN_STORE16(Ow+(long)row*OP+ch*8,v);
      float q=0.f; { const unsigned w4[4]={v.x,v.y,v.z,v.w};
        #pragma unroll
        for(int k=0;k<4;++k){const float a=__uint_as_float(w4[k]<<16),b2=__uint_as_float(w4[k]&0xffff0000u); q+=a*a+b2*b2;} }
      q+=__builtin_bit_cast(float,__builtin_amdgcn_update_dpp(0,__builtin_bit_cast(int,q),0xB1,0xF,0xF,true));
      q+=__builtin_bit_cast(float,__builtin_amdgcn_update_dpp(0,__builtin_bit_cast(int,q),0x4E,0xF,0xF,true));
      q+=__builtin_bit_cast(float,__builtin_amdgcn_update_dpp(0,__builtin_bit_cast(int,q),0x141,0xF,0xF,true));
      if(ch==0)SS[(rowbase+q0+wid*QBLK+row)*8+h]=q; } }
  asm volatile("s_waitcnt lgkmcnt(0)\n\ts_barrier":::"memory");
  #undef DMA_K
  #undef DMA_V
  #undef CMASK
  #undef START
  #undef RESC
  #undef ROT
}
constexpr int ATTN_LDS_BYTES=LDS_BYTES;
struct AttnTensors { const bf16* Q; const bf16* K; const bf16* V; bf16* O; float* SS; };
struct AttnUnit { int b, h, kvh, qb; };
struct StaticOrder {
  int vcu, G;
  __device__ __forceinline__ explicit StaticOrder(int grid,int block):vcu((grid%8==0)?(block%8)*(grid/8)+block/8:block),G(grid){}
  __device__ __forceinline__ bool next(int i,AttnUnit&u)const{ const int id=vcu+i*G; const int per=NQB*BATCH*NKV; if(id>=4*per)return false;
    const int hq=id/per, rem=id%per, bk=rem/NQB; u.qb=rem%NQB; u.b=bk/NKV; u.kvh=bk%NKV; u.h=u.kvh*4+hq; return true; }
  __device__ __forceinline__ void a_ready(const AttnUnit&)const{}
  __device__ __forceinline__ void done(const AttnUnit&)const{}
};
template<class Sched,int THRL=8> __device__ __forceinline__ void attn_phase(char*lds,const AttnTensors&T,const Sched&S,float cb){
  AttnUnit u;
  for(int i=0;S.next(i,u);++i){ S.a_ready(u); attn_unit<THRL>(cb,u.b,u.h,u.kvh,u.qb,T.Q,T.K,T.V,T.O,T.SS,lds); S.done(u); }
}
#undef SBAR
#undef WAIT_BAR
}

namespace attn8 {
typedef int v8i __attribute__((ext_vector_type(8)));
using f32x16 = __attribute__((ext_vector_type(16))) float;
using u32x4 = __attribute__((ext_vector_type(4))) unsigned;
typedef __attribute__((address_space(3))) const unsigned char* lds_cptr;
constexpr int SEQ = 8192, QB = 256, NQB = SEQ / QB, KVT = 64, NT = SEQ / KVT, OP = 1024;
constexpr int NSLOT = 8, SLOTB = 8192, LDS_OST = NSLOT * SLOTB, LDS_BYTES = LDS_OST + 8 * 4096;
__device__ __forceinline__ int crow(int r, int hi) { return (r & 3) + 8 * (r >> 2) + 4 * hi; }
__device__ __forceinline__ unsigned f2bf_rne(float f) { const unsigned u = __float_as_uint(f); return (u + 0x7fffu + ((u >> 16) & 1u)) >> 16; }
__host__ __device__ __forceinline__ int kpos(int kappa) { return 32 * ((kappa >> 2) & 1) + 16 * (kappa >> 5) + (kappa & 3) + 4 * ((kappa & 31) >> 3); }
__device__ __forceinline__ void glds16(const void* gsrc, unsigned lds_dst) { unsigned keep;
    asm volatile("s_mov_b32 %0, m0\n\ts_mov_b32 m0, %2\n\ts_nop 0\n\tglobal_load_lds_dwordx4 %1, off\n\ts_mov_b32 m0, %0" : "=&s"(keep) : "v"(gsrc), "s"(lds_dst) : "memory"); }
#define A8_MFMA(a, b, c) __builtin_amdgcn_mfma_scale_f32_32x32x64_f8f6f4(a, b, c, 0, 0, 0, 0x7F7F7F7F, 0, 0x7F7F7F7F)
struct Tensors { const unsigned char* Q8; const unsigned char* K8; const unsigned char* V8T; unsigned short* O; float* SS; };

__device__ __forceinline__ void unit(float cb8, int b, int h, int kvh, int qb, const Tensors& T, char* shm) {
    const int tid = threadIdx.x, lane = tid & 63, r32 = lane & 31, hi = lane >> 5; const int wid = __builtin_amdgcn_readfirstlane(tid >> 6);
    const long rowbase = (long)b * SEQ; const int q0 = qb * QB;
    const unsigned lds0 = (unsigned)(uintptr_t)shm;
    const int prow = 16 * (wid & 3) + (lane >> 2), pch = (lane & 3) ^ ((prow >> 2) & 3);
    const unsigned char* src = (wid < 4) ? T.K8 + (size_t)(rowbase + prow) * 128 + kvh * 64 + pch * 16
                                         : T.V8T + ((size_t)((b * 2 + kvh) * 64 + prow)) * SEQ + pch * 16;
    const long tstep = (wid < 4) ? (long)KVT * 128 : (long)KVT;
    const unsigned dst0 = lds0 + (wid < 4 ? 0 : 4096) + (wid & 3) * 1024;
#define A8_DMA(t, slot) glds16(src + (long)(t) * tstep, (unsigned)__builtin_amdgcn_readfirstlane(dst0 + (slot) * SLOTB))
    A8_DMA(0, 0); A8_DMA(1, 1); A8_DMA(2, 2);
    v8i qv; { const unsigned char* qp = T.Q8 + (size_t)(rowbase + q0 + wid * 32 + r32) * 512 + h * 64 + 32 * hi;
              const u32x4 a = *(const u32x4*)qp, c = *(const u32x4*)(qp + 16); qv = (v8i){(int)a.x, (int)a.y, (int)a.z, (int)a.w, (int)c.x, (int)c.y, (int)c.z, (int)c.w}; }
    const int f = (r32 >> 2) & 3;
    const int o0 = r32 * 64 + 16 * ((2 * hi) ^ f), o1 = r32 * 64 + 16 * ((2 * hi + 1) ^ f);
    const lds_cptr sh3 = (lds_cptr)shm;
    f32x16 negc, O0 = f32x16{}, O1 = f32x16{};
#pragma unroll
    for (int r = 0; r < 16; ++r) negc[r] = -cb8;
    f32x16 L = f32x16{}; v8i ones = {0x38383838, 0x38383838, 0x38383838, 0x38383838, 0x38383838, 0x38383838, 0x38383838, 0x38383838};
    asm volatile("" : "+v"(ones));
#define A8_FRAG(p, blk) ({ const u32x4 x_ = *(const __attribute__((address_space(3))) u32x4*)((p) + (blk) * 2048 + o0), y_ = *(const __attribute__((address_space(3))) u32x4*)((p) + (blk) * 2048 + o1); \
                           (v8i){(int)x_.x, (int)x_.y, (int)x_.z, (int)x_.w, (int)y_.x, (int)y_.y, (int)y_.z, (int)y_.w}; })
#define A8_SB __builtin_amdgcn_sched_barrier(0)
#define A8_E(S, r) S[r] = __builtin_amdgcn_exp2f(S[r])
#define A8_C(PW, w, S, d) { PW[w] = __builtin_amdgcn_cvt_pk_fp8_f32(S[4 * (d)], S[4 * (d) + 1], PW[w], false); PW[w] = __builtin_amdgcn_cvt_pk_fp8_f32(S[4 * (d) + 2], S[4 * (d) + 3], PW[w], true); }
#define A8_ITER(t, SA0, SA1, SB0, SB1, PW, PR, PV) { \
        asm volatile("s_waitcnt vmcnt(1) lgkmcnt(0)\n\ts_barrier" ::: "memory");        \
        { const int tn = (t) + 3 < NT ? (t) + 3 : NT - 1; A8_DMA(tn, ((t) + 3) & (NSLOT - 1)); }     \
        const lds_cptr kn = sh3 + (((t) + 1) & (NSLOT - 1)) * SLOTB, vb = sh3 + (((t) + NSLOT - 1) & (NSLOT - 1)) * SLOTB + 4096; \
        const v8i k0 = A8_FRAG(kn, 0), k1 = A8_FRAG(kn, 1); v8i v0 = k0, v1 = k1; if (PV) { v0 = A8_FRAG(vb, 0); v1 = A8_FRAG(vb, 1); } \
        A8_SB; A8_E(SA0, 0); A8_E(SA0, 1); A8_E(SA0, 2); A8_E(SA0, 3); A8_E(SA0, 4); A8_E(SA0, 5); A8_SB; \
        SB0 = A8_MFMA(k0, qv, negc); A8_SB; \
        A8_E(SA0, 6); A8_E(SA0, 7); A8_E(SA0, 8); A8_E(SA0, 9); A8_E(SA0, 10); A8_E(SA0, 11); A8_E(SA0, 12); A8_SB; \
        SB1 = A8_MFMA(k1, qv, negc); A8_SB; \
        A8_E(SA0, 13); A8_E(SA0, 14); A8_E(SA0, 15); A8_E(SA1, 0); A8_E(SA1, 1); A8_E(SA1, 2); A8_E(SA1, 3); A8_SB; \
        if (PV) O0 = A8_MFMA(v0, PR, O0); A8_SB; \
        A8_E(SA1, 4); A8_E(SA1, 5); A8_E(SA1, 6); A8_E(SA1, 7); A8_E(SA1, 8); A8_E(SA1, 9); A8_SB; \
        if (PV) O1 = A8_MFMA(v1, PR, O1); A8_SB; \
        A8_E(SA1, 10); A8_E(SA1, 11); A8_E(SA1, 12); A8_E(SA1, 13); A8_E(SA1, 14); A8_E(SA1, 15); A8_C(PW, 0, SA0, 0); A8_C(PW, 1, SA0, 1); A8_SB; \
        if (PV) L = A8_MFMA(ones, PR, L); A8_SB; \
        A8_C(PW, 2, SA0, 2); A8_C(PW, 3, SA0, 3); A8_C(PW, 4, SA1, 0); A8_C(PW, 5, SA1, 1); A8_C(PW, 6, SA1, 2); A8_C(PW, 7, SA1, 3); A8_SB; }
    asm volatile("s_waitcnt vmcnt(2) lgkmcnt(0)\n\ts_barrier" ::: "memory");
    f32x16 Sa0, Sa1, Sb0, Sb1; v8i pA = {0, 0, 0, 0, 0, 0, 0, 0}, pB = {0, 0, 0, 0, 0, 0, 0, 0};
    { const v8i k0 = A8_FRAG(sh3, 0), k1 = A8_FRAG(sh3, 1); Sa0 = A8_MFMA(k0, qv, negc); Sa1 = A8_MFMA(k1, qv, negc); }
    A8_ITER(0, Sa0, Sa1, Sb0, Sb1, pA, pB, false);
    A8_ITER(1, Sb0, Sb1, Sa0, Sa1, pB, pA, true);
    for (int t = 2; t < NT; t += 2) {
        A8_ITER(t, Sa0, Sa1, Sb0, Sb1, pA, pB, true);
        A8_ITER(t + 1, Sb0, Sb1, Sa0, Sa1, pB, pA, true);
    }
    { const lds_cptr vb = sh3 + ((NT - 1) & (NSLOT - 1)) * SLOTB + 4096; const v8i v0 = A8_FRAG(vb, 0), v1 = A8_FRAG(vb, 1);
      O0 = A8_MFMA(v0, pB, O0); O1 = A8_MFMA(v1, pB, O1); L = A8_MFMA(ones, pB, L); }
#undef A8_ITER
#undef A8_C
#undef A8_E
#undef A8_SB
    const float rl = 1.0f / (8.0f * L[0]);
    unsigned short* stg = (unsigned short*)(shm + LDS_OST) + wid * 2048;
#pragma unroll
    for (int r = 0; r < 16; ++r) { const int d = crow(r, hi);
        stg[r32 * 64 + d] = (unsigned short)(f2bf_rne(O0[r] * rl)); stg[r32 * 64 + 32 + d] = (unsigned short)(f2bf_rne(O1[r] * rl)); }
    asm volatile("s_waitcnt lgkmcnt(0)" ::: "memory");
    unsigned short* Ow = T.O + (rowbase + q0 + wid * 32) * OP + h * 64;
#pragma unroll
    for (int i = 0; i < 4; ++i) { const int row = i * 8 + (lane >> 3), ch = lane & 7; const u32x4 v = *(const u32x4*)(stg + row * 64 + ch * 8); *(u32x4*)(Ow + (long)row * OP + ch * 8) = v;
        float q = 0.f; { const unsigned w4[4] = {v.x, v.y, v.z, v.w};
#pragma unroll
            for (int k = 0; k < 4; ++k) { const float a = __uint_as_float(w4[k] << 16), b2 = __uint_as_float(w4[k] & 0xffff0000u); q += a * a + b2 * b2; } }
        q += __builtin_bit_cast(float, __builtin_amdgcn_update_dpp(0, __builtin_bit_cast(int, q), 0xB1, 0xF, 0xF, true));
        q += __builtin_bit_cast(float, __builtin_amdgcn_update_dpp(0, __builtin_bit_cast(int, q), 0x4E, 0xF, 0xF, true));
        q += __builtin_bit_cast(float, __builtin_amdgcn_update_dpp(0, __builtin_bit_cast(int, q), 0x141, 0xF, 0xF, true));
        if (ch == 0) T.SS[(rowbase + q0 + wid * 32 + row) * 8 + h] = q; }
    asm volatile("s_waitcnt vmcnt(0) lgkmcnt(0)\n\ts_barrier" ::: "memory");
#undef A8_DMA
#undef A8_FRAG
}
__device__ __forceinline__ void phase(char* lds, const Tensors& T, int grid, int block, float cb8) {
    const int vcu = (grid % 8 == 0) ? (block % 8) * (grid / 8) + block / 8 : block;
    for (int id = vcu; id < 4 * NQB * 8; id += grid) {
        const int per = NQB * 8, hq = id / per, rem = id % per, bk = rem / NQB, qb = rem % NQB, b = bk / 2, kvh = bk % 2;
        unit(cb8, b, kvh * 4 + hq, kvh, qb, T, lds);
    }
}
#undef A8_MFMA
}

namespace natten {
using bf16x8 = __attribute__((ext_vector_type(8))) short;
using s16x4 = __attribute__((ext_vector_type(4))) short;
using f32x4 = __attribute__((ext_vector_type(4))) float;
using u32x4 = __attribute__((ext_vector_type(4))) unsigned;
using u32x2 = __attribute__((ext_vector_type(2))) unsigned;
typedef unsigned short bf16_t;
typedef __attribute__((address_space(3))) unsigned char* lds_ptr;
typedef short v4i16_t __attribute__((ext_vector_type(4)));
constexpr int SEQ = 8192, GW = 64, ROWS = 128, PP = 2304, OP = 1024, KH = 8, KW = 16;
constexpr int LDS_K = 0, LDS_V = 9 * 64 * 128, LDS_BIAS = 2 * LDS_V, LDS_BYTES = LDS_BIAS + 15 * 64 * 4;
__device__ __forceinline__ int clampi(int v, int lo, int hi) { return v < lo ? lo : (v > hi ? hi : v); }
__device__ __forceinline__ unsigned cvtpk(float lo, float hi) { unsigned r; asm volatile("v_cvt_pk_bf16_f32 %0, %1, %2" : "=v"(r) : "v"(lo), "v"(hi)); return r; }
__device__ __forceinline__ s16x4 vtr(const __attribute__((address_space(3))) unsigned char* p) { return __builtin_bit_cast(s16x4, __builtin_amdgcn_ds_read_tr16_b64_v4i16((__attribute__((address_space(3))) v4i16_t*)p)); }

__device__ __forceinline__ int win_lo(int rp) { return clampi(2 * rp - 4, 0, ROWS - KH); }
__device__ __forceinline__ int win_hi(int rp) { const int lo = win_lo(rp); return lo + ((ROWS - lo) < 9 ? (ROWS - lo) : 9) - 1; }
__device__ __forceinline__ void stage_chunk(lds_ptr lds, int row, int col, int c, bool isv, u32x4 v) {
    const int s = row % 9;
    if (!isv) *(__attribute__((address_space(3))) u32x4*)(lds + LDS_K + s * 8192 + col * 128 + 16 * (c ^ ((col >> 1) & 7))) = v;
    else      *(__attribute__((address_space(3))) u32x4*)(lds + LDS_V + s * 8192 + col * 128 + 32 * ((c >> 1) ^ ((col >> 1) & 3)) + 16 * (c & 1)) = v;
}
__device__ __forceinline__ void natten_block(int b, int h, int rp0, int nun, const bf16_t* Qb, const bf16_t* Kb, const bf16_t* Vb, const float* rpb, bf16_t* O, float* SS, lds_ptr lds) {
    const int tid = threadIdx.x, lane = tid & 63, wid = __builtin_amdgcn_readfirstlane(tid >> 6);
    for (int n = tid; n < 15 * 64; n += 512) {
        const int dr = n >> 6, x = (n & 63) - 16;
        const float v = (x >= 0 && x < 31) ? rpb[(h * 15 + dr) * 31 + x] * 1.4426950408889634f : 0.f;
        *(__attribute__((address_space(3))) float*)(lds + LDS_BIAS + n * 4) = v;
    }
    int have_hi = win_hi(rp0);
    { const int lo = win_lo(rp0), nr = have_hi - lo + 1;
      for (int n = tid; n < nr * 1024; n += 512) {
          const int r = n >> 10, m = n & 1023, isv = m >> 9, col = (m & 511) >> 3, c = m & 7;
          const size_t tokk = (size_t)b * SEQ + (size_t)(lo + r) * GW + col;
          stage_chunk(lds, lo + r, col, c, isv, *(const u32x4*)((isv ? Vb : Kb) + tokk * PP + h * 64 + c * 8));
      } }
    __syncthreads();
    const int g = lane >> 4, i16 = lane & 15, q4 = i16 >> 2, p4 = lane & 3;
    f32x4 bm[16]; int bmkey = 0x7fffffff;
#pragma unroll
    for (int kb = 0; kb < 16; ++kb) bm[kb] = (f32x4){0.f, 0.f, 0.f, 0.f};
    for (int u = 0; u < nun; ++u) {
        const int rp = rp0 + u;
        u32x4 pf[4]; int nnew = 0;
        if (u + 1 < nun) { nnew = win_hi(rp + 1) - have_hi;
#pragma unroll
            for (int i = 0; i < 4; ++i) { const int n = tid + 512 * i; const int r = n >> 10, m = n & 1023, isv = m >> 9, col = (m & 511) >> 3, c = m & 7;
                if (r < nnew) { const size_t tokk = (size_t)b * SEQ + (size_t)(have_hi + 1 + r) * GW + col; pf[i] = *(const u32x4*)((isv ? Vb : Kb) + tokk * PP + h * 64 + c * 8); } } }
        const int rq = 2 * rp + (wid >> 2), c0 = 16 * (wid & 3), cw = clampi(c0 - 8, 0, 32), rs = clampi(rq - 4, 0, ROWS - KH);
        const int cq = c0 + i16, csq = clampi(cq - 8, 0, GW - KW);
        const size_t tok = (size_t)b * SEQ + (size_t)rq * GW + cq;
        bf16x8 qf[2];
#pragma unroll
        for (int ks = 0; ks < 2; ++ks) qf[ks] = *(const bf16x8*)(Qb + tok * PP + h * 64 + 32 * ks + 8 * g);
        const int swk = ((cw + i16) >> 1) & 7;
        const lds_ptr kp0 = lds + LDS_K + (cw + i16) * 128 + 16 * ((0 + g) ^ swk);
        const lds_ptr kp1 = lds + LDS_K + (cw + i16) * 128 + 16 * ((4 + g) ^ swk);
        int sl[8];
#pragma unroll
        for (int j = 0; j < 8; ++j) sl[j] = ((rs + j) % 9) * 8192;
        if (u == 0 || rs - rq != bmkey) { bmkey = rs - rq;
            const lds_ptr bp = lds + LDS_BIAS + ((rs - rq + 7) * 64 + (cw + 4 * g - cq + 31)) * 4;
#pragma unroll
            for (int kb = 0; kb < 16; ++kb)
#pragma unroll
                for (int r = 0; r < 4; ++r) bm[kb][r] = ((unsigned)(cw + 16 * (kb & 1) + 4 * g + r - csq) < 16u) ? *(const __attribute__((address_space(3))) float*)(bp + ((kb >> 1) * 64 + 16 * (kb & 1) + r) * 4) : -3.0e38f; }
        f32x4 s[16];
#pragma unroll
        for (int kb = 0; kb < 16; ++kb) {
            const int off = sl[kb >> 1] + (16 * (kb & 1)) * 128;
            const bf16x8 a0 = *(const __attribute__((address_space(3))) bf16x8*)(kp0 + off);
            const bf16x8 a1 = *(const __attribute__((address_space(3))) bf16x8*)(kp1 + off);
            f32x4 z = bm[kb];
            z = __builtin_amdgcn_mfma_f32_16x16x32_bf16(a0, qf[0], z, 0, 0, 0);
            s[kb] = __builtin_amdgcn_mfma_f32_16x16x32_bf16(a1, qf[1], z, 0, 0, 0);
        }
        float mx = -3.0e38f;
#pragma unroll
        for (int kb = 0; kb < 16; ++kb)
#pragma unroll
            for (int r = 0; r < 4; ++r) mx = fmaxf(mx, s[kb][r]);
        mx = fmaxf(mx, __shfl_xor(mx, 16)); mx = fmaxf(mx, __shfl_xor(mx, 32));
#pragma unroll
        for (int kb = 0; kb < 16; ++kb)
#pragma unroll
            for (int r = 0; r < 4; ++r) s[kb][r] = __builtin_amdgcn_exp2f(s[kb][r] - mx);
        const int swv = (2 * g + (q4 >> 1)) & 3;
        lds_ptr vp[4];
#pragma unroll
        for (int db = 0; db < 4; ++db) vp[db] = lds + LDS_V + (cw + 4 * g + q4) * 128 + 32 * (db ^ swv) + 8 * p4;
        f32x4 o[4];
#pragma unroll
        for (int db = 0; db < 4; ++db) o[db] = (f32x4){0.f, 0.f, 0.f, 0.f};
        f32x4 lsum = {0.f, 0.f, 0.f, 0.f}; const bf16x8 ones8 = {0x3F80, 0x3F80, 0x3F80, 0x3F80, 0x3F80, 0x3F80, 0x3F80, 0x3F80};
#pragma unroll
        for (int kk = 0; kk < 8; ++kk) {
            u32x4 pw; pw.x = cvtpk(s[2 * kk][0], s[2 * kk][1]); pw.y = cvtpk(s[2 * kk][2], s[2 * kk][3]); pw.z = cvtpk(s[2 * kk + 1][0], s[2 * kk + 1][1]); pw.w = cvtpk(s[2 * kk + 1][2], s[2 * kk + 1][3]);
            const bf16x8 pb = __builtin_bit_cast(bf16x8, pw);
#pragma unroll
            for (int db = 0; db < 4; ++db) {
                const s16x4 lo = vtr(vp[db] + sl[kk]), hi = vtr(vp[db] + sl[kk] + 16 * 128);
                const bf16x8 a = (bf16x8){lo[0], lo[1], lo[2], lo[3], hi[0], hi[1], hi[2], hi[3]};
                o[db] = __builtin_amdgcn_mfma_f32_16x16x32_bf16(a, pb, o[db], 0, 0, 0);
            }
            lsum = __builtin_amdgcn_mfma_f32_16x16x32_bf16(ones8, pb, lsum, 0, 0, 0);
        }
        const float l = lsum[0];
        const float rl = 1.0f / l;
        bf16_t* op = O + tok * OP + 512 + h * 64 + 4 * g;
        float qs = 0.f;
#pragma unroll
        for (int db = 0; db < 4; ++db) { u32x2 w; w.x = cvtpk(o[db][0] * rl, o[db][1] * rl); w.y = cvtpk(o[db][2] * rl, o[db][3] * rl); *(u32x2*)(op + 16 * db) = w;
            const float a0 = __uint_as_float(w.x << 16), a1 = __uint_as_float(w.x & 0xffff0000u), a2 = __uint_as_float(w.y << 16), a3 = __uint_as_float(w.y & 0xffff0000u); qs += (a0 * a0 + a1 * a1) + (a2 * a2 + a3 * a3); }
        qs += __shfl_xor(qs, 16); qs += __shfl_xor(qs, 32);
        if (g == 0) SS[tok * 8 + h] = qs;
        __syncthreads();
        if (u + 1 < nun) {
#pragma unroll
            for (int i = 0; i < 4; ++i) { const int n = tid + 512 * i; const int r = n >> 10, m = n & 1023, isv = m >> 9, col = (m & 511) >> 3, c = m & 7;
                if (r < nnew) stage_chunk(lds, have_hi + 1 + r, col, c, isv, pf[i]); }
            have_hi += nnew;
            __syncthreads();
        }
    }
}
__device__ __forceinline__ void natten_phase(lds_ptr lds, const bf16_t* Qb, const bf16_t* Kb, const bf16_t* Vb, const float* rpb, bf16_t* O, float* SS, int vcu, int G) {
    for (int it = vcu; it < 256; it += G) { natten_block(it >> 6, (it >> 3) & 7, (it & 7) * 8, 8, Qb, Kb, Vb, rpb, O, SS, lds); __syncthreads(); }
}
}

namespace peer {
using bf16x8 = __attribute__((ext_vector_type(8))) short;
using f32x4 = __attribute__((ext_vector_type(4))) float;
using u32x4 = __attribute__((ext_vector_type(4))) unsigned;
typedef unsigned short bf16_t;
typedef __bf16 bf16x2_t __attribute__((ext_vector_type(2)));
typedef __attribute__((address_space(3))) unsigned char* lds_ptr;
constexpr int LDS_SK = 0, LDS_TAB = 65536, LDS_WV = LDS_TAB + 256, LDS_BYTES = LDS_WV + 8 * 4096;
constexpr float LOG2E = 1.4426950408889634f;

#define PEER_CE(a, b) do { const float hi_ = fmaxf(a, b), lo_ = fminf(a, b); a = hi_; b = lo_; } while (0)
template <int N, bool DESC> __device__ __forceinline__ void bitonic_sort(float (&v)[N]) {
#pragma unroll
    for (int k = 2; k <= N; k <<= 1)
#pragma unroll
        for (int j = k >> 1; j > 0; j >>= 1)
#pragma unroll
            for (int i = 0; i < N; ++i) { const int l = i ^ j; if (l > i) { const bool d = (((i & k) == 0) == DESC); if (d) PEER_CE(v[i], v[l]); else PEER_CE(v[l], v[i]); } }
}
template <bool DESC> __device__ __forceinline__ void oem_sort16(float (&v)[16]) {
#pragma unroll
    for (int p = 1; p < 16; p <<= 1)
#pragma unroll
        for (int k = p; k >= 1; k >>= 1)
#pragma unroll
            for (int j = k % p; j <= 15 - k; j += 2 * k)
#pragma unroll
                for (int i = 0; i < k; ++i) { if (i <= 15 - j - k && ((i + j) / (2 * p) == (i + j + k) / (2 * p))) { if (DESC) PEER_CE(v[i + j], v[i + j + k]); else PEER_CE(v[i + j + k], v[i + j]); } }
}
__device__ __forceinline__ void bitonic_merge16_desc(float (&v)[16]) {
#pragma unroll
    for (int j = 8; j > 0; j >>= 1)
#pragma unroll
        for (int i = 0; i < 16; ++i) { const int l = i ^ j; if (l > i) PEER_CE(v[i], v[l]); }
}
__device__ __forceinline__ void xlane_merge16(float (&v)[16], int mask) {
    float t[16];
#pragma unroll
    for (int i = 0; i < 16; ++i) t[i] = fmaxf(v[i], __shfl_xor(v[15 - i], mask));
#pragma unroll
    for (int i = 0; i < 16; ++i) v[i] = t[i];
    bitonic_merge16_desc(v);
}
__device__ __forceinline__ float gelu_erf(float v) {
    const float av = fabsf(v), t = __builtin_amdgcn_rcpf(1.0f + 0.2316418882f * av);
    float q = t * 0.5307027145f + (-0.7265760135f); q = q * t + 0.7107068705f; q = q * t + (-0.142248368f); q = q * t + 0.127414796f; q = q * t;
    const float e = __builtin_amdgcn_exp2f((v * v) * (-0.72134752044f));
    const float m = v * (q * e);
    return v < 0.f ? m : v - m;
}
__device__ __forceinline__ float dot8(u32x4 a, u32x4 b, float acc) {
    typedef __bf16 bf16x8_t __attribute__((ext_vector_type(8)));
    const bf16x8_t va = __builtin_bit_cast(bf16x8_t, a), vb = __builtin_bit_cast(bf16x8_t, b);
    acc = __builtin_amdgcn_fdot2_f32_bf16((bf16x2_t){va[0], va[1]}, (bf16x2_t){vb[0], vb[1]}, acc, false);
    acc = __builtin_amdgcn_fdot2_f32_bf16((bf16x2_t){va[2], va[3]}, (bf16x2_t){vb[2], vb[3]}, acc, false);
    acc = __builtin_amdgcn_fdot2_f32_bf16((bf16x2_t){va[4], va[5]}, (bf16x2_t){vb[4], vb[5]}, acc, false);
    acc = __builtin_amdgcn_fdot2_f32_bf16((bf16x2_t){va[6], va[7]}, (bf16x2_t){vb[6], vb[7]}, acc, false);
    return acc;
}
__device__ __forceinline__ float blo(unsigned w) { return __uint_as_float(w << 16); }
__device__ __forceinline__ float bhi(unsigned w) { return __uint_as_float(w & 0xffff0000u); }

struct PeerArgs {
    const bf16_t* PQ;
    const bf16_t* SK;
    const bf16_t* H2;
    const unsigned char* U; const unsigned char* V;
    const float* US; const float* VS;
    int* eidx; float* egate2; float* wts;
    const bf16_t* xin; float* xout;
    const float* mod;
    const float* fg;
};

__device__ __forceinline__ void route16(const PeerArgs& A, lds_ptr lds, int tok0, int wid, int lane) {
    const int g = lane >> 4, i16 = lane & 15;
    const unsigned gm1 = g == 1 ? ~0u : 0u, gm2 = g == 2 ? ~0u : 0u, gm3 = g == 3 ? ~0u : 0u;
    auto gsel = [&](float a, float b, float c, float d) { unsigned r = __float_as_uint(a); r = (r & ~gm1) | (__float_as_uint(b) & gm1); r = (r & ~gm2) | (__float_as_uint(c) & gm2); r = (r & ~gm3) | (__float_as_uint(d) & gm3); return __uint_as_float(r); };
    const lds_ptr wv = lds + LDS_WV + wid * 4096;
    const bf16_t* qrow = A.PQ + (size_t)(tok0 + i16) * 2048;
    bf16x8 qn[4];
#pragma unroll
    for (int ks = 0; ks < 4; ++ks) qn[ks] = *(const bf16x8*)(qrow + 32 * ks + 8 * g);
#pragma unroll 2
    for (int h = 0; h < 8; ++h) {
        if (((h ^ (wid >> 2)) & 1) != 0) __builtin_amdgcn_s_setprio(1); else __builtin_amdgcn_s_setprio(0);
        float top[2][16];
#pragma unroll
        for (int half = 0; half < 2; ++half) {
            bf16x8 qf[4];
#pragma unroll
            for (int ks = 0; ks < 4; ++ks) qf[ks] = qn[ks];
            { const int nx = (2 * h + half + 1) & 15;
#pragma unroll
              for (int ks = 0; ks < 4; ++ks) qn[ks] = *(const bf16x8*)(qrow + nx * 128 + 32 * ks + 8 * g); }
            float v[32];
#pragma unroll
            for (int kb = 0; kb < 8; ++kb) {
                f32x4 s = {0.f, 0.f, 0.f, 0.f};
#pragma unroll
                for (int ks = 0; ks < 4; ++ks) {
                    const int row = 16 * kb + i16, c = 4 * ks + g;
                    const bf16x8 a = *(const __attribute__((address_space(3))) bf16x8*)(lds + LDS_SK + half * 32768 + row * 256 + 16 * (c ^ i16));
                    s = __builtin_amdgcn_mfma_f32_16x16x32_bf16(a, qf[ks], s, 0, 0, 0);
                }
#pragma unroll
                for (int r = 0; r < 4; ++r) v[4 * kb + r] = __uint_as_float((__float_as_uint(s[r]) & ~127u) | (unsigned)(16 * kb + 4 * g + r));
            }
            float a16[16], b16[16];
#pragma unroll
            for (int i = 0; i < 16; ++i) { a16[i] = v[i]; b16[i] = v[16 + i]; }
            oem_sort16<true>(a16); oem_sort16<false>(b16);
#pragma unroll
            for (int i = 0; i < 16; ++i) a16[i] = fmaxf(a16[i], b16[i]);
            bitonic_merge16_desc(a16);
            xlane_merge16(a16, 16); xlane_merge16(a16, 32);
#pragma unroll
            for (int i = 0; i < 16; ++i) top[half][i] = a16[i];
        }
        if (g == 0) {
#pragma unroll
            for (int i = 0; i < 16; ++i) { *(__attribute__((address_space(3))) float*)(wv + (i16 * 32 + i) * 4) = top[0][i]; *(__attribute__((address_space(3))) float*)(wv + (i16 * 32 + 16 + i) * 4) = top[1][i]; }
        }
        float cs[16];
#pragma unroll
        for (int j = 0; j < 16; ++j) {
            constexpr int A1[16] = {1, 1, 1, 1, 1, 1, 1, 1, 4, 4, 4, 5, 5, 8, 9, 10}, B1[16] = {0, 1, 2, 3, 4, 5, 6, 7, 0, 1, 2, 0, 1, 0, 0, 0};
            constexpr int A2[16] = {2, 2, 2, 2, 2, 3, 3, 3, 3, 6, 6, 7, 7, 11, 12, 13}, B2[16] = {0, 1, 2, 3, 4, 0, 1, 2, 3, 0, 1, 0, 1, 0, 0, 0};
            constexpr int A3[16] = {14, 15, 0, 0, 0, 0, 0, 0, 0, 0, 0, 0, 0, 0, 0, 0};
            const float x1 = gsel(top[0][0], top[0][A1[j]], top[0][A2[j]], top[0][A3[j]]);
            const float x2 = gsel(top[1][j], top[1][B1[j]], top[1][B2[j]], top[1][0]);
            float sm = __uint_as_float(__float_as_uint(x1) & ~127u) + __uint_as_float(__float_as_uint(x2) & ~127u);
            if (j >= 2) sm = __uint_as_float((__float_as_uint(sm) & ~gm3) | (0xFF61B1E6u   & gm3));
            cs[j] = __uint_as_float((__float_as_uint(sm) & ~63u) | (unsigned)(g * 16 + j));
        }
        oem_sort16<true>(cs);
        xlane_merge16(cs, 16); xlane_merge16(cs, 32);
        float mxs = __uint_as_float(__float_as_uint(cs[0]) & ~63u);
        float val[4]; int ex[4]; float es = 0.f;
#pragma unroll
        for (int k = 0; k < 4; ++k) {
            const float e = gsel(cs[k], cs[4 + k], cs[8 + k], cs[12 + k]);
            const unsigned slot = __float_as_uint(e) & 63u;
            const unsigned ab = *(const __attribute__((address_space(3))) unsigned char*)(lds + LDS_TAB + slot);
            const unsigned p1 = __float_as_uint(*(const __attribute__((address_space(3))) float*)(wv + (i16 * 32 + (ab >> 4)) * 4));
            const unsigned p2 = __float_as_uint(*(const __attribute__((address_space(3))) float*)(wv + (i16 * 32 + 16 + (ab & 15)) * 4));
            ex[k] = (int)((p1 & 127u) * 128u + (p2 & 127u));
            val[k] = __builtin_amdgcn_exp2f((__uint_as_float(p1 & ~127u) + __uint_as_float(p2 & ~127u) - mxs) * LOG2E);
            es += val[k];
        }
        es += __shfl_xor(es, 16); es += __shfl_xor(es, 32);
        const float ri = 1.0f / es;
        int* ep = A.eidx + (size_t)(tok0 + i16) * 128 + h * 16 + 4 * g;
        float* gp = A.egate2 + ((size_t)(tok0 + i16) * 128 + h * 16 + 4 * g) * 2;
        *(int4*)ep = make_int4(ex[0], ex[1], ex[2], ex[3]);
        *(float4*)gp = make_float4(A.US[ex[0]], val[0] * ri * A.VS[ex[0]], A.US[ex[1]], val[1] * ri * A.VS[ex[1]]);
        *(float4*)(gp + 4) = make_float4(A.US[ex[2]], val[2] * ri * A.VS[ex[2]], A.US[ex[3]], val[3] * ri * A.VS[ex[3]]);
    }
    __builtin_amdgcn_s_setprio(0);
}

typedef float f32x2 __attribute__((ext_vector_type(2)));
__device__ __forceinline__ float row16_sum(float x) {
    x += __builtin_bit_cast(float, __builtin_amdgcn_update_dpp(0, __builtin_bit_cast(int, x), 0xB1, 0xF, 0xF, true));
    x += __builtin_bit_cast(float, __builtin_amdgcn_update_dpp(0, __builtin_bit_cast(int, x), 0x4E, 0xF, 0xF, true));
    x += __builtin_bit_cast(float, __builtin_amdgcn_update_dpp(0, __builtin_bit_cast(int, x), 0x141, 0xF, 0xF, true));
    x += __builtin_bit_cast(float, __builtin_amdgcn_update_dpp(0, __builtin_bit_cast(int, x), 0x140, 0xF, 0xF, true));
    return x;
}
__device__ __forceinline__ f32x2 dot16_fp8(u32x4 w, const f32x2 (&h)[8], f32x2 acc) {
    acc += __builtin_amdgcn_cvt_pk_f32_fp8(w.x, false) * h[0]; acc += __builtin_amdgcn_cvt_pk_f32_fp8(w.x, true) * h[1];
    acc += __builtin_amdgcn_cvt_pk_f32_fp8(w.y, false) * h[2]; acc += __builtin_amdgcn_cvt_pk_f32_fp8(w.y, true) * h[3];
    acc += __builtin_amdgcn_cvt_pk_f32_fp8(w.z, false) * h[4]; acc += __builtin_amdgcn_cvt_pk_f32_fp8(w.z, true) * h[5];
    acc += __builtin_amdgcn_cvt_pk_f32_fp8(w.w, false) * h[6]; acc += __builtin_amdgcn_cvt_pk_f32_fp8(w.w, true) * h[7];
    return acc;
}
__device__ __forceinline__ void axpy16_fp8(u32x4 v, float wt, f32x2 (&acc)[8]) {
    const f32x2 w2 = {wt, wt};
    acc[0] += w2 * __builtin_amdgcn_cvt_pk_f32_fp8(v.x, false); acc[1] += w2 * __builtin_amdgcn_cvt_pk_f32_fp8(v.x, true);
    acc[2] += w2 * __builtin_amdgcn_cvt_pk_f32_fp8(v.y, false); acc[3] += w2 * __builtin_amdgcn_cvt_pk_f32_fp8(v.y, true);
    acc[4] += w2 * __builtin_amdgcn_cvt_pk_f32_fp8(v.z, false); acc[5] += w2 * __builtin_amdgcn_cvt_pk_f32_fp8(v.z, true);
    acc[6] += w2 * __builtin_amdgcn_cvt_pk_f32_fp8(v.w, false); acc[7] += w2 * __builtin_amdgcn_cvt_pk_f32_fp8(v.w, true);
}
typedef unsigned u32x2pv __attribute__((__vector_size__(2 * sizeof(unsigned))));
typedef unsigned v6u __attribute__((ext_vector_type(6)));
typedef float v32f __attribute__((ext_vector_type(32)));
typedef __bf16 v32bf __attribute__((ext_vector_type(32)));
typedef unsigned u32x2 __attribute__((ext_vector_type(2)));
__device__ __forceinline__ float dot32_bf16(v32bf c, u32x4 h0, u32x4 h1, u32x4 h2, u32x4 h3, float acc) {
    typedef __bf16 bf16x8_t __attribute__((ext_vector_type(8)));
    const bf16x8_t a0 = __builtin_bit_cast(bf16x8_t, h0), a1 = __builtin_bit_cast(bf16x8_t, h1), a2 = __builtin_bit_cast(bf16x8_t, h2), a3 = __builtin_bit_cast(bf16x8_t, h3);
#pragma unroll
    for (int i = 0; i < 4; ++i) {
        acc = __builtin_amdgcn_fdot2_f32_bf16((bf16x2_t){c[2 * i], c[2 * i + 1]}, (bf16x2_t){a0[2 * i], a0[2 * i + 1]}, acc, false);
        acc = __builtin_amdgcn_fdot2_f32_bf16((bf16x2_t){c[8 + 2 * i], c[8 + 2 * i + 1]}, (bf16x2_t){a1[2 * i], a1[2 * i + 1]}, acc, false);
        acc = __builtin_amdgcn_fdot2_f32_bf16((bf16x2_t){c[16 + 2 * i], c[16 + 2 * i + 1]}, (bf16x2_t){a2[2 * i], a2[2 * i + 1]}, acc, false);
        acc = __builtin_amdgcn_fdot2_f32_bf16((bf16x2_t){c[24 + 2 * i], c[24 + 2 * i + 1]}, (bf16x2_t){a3[2 * i], a3[2 * i + 1]}, acc, false);
    }
    return acc;
}
__device__ __forceinline__ float udot64(u32x4 p0, u32x4 p1, u32x4 p2, const u32x4 (&hp)[8]) {
    const v6u ga = {p0.x, p0.y, p0.z, p0.w, p1.x, p1.y}, gb = {p1.z, p1.w, p2.x, p2.y, p2.z, p2.w};
    const v32bf ca = __builtin_amdgcn_cvt_scalef32_pk32_bf16_fp6(ga, 1.0f), cb = __builtin_amdgcn_cvt_scalef32_pk32_bf16_fp6(gb, 1.0f);
    float d = dot32_bf16(ca, hp[0], hp[1], hp[2], hp[3], 0.f);
    return dot32_bf16(cb, hp[4], hp[5], hp[6], hp[7], d);
}
__device__ __forceinline__ void upass_token(const PeerArgs& A, int tok, int lane) {
    const int e4 = lane >> 4, l16 = lane & 15;
    u32x4 hp[8];
#pragma unroll
    for (int k = 0; k < 8; ++k) hp[k] = *(const u32x4*)(A.H2 + (size_t)tok * 1024 + 64 * l16 + 8 * k);
    const int2* ei = (const int2*)(A.eidx + (size_t)tok * 128 + e4 * 32); const f32x4* eg = (const f32x4*)(A.egate2 + ((size_t)tok * 128 + e4 * 32) * 2); float* wo = A.wts + (size_t)tok * 128 + e4 * 32;
    const unsigned char* ub = A.U + l16 * 16;
    int2 id[5]; u32x4 buf[3][6]; f32x4 gs[3];
#define U_IDS(st) do { id[(st) % 5] = ei[(st)]; } while (0)
#define U_GATHER(st) do { const unsigned char* pa = ub + (size_t)id[(st) % 5].x * 768; const unsigned char* pb = ub + (size_t)id[(st) % 5].y * 768; \
        buf[(st) % 3][0] = *(const u32x4*)pa; buf[(st) % 3][1] = *(const u32x4*)(pa + 256); buf[(st) % 3][2] = *(const u32x4*)(pa + 512); \
        buf[(st) % 3][3] = *(const u32x4*)pb; buf[(st) % 3][4] = *(const u32x4*)(pb + 256); buf[(st) % 3][5] = *(const u32x4*)(pb + 512); gs[(st) % 3] = eg[(st)]; } while (0)
    U_IDS(0); U_IDS(1); U_IDS(2); U_IDS(3);
    U_GATHER(0); U_GATHER(1);
#pragma unroll
    for (int st = 0; st < 16; ++st) {
        if (st + 4 < 16) U_IDS(st + 4);
        if (st + 2 < 16) U_GATHER(st + 2);
        const f32x4 g = gs[st % 3];
        const float ta = row16_sum(udot64(buf[st % 3][0], buf[st % 3][1], buf[st % 3][2], hp)) * g[0];
        const float tb = row16_sum(udot64(buf[st % 3][3], buf[st % 3][4], buf[st % 3][5], hp)) * g[2];
        if (l16 == 0) *(f32x2*)(wo + 2 * st) = (f32x2){gelu_erf(ta) * g[1], gelu_erf(tb) * g[3]};
    }
#undef U_IDS
#undef U_GATHER
}
__device__ __forceinline__ int grab(lds_ptr cnt, int lane);
__device__ __forceinline__ void upass_stream(const PeerArgs& A, int base, int ntok, int lane, lds_ptr cnt) {
    const int e4 = lane >> 4, l16 = lane & 15;
    const unsigned char* ub = A.U + l16 * 16;
    int cur = grab(cnt, lane); if (cur >= ntok) return;
    int nxt = grab(cnt, lane);
    int tok = base + cur;
    int2 id[8]; u32x4 buf[4][6]; f32x4 gs[4];
#define US_EI(t) ((const int2*)(A.eidx + (size_t)(t) * 128 + e4 * 32))
#define US_EG(t) ((const f32x4*)(A.egate2 + ((size_t)(t) * 128 + e4 * 32) * 2))
#define US_IDS(t, st) do { id[(st) % 8] = US_EI(t)[(st) % 16]; } while (0)
#define US_GATHER(t, st) do { const unsigned char* pa = ub + (size_t)id[(st) % 8].x * 768; const unsigned char* pb = ub + (size_t)id[(st) % 8].y * 768; \
        buf[(st) % 4][0] = *(const u32x4*)pa; buf[(st) % 4][1] = *(const u32x4*)(pa + 256); buf[(st) % 4][2] = *(const u32x4*)(pa + 512); \
        buf[(st) % 4][3] = *(const u32x4*)pb; buf[(st) % 4][4] = *(const u32x4*)(pb + 256); buf[(st) % 4][5] = *(const u32x4*)(pb + 512); gs[(st) % 4] = US_EG(t)[(st) % 16]; } while (0)
    US_IDS(tok, 0); US_IDS(tok, 1); US_IDS(tok, 2); US_IDS(tok, 3);
    US_GATHER(tok, 0); US_GATHER(tok, 1);
    for (;;) {
        const int tokn = nxt < ntok ? base + nxt : tok;
        u32x4 hp[8];
#pragma unroll
        for (int k = 0; k < 8; ++k) hp[k] = *(const u32x4*)(A.H2 + (size_t)tok * 1024 + 64 * l16 + 8 * k);
        float* wo = A.wts + (size_t)tok * 128 + e4 * 32;
#pragma unroll
        for (int st = 0; st < 16; ++st) {
            if (st + 4 < 16) US_IDS(tok, st + 4); else US_IDS(tokn, st + 4);
            if (st + 2 < 16) US_GATHER(tok, st + 2); else US_GATHER(tokn, st + 2);
            const f32x4 g = gs[st % 4];
            const float ta = row16_sum(udot64(buf[st % 4][0], buf[st % 4][1], buf[st % 4][2], hp)) * g[0];
            const float tb = row16_sum(udot64(buf[st % 4][3], buf[st % 4][4], buf[st % 4][5], hp)) * g[2];
            if (l16 == 0) *(f32x2*)(wo + 2 * st) = (f32x2){gelu_erf(ta) * g[1], gelu_erf(tb) * g[3]};
        }
        if (nxt >= ntok) break;
        tok = tokn; cur = nxt; nxt = grab(cnt, lane);
    }
#undef US_EI
#undef US_EG
#undef US_IDS
#undef US_GATHER
}
__device__ __forceinline__ int grab(lds_ptr cnt, int lane) {
    int t = 0;
    if (lane == 0) t = __hip_atomic_fetch_add((__attribute__((address_space(3))) int*)cnt, 1, __ATOMIC_RELAXED, __HIP_MEMORY_SCOPE_WORKGROUP);
    return __builtin_amdgcn_readfirstlane(t);
}
template <bool DYN> __device__ __forceinline__ void vpass_wave(const PeerArgs& A, int tok0, int tstride, int ntok, int lane, lds_ptr cnt = nullptr) {
    const int hw = lane >> 5, l32 = lane & 31;
    const unsigned char* vb = A.V + l32 * 16; const unsigned char* vc = A.V + 512 + l32 * 8;
    int4 id[4]; f32x4 wg[4]; u32x4 p0[4][4]; u32x2 p1[4][4];
#define V_EI(t) ((const int4*)(A.eidx + (size_t)(t) * 128 + hw * 64))
#define V_WI(t) ((const f32x4*)(A.wts + (size_t)(t) * 128 + hw * 64))
#define V_IDS(t, gr) do { id[(gr) % 4] = V_EI(t)[(gr) % 16]; wg[(gr) % 4] = V_WI(t)[(gr) % 16]; } while (0)
#define V_GATHER(gr) do { const int4 t_ = id[(gr) % 4]; \
        p0[(gr) % 4][0] = *(const u32x4*)(vb + (size_t)t_.x * 768); p1[(gr) % 4][0] = *(const u32x2*)(vc + (size_t)t_.x * 768); \
        p0[(gr) % 4][1] = *(const u32x4*)(vb + (size_t)t_.y * 768); p1[(gr) % 4][1] = *(const u32x2*)(vc + (size_t)t_.y * 768); \
        p0[(gr) % 4][2] = *(const u32x4*)(vb + (size_t)t_.z * 768); p1[(gr) % 4][2] = *(const u32x2*)(vc + (size_t)t_.z * 768); \
        p0[(gr) % 4][3] = *(const u32x4*)(vb + (size_t)t_.w * 768); p1[(gr) % 4][3] = *(const u32x2*)(vc + (size_t)t_.w * 768); } while (0)
    int cur = 0, nxt = 1;
    if (DYN) { cur = grab(cnt, lane); if (cur >= ntok) return; nxt = grab(cnt, lane); tok0 += cur; }
    V_IDS(tok0, 0); V_IDS(tok0, 1); V_IDS(tok0, 2);
    V_GATHER(0); V_GATHER(1);
    int tokd = tok0;
    for (int t = 0; DYN || t < ntok; ++t) {
        const int tok = DYN ? tokd : tok0 + t * tstride, tokn = DYN ? (nxt < ntok ? tok - cur + nxt : tok) : ((t + 1 < ntok) ? tok + tstride : tok);
        v32f acc;
#pragma unroll
        for (int i = 0; i < 32; ++i) acc[i] = 0.f;
        const u32x4 xa = *(const u32x4*)(A.xin + (size_t)tok * 1024 + 32 * l32 + 16 * hw), xb = *(const u32x4*)(A.xin + (size_t)tok * 1024 + 32 * l32 + 16 * hw + 8);
#pragma unroll
        for (int gr = 0; gr < 16; ++gr) {
            V_GATHER(gr + 2);
            const f32x4 w = wg[gr % 4];
            if (gr + 3 < 16) V_IDS(tok, gr + 3); else V_IDS(tokn, gr + 3);
#pragma unroll
            for (int k = 0; k < 4; ++k) {
                const v6u g = {p0[gr % 4][k].x, p0[gr % 4][k].y, p0[gr % 4][k].z, p0[gr % 4][k].w, p1[gr % 4][k].x, p1[gr % 4][k].y};
                const v32f c = __builtin_amdgcn_cvt_scalef32_pk32_f32_fp6(g, 1.0f);
                acc += c * w[k];
            }
        }
        float f[16];
#pragma unroll
        for (int i = 0; i < 16; ++i) { const u32x2pv r_ = __builtin_amdgcn_permlane32_swap(__float_as_uint(acc[i]), __float_as_uint(acc[16 + i]), false, false); f[i] = __uint_as_float(r_[0]) + __uint_as_float(r_[1]); }
        const int b = tok >> 13, col = 32 * l32 + 16 * hw;
        float* xo = A.xout + (size_t)tok * 1024 + col; const float* g2 = A.mod + b * 6144 + 5120 + col; const float* fgp = A.fg + col;
        float y[16]; float ss = 0.f;
        { y[0] = blo(xa.x); y[1] = bhi(xa.x); y[2] = blo(xa.y); y[3] = bhi(xa.y); y[4] = blo(xa.z); y[5] = bhi(xa.z); y[6] = blo(xa.w); y[7] = bhi(xa.w);
          y[8] = blo(xb.x); y[9] = bhi(xb.x); y[10] = blo(xb.y); y[11] = bhi(xb.y); y[12] = blo(xb.z); y[13] = bhi(xb.z); y[14] = blo(xb.w); y[15] = bhi(xb.w); }
#pragma unroll
        for (int q = 0; q < 4; ++q) {
            const f32x4 gv = *(const f32x4*)(g2 + 4 * q);
#pragma unroll
            for (int i = 0; i < 4; ++i) { y[4 * q + i] = y[4 * q + i] + gv[i] * f[4 * q + i]; ss += y[4 * q + i] * y[4 * q + i]; }
        }
#pragma unroll
        for (int o = 1; o < 64; o <<= 1) ss += __shfl_xor(ss, o);
        const float rinv = 1.0f / sqrtf(ss * (1.0f / 1024.0f) + 1e-6f);
#pragma unroll
        for (int q = 0; q < 4; ++q) {
            const f32x4 fv = *(const f32x4*)(fgp + 4 * q); f32x4 o;
#pragma unroll
            for (int i = 0; i < 4; ++i) o[i] = y[4 * q + i] * rinv * fv[i];
            *(f32x4*)(xo + 4 * q) = o;
        }
        if (DYN) { if (nxt >= ntok) break; tokd = tokn; cur = nxt; nxt = grab(cnt, lane); }
    }
#undef V_EI
#undef V_WI
#undef V_IDS
#undef V_GATHER
}

__device__ __forceinline__ void peer_phase(lds_ptr lds, const PeerArgs& A, int vcu, int G, int wid) {
    const int lane = (int)__builtin_amdgcn_mbcnt_hi(~0u, __builtin_amdgcn_mbcnt_lo(~0u, 0u)), tid = wid * 64 + lane;
    for (int n = tid; n < 2 * 128 * 16; n += 512) {
        const int tb = n >> 11, row = (n >> 4) & 127, c = n & 15;
        *(__attribute__((address_space(3))) u32x4*)(lds + LDS_SK + tb * 32768 + row * 256 + 16 * (c ^ (row & 15))) = *(const u32x4*)(A.SK + (size_t)tb * 16384 + row * 128 + c * 8);
    }
    if (tid < 64) {
        const unsigned long long A1 = 0xA985544411111111ull, B1 = 0x0001021076543210ull, A2 = 0xDCB7766333322222ull, B2 = 0x0001010321043210ull;
        const int gq = tid >> 4, j = tid & 15; int a = 0, b = 0;
        if (gq == 0) { a = 0; b = j; } else if (gq == 1) { a = (int)((A1 >> (4 * j)) & 15); b = (int)((B1 >> (4 * j)) & 15); } else if (gq == 2) { a = (int)((A2 >> (4 * j)) & 15); b = (int)((B2 >> (4 * j)) & 15); } else { a = j == 0 ? 14 : 15; b = 0; }
        *(__attribute__((address_space(3))) unsigned char*)(lds + LDS_TAB + tid) = (unsigned char)((a << 4) | b);
    }
    __syncthreads();
    const lds_ptr cU = lds + 160 * 1024 - 256 + 24 * 4, cV = cU + 4;
    for (int task_ = vcu; task_ < 256; task_ += G) {
        const int task = __builtin_amdgcn_readfirstlane(task_);
        if (tid == 0) { *(__attribute__((address_space(3))) int*)cU = 0; *(__attribute__((address_space(3))) int*)cV = 0; }
        const int tok0 = task * 128 + wid * 16;
        { int ln_ = lane; asm volatile("" : "+v"(ln_)); route16(A, lds, tok0, wid, ln_); }
        int lane2 = lane;
        asm volatile("s_waitcnt vmcnt(0) lgkmcnt(0)" : "+v"(lane2) :: "memory");
        __syncthreads();
        upass_stream(A, task * 128, 128, lane2, cU);
        asm volatile("s_waitcnt vmcnt(0)" ::: "memory");
        __syncthreads();
        vpass_wave<true>(A, task * 128, 1, 128, lane2, cV);
        __syncthreads();
    }
}
__device__ __forceinline__ void peer_vphase_local(const PeerArgs& A, int vcu, int G) {
    const int lane = threadIdx.x & 63, wid = __builtin_amdgcn_readfirstlane(threadIdx.x >> 6);
    asm volatile("s_waitcnt vmcnt(0)" ::: "memory");
    for (int task = vcu; task < 256; task += G) vpass_wave<false>(A, task * 128 + wid * 16, 1, 16, lane);
}
__device__ __forceinline__ void peer_vphase(const PeerArgs& A, int vcu, int G) {
    const int lane = threadIdx.x & 63, wid = __builtin_amdgcn_readfirstlane(threadIdx.x >> 6);
    { const int w0 = vcu * 8 + wid, nw = G * 8; if (w0 < 32768) vpass_wave<false>(A, w0, nw, (32768 - w0 + nw - 1) / nw, lane); }
}
#undef PEER_CE
}

constexpr int NWAVES = 8;
#ifndef MK_N_LAUNCHES
#define MK_N_LAUNCHES 1
#endif
constexpr int PER_PHASE = 10;
constexpr int N_LAUNCHES = MK_N_LAUNCHES;

constexpr int BATCH = 4, T = 8192, D = 1024, M = BATCH * T, NIN = 2304, NPQ = 2048, NEXP = 16384;
constexpr float EPS = 1e-6f;
constexpr float C2 = 0.125f * 1.4426950408889634f;

constexpr size_t MiB = 1u << 20;
constexpr size_t WS_CTL = 0, CTL_ZERO_BYTES = 1 * MiB;
constexpr size_t WS_TAB = 1 * MiB;
constexpr size_t WS_WIN = 2 * MiB, WS_WOUT = 8 * MiB, WS_WQ = 10 * MiB, WS_SK = 14 * MiB;
constexpr size_t WS_U = 16 * MiB, WS_V = 32 * MiB;
constexpr size_t WS_US = 48 * MiB, WS_VS = 49 * MiB, WS_XS = 50 * MiB  ;
constexpr size_t WS_H = 80 * MiB;
constexpr size_t WS_P = 144 * MiB;
constexpr size_t WS_O = 288 * MiB;
constexpr size_t WS_EI = 352 * MiB, WS_EG = 368 * MiB  , WS_EW = 400 * MiB, WS_SSA = 416 * MiB, WS_SSB = 417 * MiB, WS_X1 = 420 * MiB, WS_END = 484 * MiB;
constexpr size_t WS_Q8 = 420 * MiB, WS_K8 = 436 * MiB, WS_V8T = 440 * MiB;
constexpr int CW_BAR = 4096;
constexpr int CW_PCNT = 8192;
constexpr int CW_MOD = 131072;

constexpr int LDS_BYTES = 160 * 1024;
constexpr int MISC_OFF = LDS_BYTES - 256;

#define GAS __attribute__((address_space(1)))
#define LAS __attribute__((address_space(3)))
typedef unsigned short bf16;
typedef unsigned v4u __attribute__((ext_vector_type(4)));
typedef float f32x4 __attribute__((ext_vector_type(4)));
typedef GAS unsigned gu32;
#define RLX_AGENT __ATOMIC_RELAXED, __HIP_MEMORY_SCOPE_AGENT
#define LDS_WAIT() asm volatile("s_waitcnt lgkmcnt(0)" ::: "memory")
__device__ __forceinline__ unsigned f2bf(float f) { unsigned u = __builtin_bit_cast(unsigned, f); return (u + 0x7fffu + ((u >> 16) & 1u)) >> 16; }
__device__ __forceinline__ unsigned pk2(float lo, float hi) { return f2bf(lo) | (f2bf(hi) << 16); }

#define XB_TMO      128
#define XB_XCNT(j)  (256  + 64 * (j))
#define XB_XSUB(j)  (1280 + 64 * (j))
#define XB_XGEN(j)  (2304 + 64 * (j))
#define XB_TOP      3328
#define XB_TOPGEN   3392
#define XCD_BAR_WORDS 3456
#define XB_SPIN_CAP (1u << 20)

__device__ __forceinline__ unsigned xb_ld(unsigned* p)              { return __hip_atomic_load(p, __ATOMIC_RELAXED, __HIP_MEMORY_SCOPE_AGENT); }
__device__ __forceinline__ unsigned xb_add(unsigned* p, unsigned v) { return __hip_atomic_fetch_add(p, v, __ATOMIC_RELAXED, __HIP_MEMORY_SCOPE_AGENT); }
__device__ __forceinline__ unsigned xb_xcc_id() { return (unsigned)__builtin_amdgcn_s_getreg((3 << 11) | 20) & 0xFu; }
#define XB_SPIN(cond, bar) do { unsigned _sp = 0; while (cond) { __builtin_amdgcn_s_sleep(1); \
    if ((++_sp & 255u) == 0u) { if (xb_ld(&(bar)[XB_TMO])) break; if (_sp > XB_SPIN_CAP) { atomicAdd(&(bar)[XB_TMO], 1u); break; } } } } while (0)

struct XcdBarrier { unsigned* bar; unsigned x; volatile LAS unsigned* st; };

__device__ __forceinline__ XcdBarrier xcd_barrier_post(unsigned* bar, volatile LAS unsigned* st) {
    XcdBarrier b; b.bar = bar; b.x = xb_xcc_id(); b.st = st;
    if (threadIdx.x == 0) (void)xb_add(&bar[XB_XCNT(b.x)], 1u);
    return b;
}
__device__ __forceinline__ void xcd_barrier_complete(unsigned* bar, unsigned x, unsigned& nloc, unsigned& nx) {
    const unsigned G = gridDim.x * gridDim.y * gridDim.z;
    unsigned sum, cnt, mine, sp = 0u;
    for (;;) {
        sum = 0u; cnt = 0u; mine = 0u;
#pragma unroll
        for (unsigned j = 0; j < 16; ++j) { const unsigned c = xb_ld(&bar[XB_XCNT(j)]); sum += c; cnt += (c > 0u) ? 1u : 0u; mine = (j == x) ? c : mine; }
        if (sum == G) break;
        __builtin_amdgcn_s_sleep(1);
        if ((++sp & 255u) == 0u) { if (xb_ld(&bar[XB_TMO])) break; if (sp > XB_SPIN_CAP) { atomicAdd(&bar[XB_TMO], 1u); break; } }
    }
    nloc = mine > 0u ? mine : 1u; nx = cnt > 0u ? cnt : 1u;
}
__device__ __forceinline__ void xcd_barrier(const XcdBarrier& b) {
    asm volatile("s_waitcnt vmcnt(0)" ::: "memory");
    __syncthreads();
    if (threadIdx.x == 0) {
        unsigned* bar = b.bar;
        __builtin_amdgcn_s_waitcnt(0);
        unsigned nloc = b.st[0], nx = b.st[1];
        if (nloc == 0u) { xcd_barrier_complete(bar, b.x, nloc, nx); b.st[0] = nloc; b.st[1] = nx; }
        const unsigned old = xb_add(&bar[XB_XSUB(b.x)], 1u);
        const unsigned gen = old / nloc;
        if (old + 1u == (gen + 1u) * nloc) {
            __builtin_amdgcn_fence(__ATOMIC_RELEASE, "agent");
            asm volatile("s_waitcnt vmcnt(0)" ::: "memory");
            const unsigned og = xb_add(&bar[XB_TOP], 1u);
            const unsigned tg = og / nx;
            if (og + 1u == (tg + 1u) * nx) xb_add(&bar[XB_TOPGEN], 1u);
            else XB_SPIN(xb_ld(&bar[XB_TOPGEN]) == tg, bar);
            __builtin_amdgcn_fence(__ATOMIC_ACQUIRE, "agent");
            xb_add(&bar[XB_XGEN(b.x)], 1u);
            asm volatile("s_waitcnt vmcnt(0)" ::: "memory");
        } else {
            XB_SPIN(xb_ld(&bar[XB_XGEN(b.x)]) == gen, bar);
            __builtin_amdgcn_fence(__ATOMIC_ACQUIRE, "agent");
            asm volatile("s_waitcnt vmcnt(0)" ::: "memory");
        }
    }
    __syncthreads();
}

__device__ __forceinline__ float wave_sum(float v) {
#pragma unroll
    for (int o = 1; o < 64; o <<= 1) v += __shfl_xor(v, o);
    return v;
}
template <bool PERMUTE> __device__ __forceinline__ void p0_transpose_item(const float* W, int K, int N, bf16* WT, LAS float* scr, int item, int lane, const float* ks0 = nullptr, const float* ks1 = nullptr) {
    const int nblk = N / 32, kb = item / nblk, nb = item % nblk, k0 = 64 * kb, n0 = 32 * nb;
    int r0 = n0;
    if (PERMUTE) { const int tile = nb >> 3, ob = nb & 7, wc = ob >> 1, bj = ob & 1; r0 = tile * 256 + 32 * (4 * bj + wc); }
#pragma unroll
    for (int i = 0; i < 32; ++i) { const int kk = 2 * i + (lane >> 5); const int kg = k0 + kk; const float sc = ks0 ? (kg < 512 ? ks0[kg] : ks1[kg - 512]) : 1.0f; scr[kk * 33 + (lane & 31)] = W[(size_t)kg * N + n0 + (lane & 31)] * sc; }
    LDS_WAIT(); asm volatile("" ::: "memory");
    const int c = lane & 7;
#pragma unroll
    for (int j = 0; j < 4; ++j) { const int n = (lane >> 3) + 8 * j; const LAS float* s = scr + (8 * c) * 33 + n;
        v4u o; o.x = pk2(s[0 * 33], s[1 * 33]); o.y = pk2(s[2 * 33], s[3 * 33]); o.z = pk2(s[4 * 33], s[5 * 33]); o.w = pk2(s[6 * 33], s[7 * 33]);
        *(GAS v4u*)(WT + (size_t)(r0 + n) * K + k0 + 8 * c) = o; }
    LDS_WAIT(); asm volatile("" ::: "memory");
}
__device__ __forceinline__ void sincos_d(double a, double& s, double& c) {
    const double TWO_PI = 6.283185307179586476925286766559, INV = 0.15915494309189533576888376337251;
    const double k = __builtin_rint(a * INV); const double x = a - k * TWO_PI; const double x2 = x * x;
    double ts = x, tc = 1.0, ss = x, cc = 1.0;
#pragma unroll
    for (int n = 1; n <= 16; ++n) { tc = -tc * x2 / (double)((2 * n - 1) * (2 * n)); ts = -ts * x2 / (double)((2 * n) * (2 * n + 1)); cc += tc; ss += ts; }
    s = ss; c = cc;
}
__device__ __forceinline__ float silu_f(float v) { return v / (1.0f + __expf(-v)); }

struct Ptrs {
    const float *x, *c, *w_ada, *b_ada, *n1g, *w_in, *qng, *kng, *rpb, *gag, *gbg, *w_out, *n2g, *wq, *sk1, *sk2, *pu, *pv, *fng;
    float* out; unsigned char* ws;
};

template <int PART> __device__ __forceinline__ void p0_prologue(const Ptrs& A, LAS unsigned char* lds, int vcu, int G, int wave, int lane, int gw, int NGW) {
    LAS float* scr = (LAS float*)(lds + wave * 16384);
    bf16* Win_t = (bf16*)(A.ws + WS_WIN); bf16* Wout_t = (bf16*)(A.ws + WS_WOUT); bf16* Wq_t = (bf16*)(A.ws + WS_WQ);
    constexpr int I_IN = (D / 64) * (NIN / 32), I_OUT = (D / 64) * (D / 32), I_Q = (D / 64) * (NPQ / 32);
    if (PART == 0) { for (int it = gw; it < I_IN; it += NGW) p0_transpose_item<true>(A.w_in, D, NIN, Win_t, scr, it, lane); }
    else if (PART == 1) { for (int it = gw; it < I_Q; it += NGW) p0_transpose_item<false>(A.wq, D, NPQ, Wq_t, scr, it, lane); }
    else { for (int it = gw; it < I_OUT; it += NGW) p0_transpose_item<false>(A.w_out, D, D, Wout_t, scr, it, lane, A.gag, A.gbg); return; }
    if (PART == 1) {
        typedef float v16f __attribute__((ext_vector_type(16))); typedef unsigned v6u __attribute__((ext_vector_type(6)));
        unsigned char* U6 = A.ws + WS_U; unsigned char* V6 = A.ws + WS_V; float* USc = (float*)(A.ws + WS_US); float* VSc = (float*)(A.ws + WS_VS);
        const int hw = lane >> 5, l32 = lane & 31;
        for (int it = gw; it < NEXP; it += NGW) {
            const int r = 2 * it + hw; const bool isv = r >= NEXP; const int row = isv ? r - NEXP : r;
            const float* src = (isv ? A.pv : A.pu) + (size_t)row * D + l32 * 32;
            f32x4 v[8]; float mx = 0.f;
#pragma unroll
            for (int j = 0; j < 8; ++j) { v[j] = *(const GAS f32x4*)(src + 4 * j); mx = fmaxf(mx, fmaxf(fmaxf(fabsf(v[j][0]), fabsf(v[j][1])), fmaxf(fabsf(v[j][2]), fabsf(v[j][3])))); }
#pragma unroll
            for (int o = 1; o < 32; o <<= 1) mx = fmaxf(mx, __shfl_xor(mx, o));
            const float sc = mx > 0.f ? __uint_as_float(__float_as_uint(7.5f / mx) & 0x7f800000u) : 1.0f;
            v16f a, b;
#pragma unroll
            for (int j = 0; j < 4; ++j)
#pragma unroll
                for (int i = 0; i < 4; ++i) { a[4 * j + i] = v[2 * j + (i >> 1)][2 * (i & 1)] * sc; b[4 * j + i] = v[2 * j + (i >> 1)][2 * (i & 1) + 1] * sc; }
            const v6u q = __builtin_amdgcn_cvt_scalef32_2xpk16_fp6_f32(a, b, 1.0f);
            if (isv) {
                unsigned char* dst = V6 + (size_t)row * 768;
                *(GAS v4u*)(dst + 16 * l32) = (v4u){q[0], q[1], q[2], q[3]};
                *(GAS unsigned long long*)(dst + 512 + 8 * l32) = (unsigned long long)q[4] | ((unsigned long long)q[5] << 32);
            } else {
                unsigned char* dst = U6 + (size_t)row * 768 + 16 * (l32 >> 1);
                if ((l32 & 1) == 0) { *(GAS v4u*)dst = (v4u){q[0], q[1], q[2], q[3]}; *(GAS unsigned long long*)(dst + 256) = (unsigned long long)q[4] | ((unsigned long long)q[5] << 32); }
                else { *(GAS unsigned long long*)(dst + 256 + 8) = (unsigned long long)q[0] | ((unsigned long long)q[1] << 32); *(GAS v4u*)(dst + 512) = (v4u){q[2], q[3], q[4], q[5]}; }
            }
            if (l32 == 0) (isv ? VSc : USc)[row] = 1.0f / sc;
        }
        bf16* SKb = (bf16*)(A.ws + WS_SK);
        for (int it = gw; it < 64; it += NGW) {
            const float* src = it < 32 ? A.sk1 : A.sk2; const int r = it & 31;
            const size_t e = (size_t)r * 512 + lane * 8;
            const f32x4 a = *(const GAS f32x4*)(src + e), b = *(const GAS f32x4*)(src + e + 4);
            v4u o; o.x = pk2(a[0], a[1]); o.y = pk2(a[2], a[3]); o.z = pk2(b[0], b[1]); o.w = pk2(b[2], b[3]);
            *(GAS v4u*)(SKb + (it < 32 ? 0 : 16384) + e) = o;
        }
    }
    if (PART == 0) {
        float* rc = (float*)(A.ws + WS_TAB); float* rs = rc + 128 * 16;
        const int gt = gw * 64 + lane;
        if (gt < 128 * 16) {
            const int pos = gt >> 4, i = gt & 15;
            const double f4[4] = {1.0, 0.56234132519034908039495103977648, 0.31622776601683793319988935444327, 0.17782794100389228012254211951927};
            double fr = (i & 3) == 0 ? f4[0] : ((i & 3) == 1 ? f4[1] : ((i & 3) == 2 ? f4[2] : f4[3]));
            fr *= (i >> 2) == 0 ? 1.0 : ((i >> 2) == 1 ? 0.1 : ((i >> 2) == 2 ? 0.01 : 0.001));
            double s, c; sincos_d((double)pos * fr, s, c);
            rc[gt] = (float)c; rs[gt] = (float)s;
        }
    }
    if (PART == 0) {
        float* mod = (float*)(A.ws + WS_CTL) + CW_MOD;
        LAS float* part = (LAS float*)(lds + 131072);
        LAS float* sc_l = (LAS float*)(lds + 131072 + 8192);
        if (vcu < 96) { for (int i = threadIdx.x; i < 4096; i += 512) sc_l[i] = silu_f(A.c[i]); __syncthreads(); }
        for (int it = vcu; it < 96; it += G) {
            const int col = it * 64 + lane;
            float acc[4] = {0.f, 0.f, 0.f, 0.f};
#pragma unroll 16
            for (int k = 0; k < 128; ++k) {
                const int kk = wave * 128 + k;
                const float w = A.w_ada[(size_t)kk * 6144 + col];
#pragma unroll
                for (int b = 0; b < 4; ++b) acc[b] += w * sc_l[b * 1024 + kk];
            }
#pragma unroll
            for (int b = 0; b < 4; ++b) part[(wave * 4 + b) * 64 + lane] = acc[b];
            __syncthreads();
            if (wave < 4) {
                float s = A.b_ada[col];
#pragma unroll
                for (int w8 = 0; w8 < 8; ++w8) s += part[(w8 * 4 + wave) * 64 + lane];
                mod[wave * 6144 + col] = s;
            }
            __syncthreads();
        }
    }
}
__device__ __forceinline__ void modnorm_row(const float* xrow, const float* g, const float* shift, const float* scale, bf16* orow, int lane) {
    const GAS f32x4* xr = (const GAS f32x4*)xrow + lane;
    f32x4 v[4]; float s = 0.f;
#pragma unroll
    for (int j = 0; j < 4; ++j) { v[j] = xr[64 * j]; s += (v[j].x * v[j].x + v[j].y * v[j].y) + (v[j].z * v[j].z + v[j].w * v[j].w); }
    const float rinv = 1.0f / sqrtf(wave_sum(s) * (1.0f / D) + EPS);
    GAS unsigned long long* o8 = (GAS unsigned long long*)orow + lane;
#pragma unroll
    for (int j = 0; j < 4; ++j) {
        const f32x4 gv = *((const f32x4*)g + lane + 64 * j), sh = *((const f32x4*)shift + lane + 64 * j), sc = *((const f32x4*)scale + lane + 64 * j);
        const f32x4 y = v[j] * rinv * gv * (sc + 1.0f) + sh;
        o8[64 * j] = (unsigned long long)pk2(y.x, y.y) | ((unsigned long long)pk2(y.z, y.w) << 32);
    }
}
__device__ __forceinline__ void modnorm_row_b(const bf16* xrow, const float* g, const float* shift, const float* scale, bf16* orow, int lane) {
    float f[2][8]; float s = 0.f;
#pragma unroll
    for (int j = 0; j < 2; ++j) { const v4u w = *(const GAS v4u*)(xrow + 512 * j + lane * 8);
        f[j][0] = __uint_as_float(w.x << 16); f[j][1] = __uint_as_float(w.x & 0xffff0000u); f[j][2] = __uint_as_float(w.y << 16); f[j][3] = __uint_as_float(w.y & 0xffff0000u);
        f[j][4] = __uint_as_float(w.z << 16); f[j][5] = __uint_as_float(w.z & 0xffff0000u); f[j][6] = __uint_as_float(w.w << 16); f[j][7] = __uint_as_float(w.w & 0xffff0000u);
#pragma unroll
        for (int i = 0; i < 8; ++i) s += f[j][i] * f[j][i]; }
    const float rinv = 1.0f / sqrtf(wave_sum(s) * (1.0f / D) + EPS);
#pragma unroll
    for (int j = 0; j < 2; ++j) { const int c = 512 * j + lane * 8; float y[8];
#pragma unroll
        for (int q = 0; q < 2; ++q) { const f32x4 gv = *(const f32x4*)(g + c + 4 * q), sh = *(const f32x4*)(shift + c + 4 * q), sc = *(const f32x4*)(scale + c + 4 * q);
#pragma unroll
            for (int i = 0; i < 4; ++i) y[4 * q + i] = f[j][4 * q + i] * rinv * gv[i] * (sc[i] + 1.0f) + sh[i]; }
        v4u o; o.x = pk2(y[0], y[1]); o.y = pk2(y[2], y[3]); o.z = pk2(y[4], y[5]); o.w = pk2(y[6], y[7]);
        *(GAS v4u*)(orow + c) = o; }
}
__device__ __forceinline__ void groupnorm_row(const bf16* orow, const float* ga, const float* gb, bf16* mrow, int lane) {
#pragma unroll
    for (int j = 0; j < 2; ++j) {
        const v4u w = *(const GAS v4u*)(orow + 512 * j + lane * 8);
        float f[8]; f[0] = __uint_as_float(w.x << 16); f[1] = __uint_as_float(w.x & 0xffff0000u); f[2] = __uint_as_float(w.y << 16); f[3] = __uint_as_float(w.y & 0xffff0000u);
        f[4] = __uint_as_float(w.z << 16); f[5] = __uint_as_float(w.z & 0xffff0000u); f[6] = __uint_as_float(w.w << 16); f[7] = __uint_as_float(w.w & 0xffff0000u);
        float s = 0.f;
#pragma unroll
        for (int i = 0; i < 8; ++i) s += f[i] * f[i];
        const float rinv = 1.0f / sqrtf(wave_sum(s) * (1.0f / 512.0f) + EPS);
        const float* gp = (j ? gb : ga) + lane * 8;
        const f32x4 g0 = *(const f32x4*)gp, g1 = *(const f32x4*)(gp + 4);
        v4u o; o.x = pk2(f[0] * rinv * g0[0], f[1] * rinv * g0[1]); o.y = pk2(f[2] * rinv * g0[2], f[3] * rinv * g0[3]); o.z = pk2(f[4] * rinv * g1[0], f[5] * rinv * g1[1]); o.w = pk2(f[6] * rinv * g1[2], f[7] * rinv * g1[3]);
        *(GAS v4u*)(mrow + 512 * j + lane * 8) = o;
    }
}

struct Args { Ptrs p; int ph_lo, ph_hi; };
__global__ void __launch_bounds__(NWAVES * 64, 2) hymba_fwd(Args args) {
    extern __shared__ __attribute__((aligned(16))) unsigned char lds_raw[];
    LAS unsigned char* lds = (LAS unsigned char*)lds_raw;
    volatile LAS unsigned* MISC = (volatile LAS unsigned*)(lds + MISC_OFF);
    const Ptrs& A = args.p;
    const int tid = threadIdx.x, lane = tid & 63, wave = __builtin_amdgcn_readfirstlane(tid >> 6);
    const int G = gridDim.x; const int bx = blockIdx.x; const int vcu = (G % 8 == 0) ? (bx % 8) * (G / 8) + bx / 8 : bx;
    gu32* ctl = (gu32*)(A.ws + WS_CTL);
    if (tid < 64) MISC[tid] = 0u;
    __syncthreads();
    XcdBarrier bar; bar.bar = (unsigned*)(ctl + CW_BAR); bar.x = 0; bar.st = nullptr;
    if (N_LAUNCHES != PER_PHASE) bar = xcd_barrier_post((unsigned*)(ctl + CW_BAR), MISC + 8);
#define GRID_BAR() do { if (N_LAUNCHES != PER_PHASE) xcd_barrier(bar); } while (0)
    const int lo = args.ph_lo, hi = args.ph_hi;
#define IN(k) (lo <= (k) && (k) < hi)
#define BOTH(k) (IN(k) && IN((k) + 1))
    const float* mod = (const float*)(A.ws + WS_CTL) + CW_MOD;
    bf16* Hb = (bf16*)(A.ws + WS_H); bf16* Pb = (bf16*)(A.ws + WS_P); bf16* Ob = (bf16*)(A.ws + WS_O);
    const int gw = vcu * NWAVES + wave, NGW = G * NWAVES;

    if (IN(0)) { p0_prologue<0>(A, lds, vcu, G, wave, lane, gw, NGW); if (BOTH(0)) GRID_BAR(); }
    if (IN(1)) {
        for (int m = gw; m < M; m += NGW) { const float* md = mod + (m >> 13) * 6144; modnorm_row(A.x + (size_t)m * D, A.n1g, md, md + 1024, Hb + (size_t)m * D, lane); }
        if (BOTH(1)) GRID_BAR();
    }
    if (IN(2)) {
        pg8::Gemm g{Hb, (const bf16*)(A.ws + WS_WIN), M, NIN, D}; pg8::StaticOrder S; S.init(M, NIN, G, bx);
        { const float* tab = (const float*)(A.ws + WS_TAB); LAS float* tl = (LAS float*)(lds + 131072);
          for (int i = tid; i < 2 * 128 * 16; i += NWAVES * 64) tl[i] = tab[i];
          __syncthreads(); }
        pg8::EpiInProj E{Pb, A.ws + WS_Q8, A.ws + WS_K8, A.ws + WS_V8T, A.qng, A.kng, (const LAS float*)(lds + 131072), (const LAS float*)(lds + 131072) + 128 * 16, C2};
        pg8::gemm_phase<pg8::EpiInProj, pg8::StaticOrder, true, true>(lds, g, S, E);
        {
            const int nunits = (M / 256) * (NIN / 256), rounds = (nunits + G - 1) / G, busy = nunits - (rounds - 1) * G, nidle = G - busy;
            __syncthreads();
            if (nidle == 0) { p0_prologue<1>(A, lds, vcu, G, wave, lane, bx * NWAVES + wave, G * NWAVES); p0_prologue<2>(A, lds, vcu, G, wave, lane, bx * NWAVES + wave, G * NWAVES); }
            else if (bx >= busy) p0_prologue<1>(A, lds, vcu, G, wave, lane, (bx - busy) * NWAVES + wave, nidle * NWAVES);
            else if (wave < 4) p0_prologue<2>(A, lds, vcu, G, wave, lane, bx * 4 + wave, busy * 4);
        }
        if (BOTH(2)) GRID_BAR();
    }
    if (IN(3)) {
        float cb; { const float gq = fabsf(A.qng[lane]), gk = fabsf(A.kng[lane]); float mq = gq, mk = gk;
#pragma unroll
            for (int o = 1; o < 64; o <<= 1) { mq = fmaxf(mq, __shfl_xor(mq, o)); mk = fmaxf(mk, __shfl_xor(mk, o)); }
            cb = 8.0f * 1.4426950408889634f * mq * mk; }
        const attn8::Tensors AT{A.ws + WS_Q8, A.ws + WS_K8, A.ws + WS_V8T, Ob, (float*)(A.ws + WS_SSA)};
        attn8::phase((char*)lds_raw, AT, G, bx, cb - 8.0f);
        __syncthreads();
        natten::natten_phase(lds, Pb + 768, Pb + 1280, Pb + 1792, A.rpb, Ob, (float*)(A.ws + WS_SSB), vcu, G);
        if (BOTH(3)) GRID_BAR();
    }
    if (IN(5)) {
        pg8::Gemm g{Ob, (const bf16*)(A.ws + WS_WOUT), M, D, D}; pg8::StaticOrder S; S.init(M, D, G, bx);
        pg8::EpiX1N E{A.x, (bf16*)(A.ws + WS_X1), Hb, mod, A.n2g, (const float*)(A.ws + WS_SSA), (const float*)(A.ws + WS_SSB), (LAS float*)(lds + 131072), (unsigned*)(A.ws + WS_XS), (unsigned*)(ctl + CW_PCNT)};
        E.prep(S);
        pg8::gemm_phase<pg8::EpiX1N, pg8::StaticOrder, true, true>(lds, g, S, E);
        if (BOTH(5)) GRID_BAR();
    }
    if (IN(7)) {
        pg8::Gemm g{Hb, (const bf16*)(A.ws + WS_WQ), M, NPQ, D}; pg8::StaticOrder S; S.init(M, NPQ, G, bx);
        pg8::EpiBf16 E{Pb, NPQ};
        pg8::gemm_phase<pg8::EpiBf16, pg8::StaticOrder, true, true>(lds, g, S, E);
        if (BOTH(7)) GRID_BAR();
    }
    if (IN(8) || IN(9)) {
        peer::PeerArgs PA{Pb, (const bf16*)(A.ws + WS_SK), Hb, A.ws + WS_U, A.ws + WS_V, (const float*)(A.ws + WS_US), (const float*)(A.ws + WS_VS), (int*)(A.ws + WS_EI), (float*)(A.ws + WS_EG), (float*)(A.ws + WS_EW), (const bf16*)(A.ws + WS_X1), A.out, mod, A.fng};
        if (IN(8)) peer::peer_phase(lds, PA, vcu, G, wave);
    }
#undef IN
#undef BOTH
#undef GRID_BAR
}

extern "C" void kernel_launch(void* const* d_in, const int* in_sizes, int n_in, void* d_out, int out_size, void* d_ws, size_t ws_size, hipStream_t stream) {
    static int grid = 0;
    if (grid == 0) {
        if (n_in != 19 || in_sizes[0] != M * D || out_size != M * D || ws_size < WS_END) { fprintf(stderr, "kernel_launch: unexpected problem shape (n_in %d, in0 %d, out %d, ws %zu); nothing launched\n", n_in, n_in > 0 ? in_sizes[0] : -1, out_size, ws_size); grid = -1; return; }
        int dev = 0, cus = 0, per_cu = 0;
        if (hipGetDevice(&dev) != hipSuccess || hipDeviceGetAttribute(&cus, hipDeviceAttributeMultiprocessorCount, dev) != hipSuccess) { grid = -1; return; }
        if (hipFuncSetAttribute((const void*)hymba_fwd, hipFuncAttributeMaxDynamicSharedMemorySize, LDS_BYTES) != hipSuccess) { fprintf(stderr, "kernel_launch: hipFuncSetAttribute failed\n"); grid = -1; return; }
        if (hipOccupancyMaxActiveBlocksPerMultiprocessor(&per_cu, (const void*)hymba_fwd, NWAVES * 64, LDS_BYTES) != hipSuccess || per_cu < 1) { fprintf(stderr, "kernel_launch: occupancy query reports %d workgroups per CU; nothing launched\n", per_cu); (void)hipGetLastError(); grid = -1; return; }
        grid = cus;
    }
    if (grid < 0) return;
    if (hipMemsetAsync((char*)d_ws + WS_CTL, 0, CTL_ZERO_BYTES, stream) != hipSuccess) { fprintf(stderr, "kernel_launch: hipMemsetAsync failed\n"); return; }
    Args a{};
    a.p.x = (const float*)d_in[0]; a.p.c = (const float*)d_in[1]; a.p.w_ada = (const float*)d_in[2]; a.p.b_ada = (const float*)d_in[3]; a.p.n1g = (const float*)d_in[4];
    a.p.w_in = (const float*)d_in[5]; a.p.qng = (const float*)d_in[6]; a.p.kng = (const float*)d_in[7]; a.p.rpb = (const float*)d_in[8]; a.p.gag = (const float*)d_in[9];
    a.p.gbg = (const float*)d_in[10]; a.p.w_out = (const float*)d_in[11]; a.p.n2g = (const float*)d_in[12]; a.p.wq = (const float*)d_in[13]; a.p.sk1 = (const float*)d_in[14];
    a.p.sk2 = (const float*)d_in[15]; a.p.pu = (const float*)d_in[16]; a.p.pv = (const float*)d_in[17]; a.p.fng = (const float*)d_in[18];
    a.p.out = (float*)d_out; a.p.ws = (unsigned char*)d_ws;
    for (int li = 0; li < N_LAUNCHES; ++li) {
        a.ph_lo = (N_LAUNCHES == PER_PHASE) ? li : 0; a.ph_hi = (N_LAUNCHES == PER_PHASE) ? li + 1 : PER_PHASE;
        hipLaunchKernelGGL(hymba_fwd, dim3(grid), dim3(NWAVES * 64), LDS_BYTES, stream, a);
        const hipError_t le = hipPeekAtLastError();
        if (le != hipSuccess) { fprintf(stderr, "kernel_launch: launch %d failed: %s\n", li, hipGetErrorName(le)); break; }
    }
}
```
